# Optimizing an MI355X kernel written in HIP

```python
import math
import jax
import jax.numpy as jnp
from jax import lax
import numpy as np

D_MODEL = 2048
BATCH = 2
SEQ = 8192
DEPTH = 2

N_EVEN = (DEPTH + 1) // 2
N_ODD = DEPTH // 2

ROPE_THETA = 10000.0
NORM_EPS = 1e-6

DA_HEADS = 8
DA_DIM = 64
DA_VDIM = 2 * DA_DIM
DA_QBLK = 128

SW_HEADS = 16
SW_KV = 4
SW_DIM = 64
SW_WINDOW = 128

EVEN_IN = 3 * DA_HEADS * DA_VDIM + (SW_HEADS + 2 * SW_KV) * SW_DIM
EVEN_OUT = DA_HEADS * DA_VDIM + SW_HEADS * SW_DIM

NSA_HEADS = 16
NSA_KV = 2
NSA_DIM = 128
CMP_LEN = 32
CMP_STRIDE = 16
CMP_HIDDEN = 256
SLC_LEN = 64
SLC_TOPN = 16
NSA_WINDOW = 512
NSA_QBLK = 64

ODD_IN = NSA_HEADS * NSA_DIM + 6 * NSA_KV * NSA_DIM + 3 * NSA_HEADS
ODD_OUT = NSA_HEADS * NSA_DIM

PEER_HEADS = 8
PEER_NKEYS = 128
PEER_EXPERTS = PEER_NKEYS * PEER_NKEYS
PEER_TOPK = 16
PEER_HALF = 128
PEER_QDIM = 2 * PEER_HALF
PEER_CHUNK = 128

kernel_name = 'hybrid_diffattn_swa_nsa_peer_block'


def rmsnorm(x, g):
    xf = x.astype(jnp.float32)
    y = xf * lax.rsqrt(jnp.mean(xf * xf, axis=-1, keepdims=True) + NORM_EPS)
    return (y * g.astype(jnp.float32)).astype(x.dtype)


def rope_tables(pos, dim):
    inv = jnp.power(ROPE_THETA, -jnp.arange(0, dim, 2, dtype=jnp.float32) / dim)
    ang = pos.astype(jnp.float32)[:, None] * inv[None, :]
    return jnp.cos(ang), jnp.sin(ang)


def apply_rope(x, cos, sin):
    d2 = x.shape[-1] // 2
    shp = (1, cos.shape[0]) + (1,) * (x.ndim - 3) + (d2,)
    c = cos.reshape(shp).astype(x.dtype)
    s = sin.reshape(shp).astype(x.dtype)
    x1, x2 = x[..., :d2], x[..., d2:]
    return jnp.concatenate([x1 * c - x2 * s, x2 * c + x1 * s], axis=-1)


def masked_softmax(s, mask):
    s = jnp.where(mask, s.astype(jnp.float32), -jnp.inf)
    m = jnp.max(s, axis=-1, keepdims=True)
    m = jnp.where(jnp.isfinite(m), m, 0.0)
    p = jnp.exp(s - m)
    return p / jnp.maximum(jnp.sum(p, axis=-1, keepdims=True), 1e-30)


def ada_prenorm(x, c, w, b, g):
    mod = jax.nn.silu(c) @ w + b
    shift, scale, gate = jnp.split(mod[:, None, :], 3, axis=-1)
    h = rmsnorm(x, g) * (1 + scale) + shift
    return h, gate


def diff_attention(q, k, v, lam, lam_init, subln_g, cos, sin):
    B, S = q.shape[0], q.shape[1]
    q = apply_rope(q, cos, sin)
    k = apply_rope(k, cos, sin)
    nb = S // DA_QBLK
    qb = q.reshape(B, nb, DA_QBLK, 2, DA_HEADS, DA_DIM).transpose(1, 0, 2, 3, 4, 5)
    kpos = jnp.arange(S)
    scale = DA_DIM ** -0.5

    def block(args):
        qblk, i = args
        s = jnp.einsum('bqmhd,bkmhd->bmhqk', qblk, k) * scale
        tpos = i * DA_QBLK + jnp.arange(DA_QBLK)
        mask = (kpos[None, :] <= tpos[:, None])[None, None, None]
        p = masked_softmax(s, mask)
        a = p[:, 0] - lam * p[:, 1]
        return jnp.einsum('bhqk,bkhd->bqhd', a.astype(v.dtype), v)

    o = lax.map(block, (qb, jnp.arange(nb)))
    o = o.transpose(1, 0, 2, 3, 4).reshape(B, S, DA_HEADS, DA_VDIM)
    o = rmsnorm(o, subln_g) * (1.0 - lam_init)
    return o.reshape(B, S, DA_HEADS * DA_VDIM)


def sliding_window_sink_attention(q, k, v, sinks, cos, sin):
    B, S = q.shape[0], q.shape[1]
    G = SW_HEADS // SW_KV
    W = SW_WINDOW
    q = apply_rope(q, cos, sin)
    k = apply_rope(k, cos, sin)
    nb = S // W
    qb = q.reshape(B, nb, W, SW_KV, G, SW_DIM)

    def band(t):
        tb = t.reshape(B, nb, W, SW_KV, SW_DIM)
        prev = jnp.pad(tb, ((0, 0), (1, 0), (0, 0), (0, 0), (0, 0)))[:, :-1]
        return jnp.concatenate([prev, tb], axis=2)

    kb, vb = band(k), band(v)
    s = jnp.einsum('bnqhgd,bnkhd->bnhgqk', qb, kb).astype(jnp.float32) * (SW_DIM ** -0.5)
    qi = jnp.arange(W)[:, None] + W
    ki = jnp.arange(2 * W)[None, :]
    rel = qi - ki
    kabs = jnp.arange(nb)[:, None, None] * W - W + ki[None]
    mask = (rel >= 0)[None] & (rel < W)[None] & (kabs >= 0)
    s = jnp.where(mask[None, :, None, None], s, -jnp.inf)
    sink = sinks.astype(jnp.float32).reshape(SW_KV, G)[None, None, :, :, None, None]
    m = jnp.maximum(jnp.max(s, axis=-1, keepdims=True), sink)
    p = jnp.exp(s - m)
    p = p / (jnp.sum(p, axis=-1, keepdims=True) + jnp.exp(sink - m))
    o = jnp.einsum('bnhgqk,bnkhd->bnqhgd', p.astype(v.dtype), vb)
    return o.reshape(B, S, SW_HEADS * SW_DIM)


def even_mixer(h, w_in, w_out, lam_vecs, subln_g, sinks, lam_init, cos, sin):
    B, S, _ = h.shape
    da_qk = 2 * DA_HEADS * DA_DIM
    da_v = DA_HEADS * DA_VDIM
    sizes = [da_qk, da_qk, da_v, SW_HEADS * SW_DIM, SW_KV * SW_DIM]
    qa, ka, va, qs, ks, vs = jnp.split(h @ w_in, [int(n) for n in np.cumsum(sizes)], axis=-1)
    lv = lam_vecs.astype(jnp.float32)
    lam = jnp.exp(jnp.sum(lv[0] * lv[1])) - jnp.exp(jnp.sum(lv[2] * lv[3])) + lam_init
    oa = diff_attention(qa.reshape(B, S, 2, DA_HEADS, DA_DIM),
                        ka.reshape(B, S, 2, DA_HEADS, DA_DIM),
                        va.reshape(B, S, DA_HEADS, DA_VDIM),
                        lam, lam_init, subln_g, cos, sin)
    ob = sliding_window_sink_attention(qs.reshape(B, S, SW_HEADS, SW_DIM),
                                       ks.reshape(B, S, SW_KV, SW_DIM),
                                       vs.reshape(B, S, SW_KV, SW_DIM),
                                       sinks, cos, sin)
    return jnp.concatenate([oa, ob], axis=-1) @ w_out


def compress_blocks(t, pos_emb, w1, w2):
    B, S, H, d = t.shape
    r = CMP_LEN // CMP_STRIDE
    nch = S // CMP_STRIDE
    ch = t.reshape(B, nch, CMP_STRIDE, H, d)
    blocks = jnp.concatenate([ch[:, j:nch - r + 1 + j] for j in range(r)], axis=2)
    blocks = blocks + pos_emb[None, None, :, None, :]
    nc = blocks.shape[1]
    flat = blocks.transpose(0, 1, 3, 2, 4).reshape(B, nc, H, CMP_LEN * d)
    return jax.nn.gelu(flat @ w1) @ w2


def nsa_mixer(h, w_in, w_out, cmp_pos, cmp_w1, cmp_w2, cos, sin):
    B, S, _ = h.shape
    G = NSA_HEADS // NSA_KV
    d = NSA_DIM
    kvw = NSA_KV * d
    sizes = [NSA_HEADS * d] + [kvw] * 6
    q, kc, vc, ksl, vsl, kw, vw, gates = jnp.split(h @ w_in, [int(n) for n in np.cumsum(sizes)], axis=-1)
    q = apply_rope(q.reshape(B, S, NSA_HEADS, d), cos, sin)
    kv = lambda t: t.reshape(B, S, NSA_KV, d)
    ksl = apply_rope(kv(ksl), cos, sin)
    kw = apply_rope(kv(kw), cos, sin)
    vsl, vw = kv(vsl), kv(vw)
    kcmp = compress_blocks(kv(kc), cmp_pos[0], cmp_w1[0], cmp_w2[0])
    vcmp = compress_blocks(kv(vc), cmp_pos[1], cmp_w1[1], cmp_w2[1])
    nc = kcmp.shape[1]
    cmp_end = jnp.arange(nc) * CMP_STRIDE + CMP_LEN - 1
    kcmp = apply_rope(kcmp, cos[cmp_end], sin[cmp_end])
    ns = S // SLC_LEN
    topn = min(SLC_TOPN, ns)
    cst = jnp.arange(nc)[:, None] * CMP_STRIDE
    sst = jnp.arange(ns)[None, :] * SLC_LEN
    overlap = jnp.clip(jnp.minimum(cst + CMP_LEN, sst + SLC_LEN) - jnp.maximum(cst, sst), 0, None)
    overlap = overlap.astype(jnp.float32) / CMP_LEN
    ksb = ksl.reshape(B, ns, SLC_LEN, NSA_KV, d).transpose(0, 3, 1, 2, 4)
    vsb = vsl.reshape(B, ns, SLC_LEN, NSA_KV, d).transpose(0, 3, 1, 2, 4)
    pad = ((0, 0), (NSA_WINDOW, 0), (0, 0), (0, 0))
    kwp, vwp = jnp.pad(kw, pad), jnp.pad(vw, pad)
    nb = S // NSA_QBLK
    qb = q.reshape(B, nb, NSA_QBLK, NSA_KV, G, d).transpose(1, 0, 2, 3, 4, 5)
    gb = jax.nn.sigmoid(gates).reshape(B, nb, NSA_QBLK, 3, NSA_KV, G).transpose(1, 0, 2, 3, 4, 5)
    scale = d ** -0.5
    bidx = jnp.arange(B)[:, None, None, None]
    hidx = jnp.arange(NSA_KV)[None, None, :, None]
    blk = jnp.arange(ns)
    span = NSA_WINDOW + NSA_QBLK

    def block(args):
        qblk, gblk, i = args
        t0 = i * NSA_QBLK
        tpos = t0 + jnp.arange(NSA_QBLK)
        s = jnp.einsum('bthgd,bchd->bthgc', qblk, kcmp) * scale
        mask_c = (cmp_end[None, :] <= tpos[:, None])[None, :, None, None, :]
        p_c = masked_softmax(s, mask_c)
        o_c = jnp.einsum('bthgc,bchd->bthgd', p_c.astype(vcmp.dtype), vcmp)
        imp = jnp.einsum('bthgc,cs->bths', p_c, overlap)
        cur = tpos // SLC_LEN
        future = blk[None, :] > cur[:, None]
        forced = (blk[None, :] == 0) | (blk[None, :] == cur[:, None]) | (blk[None, :] == cur[:, None] - 1)
        imp = jnp.where(forced[None, :, None, :], jnp.inf, imp)
        imp = jnp.where(future[None, :, None, :], -jnp.inf, imp)
        _, idx = lax.top_k(imp, topn)
        k_sel = ksb[bidx, hidx, idx]
        v_sel = vsb[bidx, hidx, idx]
        kpos = idx[..., None] * SLC_LEN + jnp.arange(SLC_LEN)
        s = jnp.einsum('bthgd,bthnld->bthgnl', qblk, k_sel) * scale
        s = s.reshape(B, NSA_QBLK, NSA_KV, G, topn * SLC_LEN)
        mask_s = (kpos <= tpos[None, :, None, None, None]).reshape(B, NSA_QBLK, NSA_KV, 1, topn * SLC_LEN)
        p_s = masked_softmax(s, mask_s)
        o_s = jnp.einsum('bthgm,bthmd->bthgd', p_s.astype(v_sel.dtype),
                         v_sel.reshape(B, NSA_QBLK, NSA_KV, topn * SLC_LEN, d))
        kwin = lax.dynamic_slice_in_dim(kwp, t0, span, axis=1)
        vwin = lax.dynamic_slice_in_dim(vwp, t0, span, axis=1)
        wpos = t0 - NSA_WINDOW + jnp.arange(span)
        rel = tpos[:, None] - wpos[None, :]
        mask_w = ((rel >= 0) & (rel < NSA_WINDOW) & (wpos[None, :] >= 0))[None, :, None, None, :]
        s = jnp.einsum('bthgd,bkhd->bthgk', qblk, kwin) * scale
        p_w = masked_softmax(s, mask_w)
        o_w = jnp.einsum('bthgk,bkhd->bthgd', p_w.astype(vwin.dtype), vwin)
        g = gblk[..., None].astype(o_c.dtype)
        return g[:, :, 0] * o_c + g[:, :, 1] * o_s + g[:, :, 2] * o_w

    o = lax.map(block, (qb, gb, jnp.arange(nb)))
    o = o.transpose(1, 0, 2, 3, 4, 5).reshape(B, S, NSA_HEADS * d)
    return o @ w_out


def peer_ffn(h, wq, subkeys, u_tab, v_tab):
    B, S, D = h.shape
    T = B * S
    ht = h.reshape(T // PEER_CHUNK, PEER_CHUNK, D)
    K = PEER_TOPK

    def chunk(hc):
        q = (hc @ wq).reshape(PEER_CHUNK, PEER_HEADS, 2, PEER_HALF)
        s = jnp.einsum('thpd,hpkd->thpk', q, subkeys).astype(jnp.float32)
        sv, si = lax.top_k(s, K)
        cand = (sv[:, :, 0, :, None] + sv[:, :, 1, None, :]).reshape(PEER_CHUNK, PEER_HEADS, K * K)
        cidx = (si[:, :, 0, :, None] * PEER_NKEYS + si[:, :, 1, None, :]).reshape(PEER_CHUNK, PEER_HEADS, K * K)
        best, pos = lax.top_k(cand, K)
        eidx = jnp.take_along_axis(cidx, pos, axis=-1)
        g = jax.nn.softmax(best, axis=-1)
        u = u_tab[eidx]
        a = jax.nn.gelu(jnp.einsum('td,thkd->thk', hc, u).astype(jnp.float32))
        coef = (g * a).astype(hc.dtype)
        return jnp.einsum('thk,thkd->td', coef, v_tab[eidx])

    return lax.map(chunk, ht).reshape(B, S, D)


def setup_inputs(seed: int = 0) -> dict:
    key = jax.random.key(seed)
    ks = jax.random.split(key, 20)
    nrm = lambda k, shp, sc: jax.random.normal(k, shp, jnp.float32) * sc
    D = D_MODEL
    return {
        'x': nrm(ks[0], (BATCH, SEQ, D), 1.0),
        'c': nrm(ks[1], (BATCH, D), 1.0),
        'ada_w': nrm(ks[2], (DEPTH, 2, D, 3 * D), 0.5 * D ** -0.5),
        'ada_b': nrm(ks[3], (DEPTH, 2, 3 * D), 0.02),
        'norm_g': 1.0 + nrm(ks[4], (DEPTH, 2, D), 0.05),
        'even_w_in': nrm(ks[5], (N_EVEN, D, EVEN_IN), D ** -0.5),
        'even_w_out': nrm(ks[6], (N_EVEN, EVEN_OUT, D), EVEN_OUT ** -0.5),
        'da_lambda': nrm(ks[7], (N_EVEN, 4, DA_DIM), 0.1),
        'da_subln': 1.0 + nrm(ks[8], (N_EVEN, DA_VDIM), 0.05),
        'sw_sinks': nrm(ks[9], (N_EVEN, SW_HEADS), 0.5),
        'odd_w_in': nrm(ks[10], (N_ODD, D, ODD_IN), D ** -0.5),
        'odd_w_out': nrm(ks[11], (N_ODD, ODD_OUT, D), ODD_OUT ** -0.5),
        'nsa_cmp_pos': nrm(ks[12], (N_ODD, 2, CMP_LEN, NSA_DIM), 0.5),
        'nsa_cmp_w1': nrm(ks[13], (N_ODD, 2, CMP_LEN * NSA_DIM, CMP_HIDDEN), (CMP_LEN * NSA_DIM) ** -0.5),
        'nsa_cmp_w2': nrm(ks[14], (N_ODD, 2, CMP_HIDDEN, NSA_DIM), CMP_HIDDEN ** -0.5),
        'peer_wq': nrm(ks[15], (DEPTH, D, PEER_HEADS * PEER_QDIM), D ** -0.5),
        'peer_subkeys': nrm(ks[16], (DEPTH, PEER_HEADS, 2, PEER_NKEYS, PEER_HALF), PEER_HALF ** -0.5),
        'peer_u': nrm(ks[17], (DEPTH, PEER_EXPERTS, D), D ** -0.5),
        'peer_v': nrm(ks[18], (DEPTH, PEER_EXPERTS, D), 1.0),
        'final_g': 1.0 + nrm(ks[19], (D,), 0.05),
    }


def reference(x, c, ada_w, ada_b, norm_g, even_w_in, even_w_out, da_lambda, da_subln, sw_sinks,
              odd_w_in, odd_w_out, nsa_cmp_pos, nsa_cmp_w1, nsa_cmp_w2,
              peer_wq, peer_subkeys, peer_u, peer_v, final_g):
    S = x.shape[1]
    pos = jnp.arange(S)
    cos64, sin64 = rope_tables(pos, DA_DIM)
    cos128, sin128 = rope_tables(pos, NSA_DIM)
    for layer in range(DEPTH):
        j = layer // 2
        h, gate = ada_prenorm(x, c, ada_w[layer, 0], ada_b[layer, 0], norm_g[layer, 0])
        if layer % 2 == 0:
            lam_init = 0.8 - 0.6 * math.exp(-0.3 * layer)
            y = even_mixer(h, even_w_in[j], even_w_out[j], da_lambda[j], da_subln[j], sw_sinks[j],
                           lam_init, cos64, sin64)
        else:
            y = nsa_mixer(h, odd_w_in[j], odd_w_out[j], nsa_cmp_pos[j], nsa_cmp_w1[j], nsa_cmp_w2[j],
                          cos128, sin128)
        x = x + gate * y
        h, gate = ada_prenorm(x, c, ada_w[layer, 1], ada_b[layer, 1], norm_g[layer, 1])
        x = x + gate * peer_ffn(h, peer_wq[layer], peer_subkeys[layer], peer_u[layer], peer_v[layer])
    return rmsnorm(x, final_g)
```

```cpp
#include <hip/hip_runtime.h>
#include <hip/hip_cooperative_groups.h>
#include <cstdio>
#include <cstdint>
namespace pg8 {
#define PG8_LAS __attribute__((address_space(3)))
typedef unsigned short bf16_t;
typedef short bf16x8 __attribute__((ext_vector_type(8)));
typedef float f32x4 __attribute__((ext_vector_type(4)));
typedef unsigned u32x4 __attribute__((ext_vector_type(4)));
constexpr int BM = 256, BK = 64, HALF = 128, HTB = HALF * BK * 2  , STAGE_BYTES = 8 * HTB, NXCD = 8, WGM = 8;

__host__ __device__ __forceinline__ int lds_byte(int r, int c) { const int st = (r >> 4) * 2 + (c >> 5), rr = r & 15, cc = c & 31, ob = rr * 64 + cc * 2; return st * 1024 + (ob ^ (((ob >> 9) & 1) << 5)); }
__host__ __device__ __forceinline__ void stage_rc(int b, int& R, int& C) { const int st = b / 1024, sb = b % 1024, swz = sb ^ (((sb >> 9) & 1) << 5); R = (st >> 1) * 16 + swz / 64; C = (st & 1) * 32 + (swz % 64) / 2; }
__host__ __device__ __forceinline__ int perm32(int rho) { const int n = rho >> 4, i = rho & 15; return 8 * (i >> 2) + 4 * n + (i & 3); }

struct Unit { int pm, pn; };
struct Gemm { const bf16_t* A; const bf16_t* Bt; int M, N, K, lda; };

struct StaticOrder {
    int nM, nN, nwg, G, c;
    __host__ __device__ void init(int M, int N, int G_, int c_) { nM = M / BM; nN = N / BM; nwg = nM * nN; G = G_; c = c_; }
    __host__ __device__ bool next(int i, Unit& u) const {
        const long L = (long)i * G + c; if (L >= nwg) return false;
        int wgid = (int)L; { const int q = nwg / NXCD, r = nwg % NXCD, xcd = wgid % NXCD, off = wgid / NXCD; wgid = (xcd < r ? xcd * (q + 1) : r * (q + 1) + (xcd - r) * q) + off; }
        const int nig = WGM * nN, gid = wgid / nig, fm = gid * WGM, gsz = (nM - fm) < WGM ? (nM - fm) : WGM;
        u.pm = fm + ((wgid % nig) % gsz); u.pn = (wgid % nig) / gsz; return true;
    }
    __device__ __forceinline__ void a_ready(const Unit&) const {}
    __device__ __forceinline__ void done(const Unit&) const {}
};

__device__ __forceinline__ unsigned cvt_pk_bf16(float lo, float hi) { unsigned r; asm volatile("v_cvt_pk_bf16_f32 %0, %1, %2" : "=v"(r) : "v"(lo), "v"(hi)); return r; }
typedef float f32x2 __attribute__((ext_vector_type(2)));
template <class Epi, class Sched, bool ALIGN_EPI = false, bool SP2 = false>
__device__ __forceinline__ void gemm_phase(PG8_LAS unsigned char* lds, const Gemm g, Sched& S, const Epi& E) {
    int tid_ = threadIdx.x; asm volatile("" : "+v"(tid_));
    const int tid = tid_, wid = __builtin_amdgcn_readfirstlane(tid >> 6), lane = tid & 63, wr = wid >> 2, wc = wid & 3, fr = lane & 15, fq = lane >> 4;
    const int K = g.K, nt = K / BK, LDA = g.lda;
    unsigned voffA[2], voffB[2];
#pragma unroll
    for (int i = 0; i < 2; ++i) { int R, C; stage_rc(tid * 16 + i * 8192, R, C); const int Rb = Epi::PERM ? ((R & ~31) + perm32(R & 31)) : R;
        voffA[i] = (unsigned)(R * LDA + C) * 2u; voffB[i] = (unsigned)(Rb * K + C) * 2u; }
    const size_t kstep = (size_t)(BK * 2);
    const size_t hstepB = (size_t)HALF * K * 2, hstepA = (size_t)HALF * LDA * 2;
    const size_t tstepA = 2 * hstepA, tstepB = 2 * hstepB;
    const unsigned ldsw = (unsigned)wid * 1024u;
    const int aoff = lds_byte(wr * 64 + fr, fq * 8), boff = lds_byte(wc * 32 + fr, fq * 8);
#define PG8_SA(b, h) (((b) * 2 + (h)) * HTB)
#define PG8_SB(b, h) ((4 + (b) * 2 + (h)) * HTB)
#define PG8_STAGE(bufoff, gbase, voff) do { _Pragma("unroll") for (int _i = 0; _i < 2; ++_i) \
        __builtin_amdgcn_global_load_lds((const unsigned*)((const char*)(gbase) + (voff)[_i]), (PG8_LAS unsigned*)(lds + (bufoff) + ldsw + _i * 8192), 16, 0, 0); } while (0)
#define PG8_LDA(dst, b, h) do { _Pragma("unroll") for (int m = 0; m < 4; ++m) _Pragma("unroll") for (int k = 0; k < 2; ++k) dst[m][k] = *(const PG8_LAS bf16x8*)(lds + PG8_SA(b, h) + aoff + m * 2048 + k * 1024); } while (0)
#define PG8_LDB(dst, b, h) do { _Pragma("unroll") for (int n = 0; n < 2; ++n) _Pragma("unroll") for (int k = 0; k < 2; ++k) dst[n][k] = *(const PG8_LAS bf16x8*)(lds + PG8_SB(b, h) + boff + n * 2048 + k * 1024); } while (0)
#define PG8_MMA(ai, bj, At, Bt) do { __builtin_amdgcn_s_setprio(1); _Pragma("unroll") for (int m = 0; m < 4; ++m) _Pragma("unroll") for (int n = 0; n < 2; ++n) _Pragma("unroll") for (int k = 0; k < 2; ++k) \
        acc[ai][bj][m][n] = __builtin_amdgcn_mfma_f32_16x16x32_bf16(Bt[n][k], At[m][k], acc[ai][bj][m][n], 0, 0, 0); __builtin_amdgcn_s_setprio(0); } while (0)
#define PG8_WAIT_V(n) asm volatile("s_waitcnt vmcnt(" #n ")" ::: "memory")
#define PG8_WAIT_L(n) asm volatile("s_waitcnt lgkmcnt(" #n ")" ::: "memory")
#define PG8_BAR __builtin_amdgcn_s_barrier()
#define PG8_SCHED __builtin_amdgcn_sched_barrier(0)
    Unit cur, nxt; int ui = 0;
    if (!S.next(0, cur)) return;
    f32x4 acc[2][2][4][2];
#pragma unroll
    for (int a = 0; a < 2; ++a)
#pragma unroll
        for (int b = 0; b < 2; ++b)
#pragma unroll
            for (int m = 0; m < 4; ++m)
#pragma unroll
                for (int n = 0; n < 2; ++n) acc[a][b][m][n] = (f32x4){0.f, 0.f, 0.f, 0.f};
    bf16x8 At[4][2], B0[2][2], B1[2][2];
    const char* cA = (const char*)g.A + (size_t)cur.pm * tstepA; const char* cB = (const char*)g.Bt + (size_t)cur.pn * tstepB;
    S.a_ready(cur);
    if constexpr (SP2) {
        PG8_STAGE(PG8_SB(0, 0), cB, voffB); PG8_STAGE(PG8_SB(0, 1), cB + hstepB, voffB); PG8_STAGE(PG8_SA(0, 0), cA, voffA); PG8_STAGE(PG8_SA(0, 1), cA + hstepA, voffA);
        if (wr == 1) PG8_BAR;
        PG8_WAIT_V(2); PG8_BAR;
        PG8_STAGE(PG8_SB(1, 0), cB + kstep, voffB); PG8_STAGE(PG8_SA(1, 0), cA + kstep, voffA); PG8_STAGE(PG8_SB(1, 1), cB + hstepB + kstep, voffB);
        PG8_WAIT_V(6); PG8_BAR;
    } else {
        PG8_STAGE(PG8_SB(0, 0), cB, voffB); PG8_STAGE(PG8_SA(0, 0), cA, voffA); PG8_STAGE(PG8_SB(0, 1), cB + hstepB, voffB); PG8_STAGE(PG8_SA(0, 1), cA + hstepA, voffA);
        if (wr == 1) PG8_BAR;
        PG8_WAIT_V(4); PG8_BAR;
        PG8_STAGE(PG8_SB(1, 0), cB + kstep, voffB); PG8_STAGE(PG8_SA(1, 0), cA + kstep, voffA); PG8_STAGE(PG8_SB(1, 1), cB + hstepB + kstep, voffB);
        PG8_WAIT_V(6); PG8_BAR;
    }
    for (;;) {
        const bool has_next = S.next(ui + 1, nxt);
        const char* nA = has_next ? (const char*)g.A + (size_t)nxt.pm * tstepA : cA; const char* nB = has_next ? (const char*)g.Bt + (size_t)nxt.pn * tstepB : cB;
        for (int t = 0; t < nt; t += 2) {
            const bool last = (t == nt - 2);
            const char* a1 = cA + (size_t)(t + 1) * kstep;
            const char* a2 = last ? nA : cA + (size_t)(t + 2) * kstep; const char* b2 = last ? nB : cB + (size_t)(t + 2) * kstep;
            const char* a3 = a2 + kstep; const char* b3 = b2 + kstep;
            if (last && has_next) S.a_ready(nxt);
            if constexpr (SP2) {
            PG8_LDB(B0, 0, 0); PG8_LDB(B1, 0, 1); PG8_SCHED; PG8_LDA(At, 0, 0); PG8_STAGE(PG8_SA(1, 1), a1 + hstepA, voffA);
            PG8_WAIT_V(8); PG8_WAIT_L(0); PG8_BAR; PG8_MMA(0, 0, At, B0); PG8_MMA(0, 1, At, B1); PG8_BAR; PG8_SCHED;
            PG8_LDA(At, 0, 1); PG8_STAGE(PG8_SB(0, 0), b2, voffB); PG8_STAGE(PG8_SB(0, 1), b2 + hstepB, voffB); PG8_STAGE(PG8_SA(0, 0), a2, voffA);
            PG8_WAIT_V(8); PG8_WAIT_L(0); PG8_BAR; PG8_MMA(1, 0, At, B0); PG8_MMA(1, 1, At, B1); PG8_BAR; PG8_SCHED;
            PG8_LDB(B0, 1, 0); PG8_LDB(B1, 1, 1); PG8_SCHED; PG8_LDA(At, 1, 0); PG8_STAGE(PG8_SA(0, 1), a2 + hstepA, voffA);
            PG8_WAIT_V(8); PG8_WAIT_L(0); PG8_BAR; PG8_MMA(0, 0, At, B0); PG8_MMA(0, 1, At, B1); PG8_BAR; PG8_SCHED;
            PG8_LDA(At, 1, 1); PG8_STAGE(PG8_SB(1, 0), b3, voffB); PG8_STAGE(PG8_SB(1, 1), b3 + hstepB, voffB); PG8_STAGE(PG8_SA(1, 0), a3, voffA);
            PG8_WAIT_V(8); PG8_WAIT_L(0); PG8_BAR; PG8_MMA(1, 0, At, B0); PG8_MMA(1, 1, At, B1); PG8_BAR; PG8_SCHED;
            } else {
            PG8_LDB(B0, 0, 0); PG8_SCHED; PG8_LDA(At, 0, 0); PG8_STAGE(PG8_SA(1, 1), a1 + hstepA, voffA);
            PG8_WAIT_L(8); PG8_BAR; PG8_WAIT_L(0); PG8_MMA(0, 0, At, B0); PG8_BAR; PG8_SCHED;
            PG8_LDB(B1, 0, 1); PG8_STAGE(PG8_SB(0, 0), b2, voffB);
            PG8_BAR; PG8_WAIT_L(0); PG8_MMA(0, 1, At, B1); PG8_BAR;
            PG8_LDA(At, 0, 1); PG8_STAGE(PG8_SA(0, 0), a2, voffA);
            PG8_BAR; PG8_WAIT_L(0); PG8_MMA(1, 0, At, B0); PG8_BAR; PG8_SCHED;
            PG8_STAGE(PG8_SB(0, 1), b2 + hstepB, voffB);
            PG8_WAIT_V(6); PG8_BAR; PG8_MMA(1, 1, At, B1); PG8_BAR;
            PG8_LDB(B0, 1, 0); PG8_SCHED; PG8_LDA(At, 1, 0); PG8_STAGE(PG8_SA(0, 1), a2 + hstepA, voffA);
            PG8_WAIT_L(8); PG8_BAR; PG8_WAIT_L(0); PG8_MMA(0, 0, At, B0); PG8_BAR; PG8_SCHED;
            PG8_LDB(B1, 1, 1); PG8_STAGE(PG8_SB(1, 0), b3, voffB);
            PG8_BAR; PG8_WAIT_L(0); PG8_MMA(0, 1, At, B1); PG8_BAR;
            PG8_LDA(At, 1, 1); PG8_STAGE(PG8_SA(1, 0), a3, voffA);
            PG8_BAR; PG8_WAIT_L(0); PG8_MMA(1, 0, At, B0); PG8_BAR; PG8_SCHED;
            PG8_STAGE(PG8_SB(1, 1), b3 + hstepB, voffB);
            PG8_WAIT_V(6); PG8_BAR; PG8_MMA(1, 1, At, B1); PG8_BAR;
            }
        }
        if constexpr (ALIGN_EPI) { if (wr == 0) PG8_BAR; }
        if constexpr (!Epi::AFTER_DRAIN) { E(acc, cur, wr, wc, fr, fq); S.done(cur); }
        if (!has_next) break;
#pragma unroll
        for (int a = 0; a < 2; ++a)
#pragma unroll
            for (int b = 0; b < 2; ++b)
#pragma unroll
                for (int m = 0; m < 4; ++m)
#pragma unroll
                    for (int n = 0; n < 2; ++n) acc[a][b][m][n] = (f32x4){0.f, 0.f, 0.f, 0.f};
        cur = nxt; cA = nA; cB = nB; ++ui;
        if constexpr (ALIGN_EPI) { if (wr == 1) PG8_BAR; }
    }
    PG8_WAIT_V(0);
    if constexpr (!ALIGN_EPI) { if (wr == 0) PG8_BAR; }
    PG8_BAR;
    if constexpr (Epi::AFTER_DRAIN) { E.fused(acc, cur, wr, wc, fr, fq, lds, wid, lane); S.done(cur); }
#undef PG8_SA
#undef PG8_SB
#undef PG8_STAGE
#undef PG8_LDA
#undef PG8_LDB
#undef PG8_MMA
#undef PG8_WAIT_V
#undef PG8_WAIT_L
#undef PG8_BAR
#undef PG8_SCHED
}
}

namespace cg = cooperative_groups;
#define LAS __attribute__((address_space(3)))
typedef unsigned short bf16;
typedef short bf16x8 __attribute__((ext_vector_type(8)));
typedef short s16x4 __attribute__((ext_vector_type(4)));
typedef float f32x2 __attribute__((ext_vector_type(2)));
typedef float f32x4 __attribute__((ext_vector_type(4)));
typedef float f32x16 __attribute__((ext_vector_type(16)));
typedef unsigned u32x2 __attribute__((ext_vector_type(2)));
typedef unsigned u32x4 __attribute__((ext_vector_type(4)));
typedef __bf16 bf16x2_t __attribute__((ext_vector_type(2)));

constexpr int NB = 2, SEQ = 8192, T = NB * SEQ, DM = 2048;
constexpr float LOG2E = 1.4426950408889634f;
constexpr float NORM_EPS = 1e-6f;
constexpr int NTHREADS = 512, NWAVES = 8;
constexpr int LDS_BYTES = 160 * 1024;
constexpr float NEG_BIG = -1e30f;

constexpr size_t MiB = 1u << 20;
constexpr size_t WS_CTL = 0;
constexpr size_t WS_ROWSQ = 656 * MiB;
constexpr size_t WS_SW = 1 * MiB + 512 * 1024;
constexpr size_t WS_MOD = 1 * MiB;
constexpr size_t WS_TAB64 = 2 * MiB;
constexpr size_t WS_TAB128 = 4 * MiB;
constexpr size_t WS_BIAS1 = 8 * MiB;
constexpr size_t WS_SUBK = 9 * MiB;
constexpr size_t WS_W2T = 10 * MiB;
constexpr size_t WS_W1T = 11 * MiB;
constexpr size_t WS_WIN0 = 16 * MiB;
constexpr size_t WS_WOUT0 = 34 * MiB;
constexpr size_t WS_WIN1 = 42 * MiB;
constexpr size_t WS_WOUT1 = 57 * MiB;
constexpr size_t WS_WQ0 = 65 * MiB;
constexpr size_t WS_WQ1 = 73 * MiB;
constexpr size_t WS_SLOT = 81 * MiB;
constexpr size_t WS_U0 = 128 * MiB;
constexpr size_t WS_TAB = WS_U0;
constexpr size_t WS_TSCALE = WS_U0 + 128 * MiB;
constexpr size_t WS_H = 384 * MiB;
constexpr size_t WS_ATT = 448 * MiB;
constexpr size_t WS_QKV = 512 * MiB;
constexpr size_t WS_Q1 = 512 * MiB;
constexpr size_t WS_KSL = 576 * MiB;
constexpr size_t WS_VSL = 584 * MiB;
constexpr size_t WS_KW = 592 * MiB;
constexpr size_t WS_VW = 600 * MiB;
constexpr size_t WS_KCVC = 608 * MiB;
constexpr size_t WS_GATES = 626 * MiB;
constexpr size_t WS_HID = 630 * MiB;
constexpr size_t WS_KCMP = 633 * MiB;
constexpr size_t WS_VCMP = 634 * MiB;
constexpr size_t WS_Y = 576 * MiB;
constexpr size_t WS_XB = 656 * MiB;
constexpr size_t WS_END = 720 * MiB;

__device__ __forceinline__ unsigned cvtpk(float lo, float hi) { f32x2 v = {lo, hi}; bf16x2_t b = __builtin_convertvector(v, bf16x2_t); return __builtin_bit_cast(unsigned, b); }
__device__ __forceinline__ float bf2f(unsigned short b) { return __uint_as_float((unsigned)b << 16); }
__device__ __forceinline__ float bflo(unsigned w) { return __uint_as_float(w << 16); }
__device__ __forceinline__ float bfhi(unsigned w) { return __uint_as_float(w & 0xffff0000u); }
__device__ __forceinline__ float wave_sum(float v) {
#pragma unroll
    for (int o = 1; o < 64; o <<= 1) v += __shfl_xor(v, o);
    return v;
}
__device__ __forceinline__ float sum32(float v) {
    auto rr = __builtin_amdgcn_permlane32_swap(__float_as_uint(v), __float_as_uint(v), false, false);
    return __uint_as_float(rr[0]) + __uint_as_float(rr[1]);
}
__device__ __forceinline__ float max32(float v) {
    auto rr = __builtin_amdgcn_permlane32_swap(__float_as_uint(v), __float_as_uint(v), false, false);
    return fmaxf(__uint_as_float(rr[0]), __uint_as_float(rr[1]));
}
__device__ __forceinline__ float gelu_tanh(float x) {
    const float u = 0.7978845608028654f * (x + 0.044715f * x * x * x);
    const float e = __expf(2.f * u);
    const float th = 1.f - 2.f * __builtin_amdgcn_rcpf(e + 1.f);
    return 0.5f * x * (1.f + th);
}
__device__ __forceinline__ float sigmoidf_(float x) { return 1.f / (1.f + __expf(-x)); }
__device__ __forceinline__ float siluf_(float x) { return x / (1.f + __expf(-x)); }

#ifndef NT_ONCE
#define NT_ONCE 0
#endif
__device__ __forceinline__ void gemv_item(const LAS float* sv, int K, const float* W, int ldw, int col0, LAS float* red, float* out0, float* out1, const float* bias) {
    const int tid = threadIdx.x, lane = tid & 63, w = __builtin_amdgcn_readfirstlane(tid >> 6);
    const int kw = K / 8, kb = w * kw;
    float a00 = 0.f, a01 = 0.f, a10 = 0.f, a11 = 0.f;
    const float* wp = W + (size_t)kb * ldw + col0 + 2 * lane;
#pragma unroll 32
    for (int k = 0; k < kw; ++k) {
        const f32x2 wv = NT_ONCE ? __builtin_nontemporal_load((const f32x2*)(wp + (size_t)k * ldw)) : *(const f32x2*)(wp + (size_t)k * ldw);
        const float s0 = sv[kb + k], s1 = sv[K + kb + k];
        a00 += s0 * wv.x; a01 += s0 * wv.y; a10 += s1 * wv.x; a11 += s1 * wv.y;
    }
    red[(w * 2 + 0) * 128 + 2 * lane] = a00; red[(w * 2 + 0) * 128 + 2 * lane + 1] = a01;
    red[(w * 2 + 1) * 128 + 2 * lane] = a10; red[(w * 2 + 1) * 128 + 2 * lane + 1] = a11;
    __syncthreads();
    if (tid < 256) {
        const int v = tid >> 7, c = tid & 127; float s = 0.f;
#pragma unroll
        for (int ww = 0; ww < 8; ++ww) s += red[(ww * 2 + v) * 128 + c];
        if (bias) s += bias[col0 + c];
        (v == 0 ? out0 : out1)[col0 + c] = s;
    }
    __syncthreads();
}
__device__ __forceinline__ int rope64_pos(int n) { const int d = n & 63; return (n & ~63) | ((d < 32) ? 2 * d : 2 * (d - 32) + 1); }
__device__ __forceinline__ int rope128_pos(int n) { const int d = n & 127; return (n & ~127) | ((d < 64) ? 2 * d : 2 * (d - 64) + 1); }
__device__ __forceinline__ int dst_row(int mode, int n) {
    if (mode == 1) {
        if (n < 2048) return rope64_pos(n);
        if (n < 3072) return n;
        if (n < 4352) return rope64_pos(n);
        return n;
    }
    if (mode == 2) {
        if (n < 2048) return rope128_pos(n);
        if (n < 2560) return n;
        if (n < 2816) return rope128_pos(n);
        if (n < 3072) return n;
        if (n < 3328) return rope128_pos(n);
        return n;
    }
    if (mode == 3) return rope128_pos(n);
    return n;
}
__device__ __forceinline__ void transpose_item(const float* W, int K, int N, bf16* WT, int mode, LAS float* scr, int item, int lane) {
    const int nblk = (N + 31) / 32, kb = item / nblk, nb = item % nblk, k0 = 64 * kb, n0 = 32 * nb;
    const int nn = n0 + (lane & 31); const bool okn = nn < N;
    float tv[32];
#pragma unroll
    for (int i = 0; i < 32; ++i) { const int kk = 2 * i + (lane >> 5); tv[i] = okn ? (NT_ONCE ? __builtin_nontemporal_load(W + (size_t)(k0 + kk) * N + nn) : W[(size_t)(k0 + kk) * N + nn]) : 0.f; }
#pragma unroll
    for (int i = 0; i < 32; ++i) { const int kk = 2 * i + (lane >> 5); scr[kk * 33 + (lane & 31)] = tv[i]; }
    asm volatile("s_waitcnt lgkmcnt(0)" ::: "memory");
    const int c = lane & 7;
#pragma unroll
    for (int j = 0; j < 4; ++j) {
        const int nl = (lane >> 3) + 8 * j, n = n0 + nl; const LAS float* s = scr + (8 * c) * 33 + nl;
        u32x4 o; o.x = cvtpk(s[0 * 33], s[1 * 33]); o.y = cvtpk(s[2 * 33], s[3 * 33]); o.z = cvtpk(s[4 * 33], s[5 * 33]); o.w = cvtpk(s[6 * 33], s[7 * 33]);
        if (n < N) *(u32x4*)(WT + (size_t)dst_row(mode, n) * K + k0 + 8 * c) = o;
    }
    asm volatile("s_waitcnt lgkmcnt(0)" ::: "memory");
}

__device__ __forceinline__ void adaln_row(const float* xrow, const float* g, const float* mod, bf16* hrow, int lane) {
    f32x4 v[8]; float ss = 0.f;
#pragma unroll
    for (int j = 0; j < 4; ++j) {
        v[2 * j] = *(const f32x4*)(xrow + lane * 8 + 512 * j); v[2 * j + 1] = *(const f32x4*)(xrow + lane * 8 + 512 * j + 4);
        ss += v[2 * j].x * v[2 * j].x + v[2 * j].y * v[2 * j].y + v[2 * j].z * v[2 * j].z + v[2 * j].w * v[2 * j].w;
        ss += v[2 * j + 1].x * v[2 * j + 1].x + v[2 * j + 1].y * v[2 * j + 1].y + v[2 * j + 1].z * v[2 * j + 1].z + v[2 * j + 1].w * v[2 * j + 1].w;
    }
    const float r = 1.0f / sqrtf(wave_sum(ss) * (1.f / DM) + NORM_EPS);
#pragma unroll
    for (int j = 0; j < 4; ++j) {
        const int idx = lane * 8 + 512 * j;
        f32x4 o[2];
#pragma unroll
        for (int q = 0; q < 2; ++q) {
            const f32x4 gg = *(const f32x4*)(g + idx + 4 * q), sh = *(const f32x4*)(mod + idx + 4 * q), sc = *(const f32x4*)(mod + 2048 + idx + 4 * q);
            o[q] = v[2 * j + q] * r * gg * (1.f + sc) + sh;
        }
        u32x4 w; w.x = cvtpk(o[0].x, o[0].y); w.y = cvtpk(o[0].z, o[0].w); w.z = cvtpk(o[1].x, o[1].y); w.w = cvtpk(o[1].z, o[1].w);
        *(u32x4*)(hrow + idx) = w;
    }
}
__device__ __forceinline__ void adaln_row2(const float* xa, const float* xb, const float* g, const float* moda, const float* modb, bf16* ha, bf16* hb, int lane) {
    f32x4 va[8], vb[8]; float sa = 0.f, sb = 0.f;
#pragma unroll
    for (int j = 0; j < 8; ++j) { va[j] = *(const f32x4*)(xa + lane * 8 + 512 * (j >> 1) + 4 * (j & 1)); vb[j] = *(const f32x4*)(xb + lane * 8 + 512 * (j >> 1) + 4 * (j & 1)); }
#pragma unroll
    for (int j = 0; j < 8; ++j) { sa += va[j].x * va[j].x + va[j].y * va[j].y + va[j].z * va[j].z + va[j].w * va[j].w; sb += vb[j].x * vb[j].x + vb[j].y * vb[j].y + vb[j].z * vb[j].z + vb[j].w * vb[j].w; }
    const float ra = 1.0f / sqrtf(wave_sum(sa) * (1.f / DM) + NORM_EPS), rb = 1.0f / sqrtf(wave_sum(sb) * (1.f / DM) + NORM_EPS);
#pragma unroll
    for (int j = 0; j < 4; ++j) {
        const int idx = lane * 8 + 512 * j;
        f32x4 oa[2], ob[2];
#pragma unroll
        for (int q = 0; q < 2; ++q) {
            const f32x4 gg = *(const f32x4*)(g + idx + 4 * q);
            oa[q] = va[2 * j + q] * ra * gg * (1.f + *(const f32x4*)(moda + 2048 + idx + 4 * q)) + *(const f32x4*)(moda + idx + 4 * q);
            ob[q] = vb[2 * j + q] * rb * gg * (1.f + *(const f32x4*)(modb + 2048 + idx + 4 * q)) + *(const f32x4*)(modb + idx + 4 * q);
        }
        u32x4 w; w.x = cvtpk(oa[0].x, oa[0].y); w.y = cvtpk(oa[0].z, oa[0].w); w.z = cvtpk(oa[1].x, oa[1].y); w.w = cvtpk(oa[1].z, oa[1].w);
        *(u32x4*)(ha + idx) = w;
        w.x = cvtpk(ob[0].x, ob[0].y); w.y = cvtpk(ob[0].z, ob[0].w); w.z = cvtpk(ob[1].x, ob[1].y); w.w = cvtpk(ob[1].z, ob[1].w);
        *(u32x4*)(hb + idx) = w;
    }
}
__device__ __forceinline__ void adaln_row_bf(const bf16* xrow, const float* g, const float* mod, bf16* hrow, int lane) {
    f32x4 v[8]; float ss = 0.f;
#pragma unroll
    for (int j = 0; j < 4; ++j) {
        const u32x4 w = *(const u32x4*)(xrow + lane * 8 + 512 * j);
        v[2 * j] = (f32x4){bflo(w.x), bfhi(w.x), bflo(w.y), bfhi(w.y)}; v[2 * j + 1] = (f32x4){bflo(w.z), bfhi(w.z), bflo(w.w), bfhi(w.w)};
        ss += v[2 * j].x * v[2 * j].x + v[2 * j].y * v[2 * j].y + v[2 * j].z * v[2 * j].z + v[2 * j].w * v[2 * j].w;
        ss += v[2 * j + 1].x * v[2 * j + 1].x + v[2 * j + 1].y * v[2 * j + 1].y + v[2 * j + 1].z * v[2 * j + 1].z + v[2 * j + 1].w * v[2 * j + 1].w;
    }
    const float r = 1.0f / sqrtf(wave_sum(ss) * (1.f / DM) + NORM_EPS);
#pragma unroll
    for (int j = 0; j < 4; ++j) {
        const int idx = lane * 8 + 512 * j;
        f32x4 o[2];
#pragma unroll
        for (int q = 0; q < 2; ++q) {
            const f32x4 gg = *(const f32x4*)(g + idx + 4 * q), sh = *(const f32x4*)(mod + idx + 4 * q), sc = *(const f32x4*)(mod + 2048 + idx + 4 * q);
            o[q] = v[2 * j + q] * r * gg * (1.f + sc) + sh;
        }
        u32x4 w; w.x = cvtpk(o[0].x, o[0].y); w.y = cvtpk(o[0].z, o[0].w); w.z = cvtpk(o[1].x, o[1].y); w.w = cvtpk(o[1].z, o[1].w);
        *(u32x4*)(hrow + idx) = w;
    }
}
__device__ __forceinline__ void final_row(const float* xrow, const float* g, float* orow, int lane) {
    f32x4 v[8]; float ss = 0.f;
#pragma unroll
    for (int j = 0; j < 8; ++j) { v[j] = *(const f32x4*)(xrow + lane * 8 + 512 * (j >> 1) + 4 * (j & 1)); ss += v[j].x * v[j].x + v[j].y * v[j].y + v[j].z * v[j].z + v[j].w * v[j].w; }
    const float r = 1.0f / sqrtf(wave_sum(ss) * (1.f / DM) + NORM_EPS);
#pragma unroll
    for (int j = 0; j < 8; ++j) { const int idx = lane * 8 + 512 * (j >> 1) + 4 * (j & 1); const f32x4 gg = *(const f32x4*)(g + idx); *(f32x4*)(orow + idx) = v[j] * r * gg; }
}

#define EPI_ROWS_BEGIN _Pragma("unroll") for (int ai = 0; ai < 2; ++ai) { _Pragma("unroll") for (int m = 0; m < 4; ++m) { const int row = u.pm * 256 + wr * 64 + fr + ai * 128 + m * 16; _Pragma("unroll") for (int bj = 0; bj < 2; ++bj) { \
        const int col = u.pn * 256 + bj * 128 + wc * 32 + 8 * fq; f32x4 v0 = acc[ai][bj][m][0], v1 = acc[ai][bj][m][1];
#define EPI_ROWS_END } } }
#define EPI_HALVES _Pragma("unroll") for (int ai = 0; ai < 2; ++ai)
#define EPI_CHUNKS _Pragma("unroll") for (int m = 0; m < 4; ++m) _Pragma("unroll") for (int bj = 0; bj < 2; ++bj)
#define EPI_RC const int ci = m * 2 + bj, row = u.pm * 256 + wr * 64 + fr + ai * 128 + m * 16, col = u.pn * 256 + bj * 128 + wc * 32 + 8 * fq; (void)ci;
#ifndef EPI_BATCH
#define EPI_BATCH 1
#endif
__device__ __forceinline__ void rope8t(f32x4& v0, f32x4& v1, const f32x4& t0, const f32x4& t1) {
    f32x4 a, b;
    a.x = v0.x * t0.x - v0.y * t0.y; a.y = v0.y * t0.x + v0.x * t0.y;
    a.z = v0.z * t0.z - v0.w * t0.w; a.w = v0.w * t0.z + v0.z * t0.w;
    b.x = v1.x * t1.x - v1.y * t1.y; b.y = v1.y * t1.x + v1.x * t1.y;
    b.z = v1.z * t1.z - v1.w * t1.w; b.w = v1.w * t1.z + v1.z * t1.w;
    v0 = a; v1 = b;
}
__device__ __forceinline__ void rope8(f32x4& v0, f32x4& v1, const f32x2* tab) {
    const f32x4 t0 = *(const f32x4*)tab, t1 = *(const f32x4*)(tab + 2);
    f32x4 a, b;
    a.x = v0.x * t0.x - v0.y * t0.y; a.y = v0.y * t0.x + v0.x * t0.y;
    a.z = v0.z * t0.z - v0.w * t0.w; a.w = v0.w * t0.z + v0.z * t0.w;
    b.x = v1.x * t1.x - v1.y * t1.y; b.y = v1.y * t1.x + v1.x * t1.y;
    b.z = v1.z * t1.z - v1.w * t1.w; b.w = v1.w * t1.z + v1.z * t1.w;
    v0 = a; v1 = b;
}
__device__ __forceinline__ u32x4 pack8(const f32x4& v0, const f32x4& v1) { u32x4 w; w.x = cvtpk(v0.x, v0.y); w.y = cvtpk(v0.z, v0.w); w.z = cvtpk(v1.x, v1.y); w.w = cvtpk(v1.z, v1.w); return w; }

constexpr float QSCALE64 = 0.125f * LOG2E;
constexpr float QSCALE128 = 0.08838834764831845f * LOG2E;

struct EpiQKV0 {
    static constexpr bool PERM = true, AFTER_DRAIN = false;
    bf16* out; const f32x2* tab64;
    __device__ __forceinline__ void operator()(const f32x4 (&acc)[2][2][4][2], const pg8::Unit& u, int wr, int wc, int fr, int fq) const {
        const int pn = u.pn;
        const bool rope = (pn < 8) || (pn >= 12 && pn < 17);
        const float sc = (pn < 4 || (pn >= 12 && pn < 16)) ? QSCALE64 : 1.f;
#if EPI_BATCH
        EPI_HALVES {
            f32x4 t0[8], t1[8];
            if (rope) {
                EPI_CHUNKS { EPI_RC const f32x2* tp = tab64 + (size_t)(row & (SEQ - 1)) * 32 + ((col & 63) >> 1); t0[ci] = *(const f32x4*)tp; t1[ci] = *(const f32x4*)(tp + 2); }
#pragma unroll
                for (int c8 = 0; c8 < 8; ++c8) { asm volatile("" : "+v"(t0[c8])); asm volatile("" : "+v"(t1[c8])); }
            }
            EPI_CHUNKS { EPI_RC f32x4 v0 = acc[ai][bj][m][0], v1 = acc[ai][bj][m][1];
                if (rope) rope8t(v0, v1, t0[ci], t1[ci]);
                v0 = v0 * sc; v1 = v1 * sc;
                *(u32x4*)(out + (size_t)row * 4608 + col) = pack8(v0, v1); }
        }
#else
        EPI_ROWS_BEGIN
            if (rope) rope8(v0, v1, tab64 + (size_t)(row & (SEQ - 1)) * 32 + ((col & 63) >> 1));
            v0 = v0 * sc; v1 = v1 * sc;
            *(u32x4*)(out + (size_t)row * 4608 + col) = pack8(v0, v1);
        EPI_ROWS_END
#endif
    }
};
struct EpiQKV1 {
    static constexpr bool PERM = true, AFTER_DRAIN = false;
    unsigned char* ws; const f32x2* tab128;
    __device__ __forceinline__ void operator()(const f32x4 (&acc)[2][2][4][2], const pg8::Unit& u, int wr, int wc, int fr, int fq) const {
        const int pn = u.pn;
        const bool rope = (pn < 8) || pn == 10 || pn == 12;
#if EPI_BATCH
        EPI_HALVES {
            f32x4 t0[8], t1[8];
            if (rope) {
                EPI_CHUNKS { EPI_RC const f32x2* tp = tab128 + (size_t)(row & (SEQ - 1)) * 64 + ((col & 127) >> 1); t0[ci] = *(const f32x4*)tp; t1[ci] = *(const f32x4*)(tp + 2); }
#pragma unroll
                for (int c8 = 0; c8 < 8; ++c8) { asm volatile("" : "+v"(t0[c8])); asm volatile("" : "+v"(t1[c8])); }
            }
            EPI_CHUNKS { EPI_RC f32x4 v0 = acc[ai][bj][m][0], v1 = acc[ai][bj][m][1];
            if (rope) rope8t(v0, v1, t0[ci], t1[ci]);
            if (pn < 8) { v0 = v0 * QSCALE128; v1 = v1 * QSCALE128; *(u32x4*)((bf16*)(ws + WS_Q1) + (size_t)row * 2048 + col) = pack8(v0, v1); }
            else if (pn < 10) {
                const int c = col & 255, h = c >> 7, d0 = c & 127, b = row >> 13, s = row & (SEQ - 1);
                *(u32x4*)((bf16*)(ws + WS_KCVC) + ((((size_t)(pn - 8) * 2 + b) * 2 + h) * SEQ + s) * 128 + d0) = pack8(v0, v1);
            } else if (pn < 14) {
                const size_t off = (pn == 10) ? WS_KSL : (pn == 11) ? WS_VSL : (pn == 12) ? WS_KW : WS_VW;
                *(u32x4*)((bf16*)(ws + off) + (size_t)row * 256 + (col & 255)) = pack8(v0, v1);
            } else {
                const int c = col - 3584;
                if (c < 48) { float* gp = (float*)(ws + WS_GATES) + (size_t)row * 48 + c;
                    f32x4 a, b2; a.x = sigmoidf_(v0.x); a.y = sigmoidf_(v0.y); a.z = sigmoidf_(v0.z); a.w = sigmoidf_(v0.w);
                    b2.x = sigmoidf_(v1.x); b2.y = sigmoidf_(v1.y); b2.z = sigmoidf_(v1.z); b2.w = sigmoidf_(v1.w);
                    *(f32x4*)gp = a; *(f32x4*)(gp + 4) = b2; }
            }
            }
        }
#else
        EPI_ROWS_BEGIN
            if (rope) rope8(v0, v1, tab128 + (size_t)(row & (SEQ - 1)) * 64 + ((col & 127) >> 1));
            if (pn < 8) { v0 = v0 * QSCALE128; v1 = v1 * QSCALE128; *(u32x4*)((bf16*)(ws + WS_Q1) + (size_t)row * 2048 + col) = pack8(v0, v1); }
            else if (pn < 10) {
                const int c = col & 255, h = c >> 7, d0 = c & 127, b = row >> 13, s = row & (SEQ - 1);
                *(u32x4*)((bf16*)(ws + WS_KCVC) + ((((size_t)(pn - 8) * 2 + b) * 2 + h) * SEQ + s) * 128 + d0) = pack8(v0, v1);
            } else if (pn < 14) {
                const size_t off = (pn == 10) ? WS_KSL : (pn == 11) ? WS_VSL : (pn == 12) ? WS_KW : WS_VW;
                *(u32x4*)((bf16*)(ws + off) + (size_t)row * 256 + (col & 255)) = pack8(v0, v1);
            } else {
                const int c = col - 3584;
                if (c < 48) { float* gp = (float*)(ws + WS_GATES) + (size_t)row * 48 + c;
                    f32x4 a, b2; a.x = sigmoidf_(v0.x); a.y = sigmoidf_(v0.y); a.z = sigmoidf_(v0.z); a.w = sigmoidf_(v0.w);
                    b2.x = sigmoidf_(v1.x); b2.y = sigmoidf_(v1.y); b2.z = sigmoidf_(v1.z); b2.w = sigmoidf_(v1.w);
                    *(f32x4*)gp = a; *(f32x4*)(gp + 4) = b2; }
            }
        EPI_ROWS_END
#endif
    }
};
struct EpiGate {
    static constexpr bool PERM = true, AFTER_DRAIN = false;
    bf16* y; const float* gate;
    __device__ __forceinline__ void operator()(const f32x4 (&acc)[2][2][4][2], const pg8::Unit& u, int wr, int wc, int fr, int fq) const {
        EPI_ROWS_BEGIN
            const float* gp = gate + (size_t)(row >> 13) * 6144 + col;
            const f32x4 g0 = *(const f32x4*)gp, g1 = *(const f32x4*)(gp + 4);
            *(u32x4*)(y + (size_t)row * 2048 + col) = pack8(g0 * v0, g1 * v1);
        EPI_ROWS_END
    }
};
template <bool XOLD_F32>
struct EpiResid {
    static constexpr bool PERM = true, AFTER_DRAIN = false;
    const void* xold; bf16* xnew; const float* gate;
    __device__ __forceinline__ void operator()(const f32x4 (&acc)[2][2][4][2], const pg8::Unit& u, int wr, int wc, int fr, int fq) const {
#if EPI_BATCH
        const float* gp0 = gate + (size_t)((u.pm * 256) >> 13) * 6144 + u.pn * 256 + wc * 32 + 8 * fq;
        f32x4 gg[2][2];
#pragma unroll
        for (int bj = 0; bj < 2; ++bj) { gg[bj][0] = *(const f32x4*)(gp0 + bj * 128); gg[bj][1] = *(const f32x4*)(gp0 + bj * 128 + 4); }
        EPI_HALVES {
            if (XOLD_F32) {
                f32x4 x0[8], x1[8];
                EPI_CHUNKS { EPI_RC const float* xp = (const float*)xold + (size_t)row * 2048 + col; x0[ci] = *(const f32x4*)xp; x1[ci] = *(const f32x4*)(xp + 4); }
#pragma unroll
                for (int c8 = 0; c8 < 8; ++c8) { asm volatile("" : "+v"(x0[c8])); asm volatile("" : "+v"(x1[c8])); }
                EPI_CHUNKS { EPI_RC const f32x4 v0 = acc[ai][bj][m][0], v1 = acc[ai][bj][m][1];
                    *(u32x4*)(xnew + (size_t)row * 2048 + col) = pack8(x0[ci] + gg[bj][0] * v0, x1[ci] + gg[bj][1] * v1); }
            } else {
                u32x4 xw[8];
                EPI_CHUNKS { EPI_RC xw[ci] = *(const u32x4*)((const bf16*)xold + (size_t)row * 2048 + col); }
#pragma unroll
                for (int c8 = 0; c8 < 8; ++c8) asm volatile("" : "+v"(xw[c8]));
                EPI_CHUNKS { EPI_RC const f32x4 v0 = acc[ai][bj][m][0], v1 = acc[ai][bj][m][1]; const u32x4 w = xw[ci];
                    const f32x4 x0 = {bflo(w.x), bfhi(w.x), bflo(w.y), bfhi(w.y)}, x1 = {bflo(w.z), bfhi(w.z), bflo(w.w), bfhi(w.w)};
                    *(u32x4*)(xnew + (size_t)row * 2048 + col) = pack8(x0 + gg[bj][0] * v0, x1 + gg[bj][1] * v1); }
            }
        }
#else
        EPI_ROWS_BEGIN
            const float* gp = gate + (size_t)(row >> 13) * 6144 + col;
            const f32x4 g0 = *(const f32x4*)gp, g1 = *(const f32x4*)(gp + 4);
            f32x4 x0, x1;
            if (XOLD_F32) { const float* xp = (const float*)xold + (size_t)row * 2048 + col; x0 = *(const f32x4*)xp; x1 = *(const f32x4*)(xp + 4); }
            else { const u32x4 w = *(const u32x4*)((const bf16*)xold + (size_t)row * 2048 + col); x0 = (f32x4){bflo(w.x), bfhi(w.x), bflo(w.y), bfhi(w.y)}; x1 = (f32x4){bflo(w.z), bfhi(w.z), bflo(w.w), bfhi(w.w)}; }
            *(u32x4*)(xnew + (size_t)row * 2048 + col) = pack8(x0 + g0 * v0, x1 + g1 * v1);
        EPI_ROWS_END
#endif
    }
};
#ifndef QNT
#define QNT 0
#endif
struct EpiPlain {
    static constexpr bool PERM = true, AFTER_DRAIN = false;
    bf16* out; int ld;
    __device__ __forceinline__ void operator()(const f32x4 (&acc)[2][2][4][2], const pg8::Unit& u, int wr, int wc, int fr, int fq) const {
        EPI_ROWS_BEGIN
#if QNT
            __builtin_nontemporal_store(pack8(v0, v1), (u32x4*)(out + (size_t)row * ld + col));
#else
            *(u32x4*)(out + (size_t)row * ld + col) = pack8(v0, v1);
#endif
        EPI_ROWS_END
    }
};
struct EpiCmp1 {
    static constexpr bool PERM = true, AFTER_DRAIN = false;
    bf16* hid; const float* bias1;
    __device__ __forceinline__ void operator()(const f32x4 (&acc)[2][2][4][2], const pg8::Unit& u, int wr, int wc, int fr, int fq) const {
        EPI_ROWS_BEGIN
            const int c = col & 255; const float* bp = bias1 + u.pn * 256 + c;
            const f32x4 b0 = *(const f32x4*)bp, b1 = *(const f32x4*)(bp + 4);
            v0 = v0 + b0; v1 = v1 + b1;
            v0.x = gelu_tanh(v0.x); v0.y = gelu_tanh(v0.y); v0.z = gelu_tanh(v0.z); v0.w = gelu_tanh(v0.w);
            v1.x = gelu_tanh(v1.x); v1.y = gelu_tanh(v1.y); v1.z = gelu_tanh(v1.z); v1.w = gelu_tanh(v1.w);
            *(u32x4*)(hid + (size_t)row * 256 + c) = pack8(v0, v1);
        EPI_ROWS_END
    }
};
struct EpiCmp2 {
    static constexpr bool PERM = true, AFTER_DRAIN = false;
    bf16* kcmp; bf16* vcmp; const f32x2* tab128;
    __device__ __forceinline__ void operator()(const f32x4 (&acc)[2][2][4][2], const pg8::Unit& u, int wr, int wc, int fr, int fq) const {
        EPI_ROWS_BEGIN
            const int c = col & 255;
            if (c < 128) {
                const int r = row & 2047;
                if (u.pn == 0) { int pos = 16 * (r & 511) + 31; pos = pos > SEQ - 1 ? SEQ - 1 : pos; rope8(v0, v1, tab128 + (size_t)pos * 64 + (c >> 1)); }
                *(u32x4*)((u.pn == 0 ? kcmp : vcmp) + (size_t)r * 128 + c) = pack8(v0, v1);
            }
        EPI_ROWS_END
    }
};
struct CmpOrder {
    int c;
    __device__ __forceinline__ bool next(int i, pg8::Unit& u) const { if (i > 0 || c >= 16) return false; u.pm = c; u.pn = c >> 3; return true; }
    __device__ __forceinline__ void a_ready(const pg8::Unit&) const {}
    __device__ __forceinline__ void done(const pg8::Unit&) const {}
};

__device__ __forceinline__ int crow(int r, int hi) { return (r & 3) + 8 * (r >> 2) + 4 * hi; }
__device__ __forceinline__ float max3f(float a, float b, float c) { float r; asm("v_max3_f32 %0, %1, %2, %3" : "=v"(r) : "v"(a), "v"(b), "v"(c)); return r; }
__device__ __forceinline__ float max2f(float a, float b) { float r; asm("v_max_f32_e32 %0, %1, %2" : "=v"(r) : "v"(a), "v"(b)); return r; }
constexpr float RESCALE_THR = 8.0f;
typedef short v4i16_t __attribute__((ext_vector_type(4)));

template <int DQK, int DV> struct AT {
    static constexpr int KP = DQK + 8, VP = DV + 32;
    static constexpr int KBYTES = 64 * KP * 2, VBYTES = 64 * VP * 2;
    static constexpr int KCH = 64 * DQK / 8 / NTHREADS, VCH = 64 * DV / 8 / NTHREADS;
    static constexpr int KOFF = 0, VOFF = KBYTES;
    static constexpr int BYTES = KBYTES + VBYTES;
};

template <int DX, int NCH>
__device__ __forceinline__ void tile_load(u32x4 (&reg)[NCH], const bf16* g, int pitch, int key0, int kmax, int tid) {
    asm volatile("" : "+v"(tid));
#pragma unroll
    for (int i = 0; i < NCH; ++i) {
        const int id = tid + NTHREADS * i, row = id / (DX / 8), ch = id % (DX / 8);
        int key = key0 + row; key = key < 0 ? 0 : (key > kmax ? kmax : key);
        reg[i] = *(const u32x4*)(g + (size_t)key * pitch + ch * 8);
    }
}
template <int DX, int NCH, int PITCH = DX + 8>
__device__ __forceinline__ void tile_store(const u32x4 (&reg)[NCH], LAS unsigned char* l, int tid) {
    asm volatile("" : "+v"(tid));
#pragma unroll
    for (int i = 0; i < NCH; ++i) {
        const int id = tid + NTHREADS * i, row = id / (DX / 8), ch = id % (DX / 8);
        *(LAS u32x4*)(l + (row * PITCH + ch * 8) * 2) = reg[i];
    }
}
__device__ __forceinline__ void glds16(const void* gsrc, unsigned lds_dst) { unsigned keep;
    asm volatile("s_mov_b32 %0, m0\n\ts_mov_b32 m0, %2\n\ts_nop 0\n\tglobal_load_lds_dwordx4 %1, off\n\ts_mov_b32 m0, %0" : "=&s"(keep) : "v"(gsrc), "s"(lds_dst) : "memory"); }
template <int PITCH> struct DmaN { static constexpr int CPR = PITCH / 8, NI = 64 * CPR / 64, NIW = (NI + 7) / 8; static_assert((64 * PITCH * 2) % 1024 == 0, "tile image must be whole 1 KiB pieces"); };
template <int DX, int PITCH>
__device__ __forceinline__ void tile_dma(const bf16* g, int pitch, int key0, int kmax, unsigned lds_tile, unsigned lds_dump, int wave, int lane) {
    typedef DmaN<PITCH> D;
#pragma unroll
    for (int j = 0; j < D::NIW; ++j) {
        const int idx = j * 8 + wave; const bool ok = idx < D::NI;
        const int gch = (ok ? idx : 0) * 64 + lane, row = gch / D::CPR, ch = gch % D::CPR;
        int key = key0 + row; key = key < 0 ? 0 : (key > kmax ? kmax : key);
        const bf16* src = g + (size_t)key * pitch + (ch < DX / 8 ? ch : 0) * 8;
        glds16(src, (unsigned)__builtin_amdgcn_readfirstlane((int)(ok ? lds_tile + (unsigned)idx * 1024u : lds_dump)));
    }
}
template <int N> __device__ __forceinline__ void wait_bar() { asm volatile("s_waitcnt vmcnt(%0) lgkmcnt(0)\n\ts_barrier" :: "i"(N) : "memory"); }
__device__ __forceinline__ unsigned lds_addr(const LAS unsigned char* p) { return (unsigned)(__UINTPTR_TYPE__)p; }
template <int DQK, bool QL = false>
__device__ __forceinline__ void qk_tile(const LAS unsigned char* kl, const bf16x8 (&qf)[QL ? 1 : DQK / 16], f32x16& s0, f32x16& s1, int lane, const LAS unsigned char* ql = nullptr) {
    const int r32 = lane & 31, hi = lane >> 5;
    const LAS unsigned char* p = kl + (r32 * (DQK + 8) + hi * 8) * 2;
#pragma unroll
    for (int i = 0; i < 16; ++i) { s0[i] = 0.f; s1[i] = 0.f; }
#pragma unroll
    for (int sg = 0; sg < DQK / 64; ++sg) {
        bf16x8 a0[4], a1[4];
#pragma unroll
        for (int st = 0; st < 4; ++st) { a0[st] = *(const LAS bf16x8*)(p + (sg * 4 + st) * 32); a1[st] = *(const LAS bf16x8*)(p + 32 * (DQK + 8) * 2 + (sg * 4 + st) * 32); }
        __builtin_amdgcn_s_setprio(1);
#pragma unroll
        for (int st = 0; st < 4; ++st) {
            const bf16x8 qv = QL ? *(const LAS bf16x8*)(ql + (sg * 4 + st) * 32) : qf[QL ? 0 : sg * 4 + st];
            s0 = __builtin_amdgcn_mfma_f32_32x32x16_bf16(a0[st], qv, s0, 0, 0, 0);
            s1 = __builtin_amdgcn_mfma_f32_32x32x16_bf16(a1[st], qv, s1, 0, 0, 0);
        }
        __builtin_amdgcn_s_setprio(0);
        if (DQK > 64) __builtin_amdgcn_sched_barrier(0);
    }
}
__device__ __forceinline__ bf16x8 pfrag(const f32x16& p, int s) {
    u32x4 w; w.x = cvtpk(p[8 * s + 0], p[8 * s + 1]); w.y = cvtpk(p[8 * s + 2], p[8 * s + 3]); w.z = cvtpk(p[8 * s + 4], p[8 * s + 5]); w.w = cvtpk(p[8 * s + 6], p[8 * s + 7]);
    return __builtin_bit_cast(bf16x8, w);
}
template <int DV>
__device__ __forceinline__ void pv_tile(const LAS unsigned char* vl, const f32x16& p0, const f32x16& p1, f32x16 (&O)[DV / 32], int lane) {
    const int hi = lane >> 5, g1 = (lane >> 4) & 1, i = lane & 15, q = i >> 2, pp = i & 3;
    const LAS unsigned char* vb = vl + ((4 * hi + q) * (DV + 32) + 16 * g1 + 4 * pp) * 2;
    v4i16_t lo[2][DV / 32], hh[2][DV / 32];
#pragma unroll
    for (int dt = 0; dt < DV / 32; ++dt) { lo[0][dt] = __builtin_amdgcn_ds_read_tr16_b64_v4i16((LAS v4i16_t*)(vb + dt * 64)); hh[0][dt] = __builtin_amdgcn_ds_read_tr16_b64_v4i16((LAS v4i16_t*)(vb + dt * 64 + 8 * (DV + 32) * 2)); }
#pragma unroll
    for (int ks = 0; ks < 4; ++ks) {
        const bf16x8 pf = pfrag((ks & 2) ? p1 : p0, ks & 1);
        if (ks < 3) {
#pragma unroll
            for (int dt = 0; dt < DV / 32; ++dt) { const LAS unsigned char* a = vb + (16 * (ks + 1)) * (DV + 32) * 2 + dt * 64;
                lo[(ks + 1) & 1][dt] = __builtin_amdgcn_ds_read_tr16_b64_v4i16((LAS v4i16_t*)a); hh[(ks + 1) & 1][dt] = __builtin_amdgcn_ds_read_tr16_b64_v4i16((LAS v4i16_t*)(a + 8 * (DV + 32) * 2)); }
        }
        __builtin_amdgcn_s_setprio(1);
#pragma unroll
        for (int dt = 0; dt < DV / 32; ++dt) {
            const bf16x8 vf = __builtin_shufflevector(lo[ks & 1][dt], hh[ks & 1][dt], 0, 1, 2, 3, 4, 5, 6, 7);
            O[dt] = __builtin_amdgcn_mfma_f32_32x32x16_bf16(vf, pf, O[dt], 0, 0, 0);
        }
        __builtin_amdgcn_s_setprio(0);
        __builtin_amdgcn_sched_barrier(0);
    }
}
struct MaskCausal { int tpos; __device__ __forceinline__ bool full(int k0, bool) const { return k0 + 63 <= tpos; } __device__ __forceinline__ bool prep(int k0) const { return k0 <= tpos; } __device__ __forceinline__ bool valid(int k, bool) const { return k <= tpos; } };
struct MaskWindow { int tpos, w; __device__ __forceinline__ bool full(int k0, bool) const { return k0 + 63 <= tpos && k0 > tpos - w; } __device__ __forceinline__ bool prep(int k0) const { return k0 <= tpos && k0 + 63 > tpos - w; } __device__ __forceinline__ bool valid(int k, bool) const { return k <= tpos && k > tpos - w; } };
struct MaskCmp { int cmax; __device__ __forceinline__ bool full(int k0, bool) const { return k0 + 63 <= cmax; } __device__ __forceinline__ bool prep(int k0) const { return k0 <= cmax; } __device__ __forceinline__ bool valid(int k, bool) const { return k <= cmax; } };
struct MaskSel { int tpos; unsigned long long lo, hi2;
    __device__ __forceinline__ bool prep(int k0) const { const int j = k0 >> 6; return k0 <= tpos && (((j < 64 ? (lo >> j) : (hi2 >> (j - 64))) & 1ull) != 0ull); }
    __device__ __forceinline__ bool full(int k0, bool act) const { return act && k0 + 63 <= tpos; }
    __device__ __forceinline__ bool valid(int k, bool act) const { return act && k <= tpos; } };

template <class M> __device__ __forceinline__ float mask_tile(f32x16& s0, f32x16& s1, int key0, const M& mk, bool act, int lane) {
    const int hi = lane >> 5; float mx = -INFINITY;
    if (__all(mk.full(key0, act))) {
#pragma unroll
        for (int r = 0; r < 16; ++r) mx = max3f(mx, s0[r], s1[r]);
        return mx;
    }
#pragma unroll
    for (int r = 0; r < 16; ++r) {
        const int k = key0 + crow(r, hi);
        s0[r] = mk.valid(k, act) ? s0[r] : -INFINITY; s1[r] = mk.valid(k + 32, act) ? s1[r] : -INFINITY;
        mx = max3f(mx, s0[r], s1[r]);
    }
    return mx;
}
template <int DV> __device__ __forceinline__ void online_update(f32x16& s0, f32x16& s1, float mx, float& m, float& l, f32x16 (&O)[DV / 32]) {
    mx = max32(mx);
    const float mn = (mx - m > RESCALE_THR) ? mx : m, alpha = __builtin_amdgcn_exp2f(m - mn);
    float ps = 0.f;
#pragma unroll
    for (int r = 0; r < 16; ++r) { s0[r] = __builtin_amdgcn_exp2f(s0[r] - mn); s1[r] = __builtin_amdgcn_exp2f(s1[r] - mn); ps += s0[r] + s1[r]; }
    l = l * alpha + ps; m = mn;
    if (__any(alpha != 1.f)) {
#pragma unroll
        for (int dt = 0; dt < DV / 32; ++dt)
#pragma unroll
            for (int r = 0; r < 16; ++r) O[dt][r] *= alpha;
    }
}

template <int DQK, bool QL>
__device__ __forceinline__ void qk_half(const LAS unsigned char* kl, const bf16x8 (&qf)[QL ? 1 : DQK / 16], f32x16& s, int kt, int lane, const LAS unsigned char* ql) {
    const int r32 = lane & 31, hi = lane >> 5;
    const LAS unsigned char* p = kl + ((kt * 32 + r32) * (DQK + 8) + hi * 8) * 2;
#pragma unroll
    for (int i = 0; i < 16; ++i) s[i] = 0.f;
#pragma unroll
    for (int sg = 0; sg < DQK / 64; ++sg) {
        bf16x8 a0[4];
#pragma unroll
        for (int st = 0; st < 4; ++st) a0[st] = *(const LAS bf16x8*)(p + (sg * 4 + st) * 32);
        __builtin_amdgcn_s_setprio(1);
#pragma unroll
        for (int st = 0; st < 4; ++st) { const bf16x8 qv = QL ? *(const LAS bf16x8*)(ql + (sg * 4 + st) * 32) : qf[QL ? 0 : sg * 4 + st]; s = __builtin_amdgcn_mfma_f32_32x32x16_bf16(a0[st], qv, s, 0, 0, 0); }
        __builtin_amdgcn_s_setprio(0);
        if (DQK > 64) __builtin_amdgcn_sched_barrier(0);
    }
}
template <class M> __device__ __forceinline__ float mask_half(f32x16& s, int key0, const M& mk, bool act, int lane, bool allfull) {
    const int hi = lane >> 5; float mx = -INFINITY;
    if (allfull) {
#pragma unroll
        for (int r = 0; r < 16; r += 2) mx = max3f(mx, s[r], s[r + 1]);
        return mx;
    }
#pragma unroll
    for (int r = 0; r < 16; ++r) { const int k = key0 + crow(r, hi); s[r] = mk.valid(k, act) ? s[r] : -INFINITY; mx = fmaxf(mx, s[r]); }
    return mx;
}
template <int DV> __device__ __forceinline__ void online_half(f32x16& s, float mx, float& m, float& l, f32x16 (&O)[DV / 32]) {
    mx = max32(mx);
    const float mn = (mx - m > RESCALE_THR) ? mx : m, alpha = __builtin_amdgcn_exp2f(m - mn);
    float ps = 0.f;
#pragma unroll
    for (int r = 0; r < 16; ++r) { s[r] = __builtin_amdgcn_exp2f(s[r] - mn); ps += s[r]; }
    l = l * alpha + ps; m = mn;
    if (__any(alpha != 1.f)) {
#pragma unroll
        for (int dt = 0; dt < DV / 32; ++dt)
#pragma unroll
            for (int r = 0; r < 16; ++r) O[dt][r] *= alpha;
    }
}
template <int DV>
__device__ __forceinline__ void pv_half(const LAS unsigned char* vl, const f32x16& p, int kt, f32x16 (&O)[DV / 32], int lane) {
    const int hi = lane >> 5, g1 = (lane >> 4) & 1, i = lane & 15, q = i >> 2, pp = i & 3;
    const LAS unsigned char* vb = vl + ((kt * 32 + 4 * hi + q) * (DV + 32) + 16 * g1 + 4 * pp) * 2;
#pragma unroll
    for (int ks = 0; ks < 2; ++ks) {
        const bf16x8 pf = pfrag(p, ks);
        v4i16_t lo[DV / 32], hh[DV / 32];
#pragma unroll
        for (int dt = 0; dt < DV / 32; ++dt) { const LAS unsigned char* a = vb + (16 * ks) * (DV + 32) * 2 + dt * 64;
            lo[dt] = __builtin_amdgcn_ds_read_tr16_b64_v4i16((LAS v4i16_t*)a); hh[dt] = __builtin_amdgcn_ds_read_tr16_b64_v4i16((LAS v4i16_t*)(a + 8 * (DV + 32) * 2)); }
        __builtin_amdgcn_s_setprio(1);
#pragma unroll
        for (int dt = 0; dt < DV / 32; ++dt) { const bf16x8 vf = __builtin_shufflevector(lo[dt], hh[dt], 0, 1, 2, 3, 4, 5, 6, 7); O[dt] = __builtin_amdgcn_mfma_f32_32x32x16_bf16(vf, pf, O[dt], 0, 0, 0); }
        __builtin_amdgcn_s_setprio(0);
        if (DV > 64) __builtin_amdgcn_sched_barrier(0);
    }
}
template <int DQK, int DV, class M, bool SPLIT = false, int TPS = 1, int NSLOT = 3>
__device__ __forceinline__ void attn_run(LAS unsigned char* lds, const bf16* Kg, int kpitch, const bf16* Vg, int vpitch, int kmax, int t_lo, int t_hi,
                                         const bf16x8 (&qf)[DQK / 16], f32x16 (&O)[DV / 32], float& m, float& l, const M& mk) {
    typedef AT<DQK, DV> A;
    constexpr int NT = (DmaN<A::KP>::NIW + DmaN<A::VP>::NIW) * TPS;
    constexpr int SB = A::BYTES * TPS;
    const int tid = threadIdx.x, lane = tid & 63, wave = __builtin_amdgcn_readfirstlane(tid >> 6);
    if (t_lo >= t_hi) return;
    const int ns = (t_hi - t_lo + TPS - 1) / TPS;
    const unsigned ring = lds_addr(lds), dump = ring + (unsigned)(NSLOT * SB);
#define ATT_DMA(st, slot) do { _Pragma("unroll 1") for (int u_ = 0; u_ < TPS; ++u_) { const int tt_ = t_lo + (st) * TPS + u_; \
        tile_dma<DQK, A::KP>(Kg, kpitch, tt_ * 64, kmax, ring + (unsigned)(slot) * SB + u_ * A::BYTES + A::KOFF, dump, wave, lane); \
        tile_dma<DV, A::VP>(Vg, vpitch, tt_ * 64, kmax, ring + (unsigned)(slot) * SB + u_ * A::BYTES + A::VOFF, dump, wave, lane); } } while (0)
    ATT_DMA(0, 0);
    if (NSLOT == 3) { if (1 < ns) { ATT_DMA(1, 1); wait_bar<NT>(); } else wait_bar<0>(); }
    else wait_bar<0>();
    int slot = 0;
#pragma unroll 1
    for (int s = 0; s < ns; ++s) {
        const int sn = (slot == 0) ? NSLOT - 1 : slot - 1;
        if (s + NSLOT - 1 < ns) ATT_DMA(s + NSLOT - 1, sn);
#pragma unroll 1
        for (int u = 0; u < TPS; ++u) {
            const int t = t_lo + s * TPS + u;
            LAS unsigned char* cur = lds + slot * SB + u * A::BYTES;
            const bool act = (t < t_hi) && mk.prep(t * 64);
            if (__any(act)) {
                if (SPLIT) {
                    const bool allfull = __all(mk.full(t * 64, act));
#pragma unroll
                    for (int kt = 0; kt < 2; ++kt) {
                        f32x16 sh;
                        qk_half<DQK, false>(cur + A::KOFF, qf, sh, kt, lane, nullptr);
                        const float mx = mask_half(sh, t * 64 + kt * 32, mk, act, lane, allfull);
                        online_half<DV>(sh, mx, m, l, O);
                        pv_half<DV>(cur + A::VOFF, sh, kt, O, lane);
                    }
                } else {
                    f32x16 s0, s1;
                    qk_tile<DQK, false>(cur + A::KOFF, qf, s0, s1, lane, nullptr);
                    const float mx = mask_tile(s0, s1, t * 64, mk, act, lane);
                    online_update<DV>(s0, s1, mx, m, l, O);
                    pv_tile<DV>(cur + A::VOFF, s0, s1, O, lane);
                }
            }
        }
        if (NSLOT == 3 && s + 2 < ns) wait_bar<NT>(); else wait_bar<0>();
        slot = (slot == NSLOT - 1) ? 0 : slot + 1;
    }
#undef ATT_DMA
}
template <int DQK> __device__ __forceinline__ void load_q(bf16x8 (&qf)[DQK / 16], const bf16* qrow, int lane) {
    const int hi = lane >> 5;
#pragma unroll
    for (int st = 0; st < DQK / 16; ++st) qf[st] = *(const bf16x8*)(qrow + st * 16 + hi * 8);
#pragma unroll
    for (int st = 0; st < DQK / 16; ++st) asm volatile("" : "+v"(qf[st]));
}
#ifndef DA_TPS
#define DA_TPS 2
#define DA_NSLOT 2
#endif

__device__ __forceinline__ void da_unit(LAS unsigned char* lds, const bf16* qkv, bf16* att, int b, int h, int qb, float lam, const float* subln, float* slotbase) {
    const int tid = threadIdx.x, lane = tid & 63, wave = __builtin_amdgcn_readfirstlane(tid >> 6), r32 = lane & 31, hi = lane >> 5;
    const int tpos = qb * 256 + wave * 32 + r32; const size_t row = (size_t)b * SEQ + tpos;
    unsigned o0p[32];
    const bf16* base = qkv + (size_t)b * SEQ * 4608;
    f32x16 O[4]; float ss = 0.f;
#pragma unroll 1
    for (int map = 0; map < 2; ++map) {
        bf16x8 qf[4]; load_q<64>(qf, qkv + row * 4608 + map * 512 + h * 64, lane);
#pragma unroll
        for (int dt = 0; dt < 4; ++dt)
#pragma unroll
            for (int r = 0; r < 16; ++r) O[dt][r] = 0.f;
        float m = NEG_BIG, l = 0.f;
        attn_run<64, 128, MaskCausal, false, DA_TPS, DA_NSLOT>(lds, base + 1024 + map * 512 + h * 64, 4608, base + 2048 + h * 128, 4608, SEQ - 1, 0, 4 * (qb + 1), qf, O, m, l, MaskCausal{tpos});
        const float inv = 1.f / sum32(l);
        if (map == 0) {
#pragma unroll
            for (int dt = 0; dt < 4; ++dt)
#pragma unroll
                for (int r = 0; r < 16; r += 2) o0p[dt * 8 + (r >> 1)] = cvtpk(O[dt][r] * inv, O[dt][r + 1] * inv);
        } else {
#pragma unroll
            for (int dt = 0; dt < 4; ++dt)
#pragma unroll
                for (int r = 0; r < 16; r += 2) { const unsigned w = o0p[dt * 8 + (r >> 1)];
                    const float oa = bflo(w) - lam * (O[dt][r] * inv), ob = bfhi(w) - lam * (O[dt][r + 1] * inv); O[dt][r] = oa; O[dt][r + 1] = ob; ss += oa * oa + ob * ob; }
        }
    }
    const float rn = 1.0f / sqrtf(sum32(ss) * (1.f / 128.f) + NORM_EPS) * 0.8f;
    bf16* orow = att + row * 2048 + h * 128;
#pragma unroll
    for (int dt = 0; dt < 4; ++dt)
#pragma unroll
        for (int g4 = 0; g4 < 4; ++g4) {
            const int d = dt * 32 + 8 * g4 + 4 * hi; const f32x4 sg = *(const f32x4*)(subln + d);
            u32x2 w; w.x = cvtpk(O[dt][4 * g4] * rn * sg.x, O[dt][4 * g4 + 1] * rn * sg.y); w.y = cvtpk(O[dt][4 * g4 + 2] * rn * sg.z, O[dt][4 * g4 + 3] * rn * sg.w);
            *(u32x2*)(orow + d) = w;
        }
}
__device__ __forceinline__ void swa_unit(LAS unsigned char* lds, const bf16* qkv, bf16* att, int b, int kvh, int tb, const float* sinks) {
    const int tid = threadIdx.x, lane = tid & 63, wave = __builtin_amdgcn_readfirstlane(tid >> 6), c = lane & 31, hi = lane >> 5;
    const int t0 = tb * 64, tpos = t0 + wave * 8 + (c >> 2), qh = kvh * 4 + (c & 3); const size_t row = (size_t)b * SEQ + tpos;
    const bf16* base = qkv + (size_t)b * SEQ * 4608;
    bf16x8 qf[4]; load_q<64>(qf, qkv + row * 4608 + 3072 + qh * 64, lane);
    f32x16 O[2];
#pragma unroll
    for (int dt = 0; dt < 2; ++dt)
#pragma unroll
        for (int r = 0; r < 16; ++r) O[dt][r] = 0.f;
    float m = sinks[qh] * LOG2E, l = (hi == 0) ? 1.f : 0.f;
    asm volatile("" : "+v"(m));
    const int t_lo = tb >= 2 ? tb - 2 : 0;
    attn_run<64, 64, MaskWindow>(lds, base + 4096 + kvh * 64, 4608, base + 4352 + kvh * 64, 4608, SEQ - 1, t_lo, tb + 1, qf, O, m, l, MaskWindow{tpos, 128});
    const float inv = 1.f / sum32(l);
    bf16* orow = att + row * 2048 + 1024 + qh * 64;
#pragma unroll
    for (int dt = 0; dt < 2; ++dt)
#pragma unroll
        for (int g4 = 0; g4 < 4; ++g4) {
            const int d = dt * 32 + 8 * g4 + 4 * hi;
            u32x2 w; w.x = cvtpk(O[dt][4 * g4] * inv, O[dt][4 * g4 + 1] * inv); w.y = cvtpk(O[dt][4 * g4 + 2] * inv, O[dt][4 * g4 + 3] * inv);
            *(u32x2*)(orow + d) = w;
        }
}

__device__ __forceinline__ void swa_naive(const bf16* qkv, bf16* att, int b, int tpos, int qh, const float* sinks, int lane) {
    const size_t row = (size_t)b * SEQ + tpos; const int kvh = qh >> 2;
    const bf16* q = qkv + row * 4608 + 3072 + qh * 64;
    float sc[2];
#pragma unroll
    for (int j = 0; j < 2; ++j) {
        const int key = tpos - 127 + lane + 64 * j;
        float s = -INFINITY;
        if (key >= 0) { const bf16* k = qkv + ((size_t)b * SEQ + key) * 4608 + 4096 + kvh * 64; float a = 0.f; for (int d = 0; d < 64; ++d) a += bf2f(q[d]) * bf2f(k[d]); s = a; }
        sc[j] = s;
    }
    const float snk = sinks[qh] * LOG2E;
    float mx = fmaxf(fmaxf(sc[0], sc[1]), snk);
#pragma unroll
    for (int o = 1; o < 64; o <<= 1) mx = fmaxf(mx, __shfl_xor(mx, o));
    const float p0 = exp2f(sc[0] - mx), p1 = exp2f(sc[1] - mx);
    const float den = wave_sum(p0 + p1) + exp2f(snk - mx);
    float acc = 0.f;
    for (int kk = 0; kk < 128; ++kk) {
        const int key = tpos - 127 + kk; const float p = __shfl(kk < 64 ? p0 : p1, kk & 63);
        if (key >= 0) acc += p * bf2f(qkv[((size_t)b * SEQ + key) * 4608 + 4352 + kvh * 64 + lane]);
    }
    const float o = acc / den;
    att[row * 2048 + 1024 + qh * 64 + lane] = (bf16)(cvtpk(o, 0.f) & 0xffffu);
}

struct Args { const float* in[20]; float* out; unsigned char* ws; int ph_lo, ph_hi; };
typedef const __attribute__((address_space(4))) Args* KArgs;
__device__ __forceinline__ KArgs kargs() { KArgs p = (KArgs)__builtin_amdgcn_kernarg_segment_ptr(); asm volatile("" : "+s"(p)); return p; }

template <int CTRL> __device__ __forceinline__ float dppf(float v) { return __int_as_float(__builtin_amdgcn_update_dpp(0, __float_as_int(v), CTRL, 0xF, 0xF, false)); }
template <int CTRL> __device__ __forceinline__ unsigned dppu(unsigned v) { return (unsigned)__builtin_amdgcn_update_dpp(0, (int)v, CTRL, 0xF, 0xF, false); }
__device__ __forceinline__ float sum8(float v) { v += dppf<0xB1>(v); v += dppf<0x4E>(v); v += dppf<0x141>(v); return v; }
__device__ __forceinline__ unsigned wave_max_u32(unsigned v) {
    unsigned t;
    t = dppu<0xB1>(v); v = v > t ? v : t;
    t = dppu<0x4E>(v); v = v > t ? v : t;
    t = dppu<0x141>(v); v = v > t ? v : t;
    t = dppu<0x140>(v); v = v > t ? v : t;
    const unsigned a = __builtin_amdgcn_readlane(v, 0), b = __builtin_amdgcn_readlane(v, 16), c = __builtin_amdgcn_readlane(v, 32), d = __builtin_amdgcn_readlane(v, 48);
    const unsigned ab = a > b ? a : b, cd = c > d ? c : d;
    return ab > cd ? ab : cd;
}
__device__ __forceinline__ unsigned ordf(float f) { const unsigned u = __float_as_uint(f); return u ^ ((u >> 31) ? 0xFFFFFFFFu : 0x80000000u); }

#ifndef NSA_SPLIT
#define NSA_SPLIT false
#endif
#ifndef NSA_PROBE
#define NSA_PROBE 0
#endif
constexpr int NSA_TILE = AT<128, 128>::BYTES;
constexpr int NSA_OUT = 2 * NSA_TILE + 1024;
constexpr int NSA_IMPA = NSA_OUT + 65536, NSA_IMPP = 132, NSA_SEL = NSA_IMPA + 32 * NSA_IMPP * 4;
static_assert(NSA_SEL + 512 <= LDS_BYTES && 3 * NSA_TILE + 1024 <= NSA_IMPA, "nsa lds map");

template <int PASS>
__device__ __forceinline__ void nsa_cmp_pass(LAS unsigned char* lds, const bf16* Kg, const bf16* Vg, int t_hi, const bf16x8 (&qf)[8], f32x16 (&O)[4], float& m, float& l, float invl, const MaskCmp& mk, int tl) {
    typedef AT<128, 128> A;
    constexpr int NT = DmaN<A::KP>::NIW + (PASS == 2 ? DmaN<A::VP>::NIW : 0);
    const int tid = threadIdx.x, lane = tid & 63, hi = lane >> 5, wave = __builtin_amdgcn_readfirstlane(tid >> 6);
    LAS float* impA = (LAS float*)(lds + NSA_IMPA);
    const unsigned ring = lds_addr(lds), dump = ring + 3u * A::BYTES;
#define CMP_DMA(t, slot) do { tile_dma<128, A::KP>(Kg, 128, (t) * 64, 511, ring + (unsigned)(slot) * A::BYTES + A::KOFF, dump, wave, lane); \
                              if (PASS == 2) tile_dma<128, A::VP>(Vg, 128, (t) * 64, 511, ring + (unsigned)(slot) * A::BYTES + A::VOFF, dump, wave, lane); } while (0)
    CMP_DMA(0, 0);
    if (1 < t_hi) { CMP_DMA(1, 1); wait_bar<NT>(); } else wait_bar<0>();
    float carry = 0.f;
    int slot = 0;
#pragma unroll 1
    for (int t = 0; t < t_hi; ++t) {
        LAS unsigned char* cur = lds + slot * A::BYTES;
        const int s2 = slot == 0 ? 2 : slot - 1;
        if (t + 2 < t_hi) CMP_DMA(t + 2, s2);
        const bool act = mk.prep(t * 64);
        if (__any(act)) {
            f32x16 s0, s1;
            qk_tile<128, false>(cur + A::KOFF, qf, s0, s1, lane, nullptr);
            float mx = mask_tile(s0, s1, t * 64, mk, act, lane);
            if (PASS == 1) {
                mx = max32(mx);
                const float mn = fmaxf(m, mx), alpha = __builtin_amdgcn_exp2f(m - mn); float ps = 0.f;
#pragma unroll
                for (int r = 0; r < 16; ++r) ps += __builtin_amdgcn_exp2f(s0[r] - mn) + __builtin_amdgcn_exp2f(s1[r] - mn);
                l = l * alpha + ps; m = mn;
            } else {
#pragma unroll
                for (int r = 0; r < 16; ++r) { s0[r] = __builtin_amdgcn_exp2f(s0[r] - m) * invl; s1[r] = __builtin_amdgcn_exp2f(s1[r] - m) * invl; }
#pragma unroll
                for (int kt = 0; kt < 2; ++kt) {
                    const f32x16& p = kt ? s1 : s0;
#pragma unroll
                    for (int g4 = 0; g4 < 4; ++g4) {
                        auto rr = __builtin_amdgcn_permlane32_swap(__float_as_uint(p[4 * g4 + 3]), __float_as_uint(p[4 * g4 + 3]), false, false);
                        const float prev = hi ? __uint_as_float(rr[0]) : carry;
                        carry = __uint_as_float(rr[1]);
                        float a = p[4 * g4] + p[4 * g4 + 1] + p[4 * g4 + 2] + 0.5f * (p[4 * g4 + 3] + prev);
                        a = sum8(a);
                        const int si = 16 * t + 8 * kt + 2 * g4 + hi;
                        if ((lane & 7) == 0) impA[tl * NSA_IMPP + si] = a;
                    }
                }
                pv_tile<128>(cur + A::VOFF, s0, s1, O, lane);
            }
        }
        if (t + 2 < t_hi) wait_bar<NT>(); else wait_bar<0>();
        slot = slot == 2 ? 0 : slot + 1;
    }
#undef CMP_DMA
}
__device__ __forceinline__ void nsa_window_unit(LAS unsigned char* lds, int b, int kvh, int tb) {
#define ws (kargs()->ws)
    const int tid = threadIdx.x, lane = tid & 63, wave = __builtin_amdgcn_readfirstlane(tid >> 6), c = lane & 31, hi = lane >> 5;
    const int t0 = tb * 32, tl = wave * 4 + (c >> 3), tok = t0 + tl, qh = kvh * 8 + (c & 7); const size_t row = (size_t)b * SEQ + tok;
    __syncthreads();
    bf16x8 qf[8]; load_q<128>(qf, (const bf16*)(ws + WS_Q1) + row * 2048 + qh * 128, lane);
    f32x16 O[4];
#pragma unroll
    for (int dt = 0; dt < 4; ++dt)
#pragma unroll
        for (int r = 0; r < 16; ++r) O[dt][r] = 0.f;
    float m = NEG_BIG, l = 0.f;
    const MaskWindow mk{tok, 512};
    const bf16* Kg = (const bf16*)(ws + WS_KW) + (size_t)b * SEQ * 256 + kvh * 128; const bf16* Vg = (const bf16*)(ws + WS_VW) + (size_t)b * SEQ * 256 + kvh * 128;
    const int t_lo = t0 >= 511 ? ((t0 - 511) >> 6) : 0;
    attn_run<128, 128, MaskWindow, NSA_SPLIT, 1, 2>(lds, Kg, 256, Vg, 256, SEQ - 1, t_lo, ((t0 + 31) >> 6) + 1, qf, O, m, l, mk);
    l = sum32(l);
    const float sc = ((const float*)(ws + WS_GATES))[row * 48 + 2 * 16 + qh] / l;
    bf16* orow = (bf16*)(ws + WS_ATT) + row * 2048 + qh * 128;
#pragma unroll
    for (int dt = 0; dt < 4; ++dt)
#pragma unroll
        for (int g4 = 0; g4 < 4; ++g4) {
            u32x2 w; w.x = cvtpk(sc * O[dt][4 * g4], sc * O[dt][4 * g4 + 1]); w.y = cvtpk(sc * O[dt][4 * g4 + 2], sc * O[dt][4 * g4 + 3]);
            *(u32x2*)(orow + dt * 32 + 8 * g4 + 4 * hi) = w;
        }
#undef ws
}
__device__ __forceinline__ void nsa_unit(LAS unsigned char* lds, int b, int kvh, int tb) {
#define ws (kargs()->ws)
    const int tid = threadIdx.x, lane = tid & 63, wave = __builtin_amdgcn_readfirstlane(tid >> 6), c = lane & 31, hi = lane >> 5;
    const int t0 = tb * 32, tl = wave * 4 + (c >> 3), tok = t0 + tl, qh = kvh * 8 + (c & 7); const size_t row = (size_t)b * SEQ + tok;
    LAS float* impA = (LAS float*)(lds + NSA_IMPA);
    LAS unsigned long long* selm = (LAS unsigned long long*)(lds + NSA_SEL);
    LAS unsigned* outl = (LAS unsigned*)(lds + NSA_OUT) + wave * 2048;

#define NSA_SLOT ((float*)(ws + WS_SLOT) + ((size_t)blockIdx.x * NWAVES + wave) * 4096)
#define NSA_GATE(br) (((const float*)(ws + WS_GATES))[((size_t)b * SEQ + t0 + wave * 4 + (c >> 3)) * 48 + (br) * 16 + kvh * 8 + (c & 7)])
    __syncthreads();
    bf16x8 qf[8]; load_q<128>(qf, (const bf16*)(ws + WS_Q1) + row * 2048 + qh * 128, lane);
    for (int i = tid; i < 32 * NSA_IMPP; i += NTHREADS) impA[i] = 0.f;
    f32x16 O[4];
    {
        const bf16* Kc = (const bf16*)(ws + WS_KCMP) + (size_t)(b * 2 + kvh) * 512 * 128; const bf16* Vc = (const bf16*)(ws + WS_VCMP) + (size_t)(b * 2 + kvh) * 512 * 128;
        const MaskCmp mk{(tok - 31) >> 4};
        const int t_hi = ((2 * tb) >> 6) + 1;
        float m = NEG_BIG, l = 0.f;
#if NSA_PROBE == 3
        { nsa_cmp_pass<1>(lds, Kc, Vc, t_hi, qf, O, m, l, 0.f, mk, tl); float l2 = sum32(l); const float iv = l2 > 0.f ? 1.f / l2 : 0.f;
#pragma unroll
          for (int dt = 0; dt < 4; ++dt)
#pragma unroll
            for (int r = 0; r < 16; ++r) O[dt][r] = 0.f;
          nsa_cmp_pass<2>(lds, Kc, Vc, t_hi, qf, O, m, l, iv, mk, tl);
#pragma unroll
          for (int dt = 0; dt < 4; ++dt) asm volatile("" :: "v"(O[dt]));
          m = NEG_BIG; l = 0.f; }
#endif
        nsa_cmp_pass<1>(lds, Kc, Vc, t_hi, qf, O, m, l, 0.f, mk, tl);
        l = sum32(l); const float invl = l > 0.f ? 1.f / l : 0.f;
#pragma unroll
        for (int dt = 0; dt < 4; ++dt)
#pragma unroll
            for (int r = 0; r < 16; ++r) O[dt][r] = 0.f;
        nsa_cmp_pass<2>(lds, Kc, Vc, t_hi, qf, O, m, l, invl, mk, tl);
        const float g0 = NSA_GATE(0);
#pragma unroll
        for (int dt = 0; dt < 4; ++dt)
#pragma unroll
            for (int r = 0; r < 16; r += 2) outl[(dt * 8 + (r >> 1)) * 64 + lane] = cvtpk(g0 * O[dt][r], g0 * O[dt][r + 1]);
    }
    asm volatile("s_waitcnt lgkmcnt(0)" ::: "memory");
    {
        const int rw = lane >> 4, li = lane & 15, tlj = wave * 4 + rw, cur = t0 >> 6;
        unsigned selb = 0u;
        if (cur < 16) {
#pragma unroll
            for (int k = 0; k < 8; ++k) selb |= (li * 8 + k <= cur) ? (1u << k) : 0u;
        } else {
            unsigned kk[8];
            { const f32x4 x0 = *(const LAS f32x4*)(impA + tlj * NSA_IMPP + li * 8), x1 = *(const LAS f32x4*)(impA + tlj * NSA_IMPP + li * 8 + 4);
#pragma unroll
              for (int k = 0; k < 8; ++k) { const int s = li * 8 + k; const float v = k < 4 ? x0[k & 3] : x1[k & 3];
                  const bool forced = (s == 0) || (s == cur) || (s == cur - 1);
                  kk[k] = (s > cur) ? 0u : ((forced ? 0xFFFFFF80u : (ordf(v) & 0xFFFFFF80u)) | (unsigned)(127 - s)); } }
#pragma unroll 1
            for (int r = 0; r < 16; ++r) {
                unsigned mk_ = kk[0];
#pragma unroll
                for (int k = 1; k < 8; ++k) mk_ = mk_ > kk[k] ? mk_ : kk[k];
                unsigned t;
                t = dppu<0xB1>(mk_); mk_ = mk_ > t ? mk_ : t; t = dppu<0x4E>(mk_); mk_ = mk_ > t ? mk_ : t; t = dppu<0x141>(mk_); mk_ = mk_ > t ? mk_ : t; t = dppu<0x140>(mk_); mk_ = mk_ > t ? mk_ : t;
#pragma unroll
                for (int k = 0; k < 8; ++k) { const bool hit = kk[k] == mk_; selb |= hit ? (1u << k) : 0u; kk[k] = hit ? 0u : kk[k]; }
            }
        }
        ((LAS unsigned char*)selm)[tlj * 16 + li] = (unsigned char)selb;
    }
    asm volatile("s_waitcnt lgkmcnt(0)" ::: "memory");
    {
        const MaskSel mk{tok, selm[tl * 2], selm[tl * 2 + 1]};
#pragma unroll
        for (int dt = 0; dt < 4; ++dt)
#pragma unroll
            for (int r = 0; r < 16; ++r) O[dt][r] = 0.f;
        float m = NEG_BIG, l = 0.f;
        const bf16* Kg = (const bf16*)(ws + WS_KSL) + (size_t)b * SEQ * 256 + kvh * 128; const bf16* Vg = (const bf16*)(ws + WS_VSL) + (size_t)b * SEQ * 256 + kvh * 128;
#if NSA_PROBE == 1
        { attn_run<128, 128, MaskSel, NSA_SPLIT, 1, 2>(lds, Kg, 256, Vg, 256, SEQ - 1, 0, ((t0 + 31) >> 6) + 1, qf, O, m, l, mk);
#pragma unroll
          for (int dt = 0; dt < 4; ++dt) { asm volatile("" :: "v"(O[dt]));
#pragma unroll
            for (int r = 0; r < 16; ++r) O[dt][r] = 0.f; }
          m = NEG_BIG; l = 0.f; }
#endif
        attn_run<128, 128, MaskSel, NSA_SPLIT, 1, 2>(lds, Kg, 256, Vg, 256, SEQ - 1, 0, ((t0 + 31) >> 6) + 1, qf, O, m, l, mk);
        l = sum32(l); const float sc = NSA_GATE(1) / l;
        bf16* orow = (bf16*)(ws + WS_ATT) + ((size_t)b * SEQ + t0 + wave * 4 + (c >> 3)) * 2048 + (kvh * 8 + (c & 7)) * 128;
#pragma unroll
        for (int dt = 0; dt < 4; ++dt)
#pragma unroll
            for (int g4 = 0; g4 < 4; ++g4) {
                const unsigned w0 = outl[(dt * 8 + 2 * g4) * 64 + lane], w1 = outl[(dt * 8 + 2 * g4 + 1) * 64 + lane];
                const u32x2 pw = *(const u32x2*)(orow + dt * 32 + 8 * g4 + 4 * hi);
                u32x2 w; w.x = cvtpk(bflo(w0) + bflo(pw.x) + sc * O[dt][4 * g4], bfhi(w0) + bfhi(pw.x) + sc * O[dt][4 * g4 + 1]);
                w.y = cvtpk(bflo(w1) + bflo(pw.y) + sc * O[dt][4 * g4 + 2], bfhi(w1) + bfhi(pw.y) + sc * O[dt][4 * g4 + 3]);
                *(u32x2*)(orow + dt * 32 + 8 * g4 + 4 * hi) = w;
            }
    }
#undef ws
}

#define XB_TMO      128
#define XB_XCNT(j)  (256  + 64 * (j))
#define XB_XSUB(j)  (1280 + 64 * (j))
#define XB_XGEN(j)  (2304 + 64 * (j))
#define XB_TOP      3328
#define XB_TOPGEN   3392
#define XCD_BAR_WORDS 3456
#define XB_SPIN_CAP (1u << 18)

__device__ __forceinline__ unsigned xb_ld(unsigned* p)              { return __hip_atomic_load(p, __ATOMIC_RELAXED, __HIP_MEMORY_SCOPE_AGENT); }
__device__ __forceinline__ unsigned xb_add(unsigned* p, unsigned v) { return __hip_atomic_fetch_add(p, v, __ATOMIC_RELAXED, __HIP_MEMORY_SCOPE_AGENT); }
__device__ __forceinline__ unsigned xb_xcc_id() { return (unsigned)__builtin_amdgcn_s_getreg((3 << 11) | 20) & 0xFu; }
#define XB_SPIN(cond, bar) do { unsigned _sp = 0; while (cond) { __builtin_amdgcn_s_sleep(1); \
    if ((++_sp & 255u) == 0u) { if (xb_ld(&(bar)[XB_TMO])) break; if (_sp > XB_SPIN_CAP) { atomicAdd(&(bar)[XB_TMO], 1u); break; } } } } while (0)

struct XcdBarrier {
    unsigned* bar; unsigned x;
    volatile unsigned* st;
};

__device__ __forceinline__ XcdBarrier xcd_barrier_post(unsigned* bar, volatile unsigned* st) {
    XcdBarrier b; b.bar = bar; b.x = xb_xcc_id(); b.st = st;
    if (threadIdx.x == 0) (void)xb_add(&bar[XB_XCNT(b.x)], 1u);
    return b;
}
__device__ __forceinline__ void xcd_barrier_complete(unsigned* bar, unsigned x, unsigned& nloc, unsigned& nx) {
    const unsigned G = gridDim.x * gridDim.y * gridDim.z;
    unsigned sum, cnt, mine, sp = 0u;
    for (;;) {
        sum = 0u; cnt = 0u; mine = 0u;
#pragma unroll
        for (unsigned j = 0; j < 16; ++j) { const unsigned c = xb_ld(&bar[XB_XCNT(j)]); sum += c; cnt += (c > 0u) ? 1u : 0u; mine = (j == x) ? c : mine; }
        if (sum == G) break;
        __builtin_amdgcn_s_sleep(1);
        if ((++sp & 255u) == 0u) { if (xb_ld(&bar[XB_TMO])) break; if (sp > XB_SPIN_CAP) { atomicAdd(&bar[XB_TMO], 1u); break; } }
    }
    nloc = mine > 0u ? mine : 1u; nx = cnt > 0u ? cnt : 1u;
}

__device__ __forceinline__ void xcd_barrier(const XcdBarrier& b) {
    asm volatile("s_waitcnt vmcnt(0)" ::: "memory");
    __syncthreads();
    if (threadIdx.x == 0) {
        unsigned* bar = b.bar;
        __builtin_amdgcn_s_waitcnt(0);
        unsigned nloc = b.st[0], nx = b.st[1];
        if (nloc == 0u) { xcd_barrier_complete(bar, b.x, nloc, nx); b.st[0] = nloc; b.st[1] = nx; }
        const unsigned old = xb_add(&bar[XB_XSUB(b.x)], 1u);
        const unsigned gen = old / nloc;
        if (old + 1u == (gen + 1u) * nloc) {
            __builtin_amdgcn_fence(__ATOMIC_RELEASE, "agent");
            asm volatile("s_waitcnt vmcnt(0)" ::: "memory");
            const unsigned og = xb_add(&bar[XB_TOP], 1u);
            const unsigned tg = og / nx;
            if (og + 1u == (tg + 1u) * nx) xb_add(&bar[XB_TOPGEN], 1u);
            else XB_SPIN(xb_ld(&bar[XB_TOPGEN]) == tg, bar);
            __builtin_amdgcn_fence(__ATOMIC_ACQUIRE, "agent");
            xb_add(&bar[XB_XGEN(b.x)], 1u);
            asm volatile("s_waitcnt vmcnt(0)" ::: "memory");
        } else {
            XB_SPIN(xb_ld(&bar[XB_XGEN(b.x)]) == gen, bar);
            __builtin_amdgcn_fence(__ATOMIC_ACQUIRE, "agent");
            asm volatile("s_waitcnt vmcnt(0)" ::: "memory");
        }
    }
    __syncthreads();
}

typedef unsigned v6u_t __attribute__((ext_vector_type(6)));
typedef float v32f_t __attribute__((ext_vector_type(32)));
typedef __bf16 v32bf_t __attribute__((ext_vector_type(32)));
__device__ __forceinline__ v32bf_t fp6_to_bf16x32(v6u_t p) { return __builtin_amdgcn_cvt_scalef32_pk32_bf16_fp6(p, 1.0f); }
__device__ __forceinline__ v32f_t fp6_to_f32x32(v6u_t p) { return __builtin_amdgcn_cvt_scalef32_pk32_f32_fp6(p, 1.0f); }
#define PEER_BKT(r) ((((r) >> 15) & 1u) << 8 | (((r) & 0x3FFFu) >> 6))
#ifndef PEER_HCOPY
#define PEER_HCOPY 0
#endif
#ifndef PEER_SELPF
#define PEER_SELPF 1
#endif
#ifndef PEER_DRYMASK
#define PEER_DRYMASK 0
#endif
#ifndef PEER_NT
#define PEER_NT 0
#endif
#ifndef PEER_NTX
#define PEER_NTX 0
#endif
#ifndef PEER_SWEEP_SYNC
#define PEER_SWEEP_SYNC 0
#endif
#ifndef PEER_P
#define PEER_P 8
#endif
constexpr int PEER_SC = 0, PEER_CS = 98304, PEER_REC = 131072, PEER_SRT = 147456;
__device__ __forceinline__ float sum16(float v) { v += dppf<0xB1>(v); v += dppf<0x4E>(v); v += dppf<0x141>(v); v += dppf<0x140>(v); return v; }
__device__ __forceinline__ float dot8(const u32x4& a, const u32x4& b, float acc) {
    acc = fmaf(bflo(a.x), bflo(b.x), acc); acc = fmaf(bfhi(a.x), bfhi(b.x), acc);
    acc = fmaf(bflo(a.y), bflo(b.y), acc); acc = fmaf(bfhi(a.y), bfhi(b.y), acc);
    acc = fmaf(bflo(a.z), bflo(b.z), acc); acc = fmaf(bfhi(a.z), bfhi(b.z), acc);
    acc = fmaf(bflo(a.w), bflo(b.w), acc); acc = fmaf(bfhi(a.w), bfhi(b.w), acc);
    return acc;
}
__device__ __forceinline__ void cand_ij(int c, int& i, int& j) {
    if (c < 16) { i = 0; j = c; } else if (c < 24) { i = 1; j = c - 16; } else if (c < 29) { i = 2; j = c - 24; } else if (c < 33) { i = 3; j = c - 29; }
    else if (c < 36) { i = 4; j = c - 33; } else if (c < 38) { i = 5; j = c - 36; } else if (c < 40) { i = 6; j = c - 38; } else if (c < 42) { i = 7; j = c - 40; }
    else { i = c - 34; j = 0; }
}
template <int MODE, bool DRY = false, bool SELONLY = false>
__device__ __forceinline__ void peer_tile(LAS unsigned char* lds, int tile, int layer, const XcdBarrier& xb) {
#define PWS (kargs()->ws)
#define q ((const bf16*)(PWS + WS_Q1))
#define subk ((const bf16*)(PWS + WS_SUBK) + (size_t)layer * (8 * 2 * 128 * 128))
#define utab ((const unsigned char*)(PWS + WS_TAB + (size_t)layer * 48 * MiB))
#define vtab ((const unsigned char*)(PWS + WS_TAB + (size_t)layer * 48 * MiB + 24 * MiB))
#define tscale ((const float*)(PWS + WS_TSCALE) + (size_t)layer * 2 * 16384)
#define hbuf ((bf16*)(PWS + WS_H))
#define xbuf ((bf16*)(PWS + WS_XB))
#define fout (kargs()->out)
#define gate ((const float*)(PWS + WS_MOD) + (size_t)(layer * 2 + 1) * 2 * 6144 + 4096)
#define g_next (MODE == 0 ? kargs()->in[4] + 2 * 2048 : kargs()->in[19])
#define mod_next ((const float*)(PWS + WS_MOD) + (size_t)2 * 2 * 6144)
    int tid_ = threadIdx.x; asm volatile("" : "+v"(tid_));
    const int tid = tid_, lane = tid & 63, wave = __builtin_amdgcn_readfirstlane(tid >> 6), r32 = lane & 31, hi = lane >> 5;
    LAS float* sc = (LAS float*)(lds + PEER_SC); LAS unsigned* rec = (LAS unsigned*)(lds + PEER_REC);
    const int tok0 = tile * 32;
    const int rw = lane >> 4, li = lane & 15, tlr = wave * 4 + rw;
    LAS float* cscr = (LAS float*)(lds + PEER_CS) + wave * 512;
    bf16x8 fa[8], fb[8];
#if PEER_SELPF
    {   const int p = wave >> 2, kt = wave & 3;
        const bf16* ap = subk + ((size_t)((0 * 2 + p) * 128 + kt * 32 + r32)) * 128 + hi * 8; const bf16* bp = q + (size_t)(tok0 + r32) * 2048 + p * 128 + hi * 8;
#pragma unroll
        for (int st = 0; st < 8; ++st) { fa[st] = *(const bf16x8*)(ap + st * 16); fb[st] = *(const bf16x8*)(bp + st * 16); } }
#endif
#pragma unroll 1
    for (int h = 0; h < 8; ++h) {
        LAS float* scb = sc + (h & 1) * 8192;
        {
            const int p = wave >> 2, kt = wave & 3;
            f32x16 s;
#pragma unroll
            for (int i = 0; i < 16; ++i) s[i] = 0.f;
#if PEER_SELPF
#pragma unroll
            for (int st = 0; st < 8; ++st) s = __builtin_amdgcn_mfma_f32_32x32x16_bf16(fa[st], fb[st], s, 0, 0, 0);
            if (h + 1 < 8) {
                const bf16* ap = subk + ((size_t)(((h + 1) * 2 + p) * 128 + kt * 32 + r32)) * 128 + hi * 8; const bf16* bp = q + (size_t)(tok0 + r32) * 2048 + (h + 1) * 256 + p * 128 + hi * 8;
#pragma unroll
                for (int st = 0; st < 8; ++st) { fa[st] = *(const bf16x8*)(ap + st * 16); fb[st] = *(const bf16x8*)(bp + st * 16); }
            }
#else
            const bf16* ap = subk + ((size_t)((h * 2 + p) * 128 + kt * 32 + r32)) * 128 + hi * 8;
            const bf16* bp = q + (size_t)(tok0 + r32) * 2048 + h * 256 + p * 128 + hi * 8;
#pragma unroll
            for (int st = 0; st < 8; ++st) s = __builtin_amdgcn_mfma_f32_32x32x16_bf16(*(const bf16x8*)(ap + st * 16), *(const bf16x8*)(bp + st * 16), s, 0, 0, 0);
#endif
#pragma unroll
            for (int r = 0; r < 16; ++r) scb[(p * 32 + r32) * 128 + kt * 32 + crow(r, hi)] = s[r];
        }
        __syncthreads();
        {
            const LAS float* s0 = scb + tlr * 128; const LAS float* s1 = scb + (32 + tlr) * 128;
            unsigned ka[8], kb[8];
            { const f32x4 x0 = *(const LAS f32x4*)(s0 + li * 8), x1 = *(const LAS f32x4*)(s0 + li * 8 + 4), y0 = *(const LAS f32x4*)(s1 + li * 8), y1 = *(const LAS f32x4*)(s1 + li * 8 + 4);
#pragma unroll
              for (int k = 0; k < 4; ++k) { ka[k] = (ordf(x0[k]) & 0xFFFFFF80u) | (unsigned)(127 - (li * 8 + k)); ka[4 + k] = (ordf(x1[k]) & 0xFFFFFF80u) | (unsigned)(127 - (li * 8 + 4 + k));
                  kb[k] = (ordf(y0[k]) & 0xFFFFFF80u) | (unsigned)(127 - (li * 8 + k)); kb[4 + k] = (ordf(y1[k]) & 0xFFFFFF80u) | (unsigned)(127 - (li * 8 + 4 + k)); } }
            unsigned ra = 0u, rb = 0u;
#pragma unroll 1
            for (int r = 0; r < 16; ++r) {
                unsigned ma = ka[0], mb = kb[0];
#pragma unroll
                for (int k = 1; k < 8; ++k) { ma = ma > ka[k] ? ma : ka[k]; mb = mb > kb[k] ? mb : kb[k]; }
                unsigned t;
                t = dppu<0xB1>(ma); ma = ma > t ? ma : t; t = dppu<0xB1>(mb); mb = mb > t ? mb : t;
                t = dppu<0x4E>(ma); ma = ma > t ? ma : t; t = dppu<0x4E>(mb); mb = mb > t ? mb : t;
                t = dppu<0x141>(ma); ma = ma > t ? ma : t; t = dppu<0x141>(mb); mb = mb > t ? mb : t;
                t = dppu<0x140>(ma); ma = ma > t ? ma : t; t = dppu<0x140>(mb); mb = mb > t ? mb : t;
#pragma unroll
                for (int k = 0; k < 8; ++k) { ka[k] = ka[k] == ma ? 0u : ka[k]; kb[k] = kb[k] == mb ? 0u : kb[k]; }
                if (li == r) { ra = ma; rb = mb; }
            }
            const int ia = 127 - (int)(ra & 127u), ib = 127 - (int)(rb & 127u);
            const float av = s0[ia], bv = s1[ib];
            unsigned ck[4]; const int rowbase = lane & 48;
#pragma unroll
            for (int u = 0; u < 4; ++u) {
                const int c = li + 16 * u; int ci, cj; cand_ij(c < 50 ? c : 0, ci, cj);
                const float cand = __shfl(av, rowbase + ci) + __shfl(bv, rowbase + cj);
                const int ce = __shfl(ia, rowbase + ci) * 128 + __shfl(ib, rowbase + cj);
                cscr[rw * 64 + c] = cand; ((LAS int*)cscr)[256 + rw * 64 + c] = ce;
                ck[u] = c < 50 ? ((ordf(cand) & 0xFFFFFFC0u) | (unsigned)(63 - c)) : 0u;
            }
            unsigned rc = 0u;
#pragma unroll 1
            for (int r = 0; r < 16; ++r) {
                unsigned mc = ck[0] > ck[1] ? ck[0] : ck[1]; { const unsigned m2 = ck[2] > ck[3] ? ck[2] : ck[3]; mc = mc > m2 ? mc : m2; }
                unsigned t;
                t = dppu<0xB1>(mc); mc = mc > t ? mc : t; t = dppu<0x4E>(mc); mc = mc > t ? mc : t; t = dppu<0x141>(mc); mc = mc > t ? mc : t; t = dppu<0x140>(mc); mc = mc > t ? mc : t;
#pragma unroll
                for (int u = 0; u < 4; ++u) ck[u] = ck[u] == mc ? 0u : ck[u];
                if (li == r) rc = mc;
            }
            const int cw = 63 - (int)(rc & 63u);
            const float best = cscr[rw * 64 + cw]; const int be = ((LAS int*)cscr)[256 + rw * 64 + cw];
            const float mx = __shfl(best, rowbase);
            const float ex = __expf(best - mx);
            const float den = sum16(ex);
            rec[tlr * 128 + h * 16 + li] = (cvtpk(0.f, ex / den) & 0xffff0000u) | ((unsigned)rw << 14) | (unsigned)be;
        }
    }
    __syncthreads();
    if (SELONLY) return;
    {
        LAS unsigned* rec2 = (LAS unsigned*)(lds + PEER_SRT);
#pragma unroll 1
        for (int j = 0; j < 4; ++j) {
            const int tl = wave * 4 + j; const size_t row = (size_t)tok0 + tl;
            const LAS unsigned* rcw = rec + tl * 128; LAS unsigned* rc2 = rec2 + tl * 128;
#pragma unroll
            for (int k2 = 0; k2 < 2; ++k2) { const unsigned e = rcw[lane + 64 * k2] & 0x3FFFu; rc2[lane + 64 * k2] = cvtpk(tscale[16384 + e], tscale[e]); }
            u32x4 hh[4];
#pragma unroll
            for (int c4 = 0; c4 < 4; ++c4) hh[c4] = *(const u32x4*)(hbuf + row * 2048 + lane * 32 + 8 * c4);
#pragma unroll
            for (int c4 = 0; c4 < 4; ++c4) asm volatile("" : "+v"(hh[c4]));
            f32x2 acc[16];
#pragma unroll
            for (int i = 0; i < 16; ++i) acc[i] = (f32x2){0.f, 0.f};
#pragma unroll 1
            for (int g0 = 0; g0 < 128; g0 += PEER_P) {
                u32x4 ura[PEER_P], vra[PEER_P]; u32x2 urb[PEER_P], vrb[PEER_P];
#pragma unroll
                for (int p = 0; p < PEER_P; ++p) {
                    const unsigned e = (unsigned)__builtin_amdgcn_readfirstlane((int)rcw[g0 + p]) & ((DRY && PEER_DRYMASK) ? 0x3FFu : 0x3FFFu);
                    const unsigned char* up = utab + (size_t)e * 1536; const unsigned char* vp = vtab + (size_t)e * 1536;
#if PEER_NT
                    ura[p] = __builtin_nontemporal_load((const u32x4*)(up + lane * 16)); urb[p] = __builtin_nontemporal_load((const u32x2*)(up + 1024 + lane * 8));
                    vra[p] = __builtin_nontemporal_load((const u32x4*)(vp + lane * 16)); vrb[p] = __builtin_nontemporal_load((const u32x2*)(vp + 1024 + lane * 8));
#else
                    ura[p] = *(const u32x4*)(up + lane * 16); urb[p] = *(const u32x2*)(up + 1024 + lane * 8);
                    vra[p] = *(const u32x4*)(vp + lane * 16); vrb[p] = *(const u32x2*)(vp + 1024 + lane * 8);
#endif
                }
                float part[PEER_P];
#pragma unroll
                for (int p = 0; p < PEER_P; ++p) {
                    const v6u_t up6 = {ura[p].x, ura[p].y, ura[p].z, ura[p].w, urb[p].x, urb[p].y};
                    const v32bf_t ub = fp6_to_bf16x32(up6);
                    float d = 0.f;
#pragma unroll
                    for (int k = 0; k < 16; ++k) { const bf16x2_t uu = {ub[2 * k], ub[2 * k + 1]}; const unsigned hw = hh[k >> 2][k & 3];     d = __builtin_amdgcn_fdot2_f32_bf16(uu, __builtin_bit_cast(bf16x2_t, hw), d, false); }
                    part[p] = d;
                }
                float v4[4], v2[2], v1;
                { const bool up = (lane & 32) != 0;
#pragma unroll
                  for (int i = 0; i < 4; ++i) { const float keep = up ? part[i + 4] : part[i], snd = up ? part[i] : part[i + 4]; v4[i] = keep + __shfl_xor(snd, 32); } }
                { const bool up = (lane & 16) != 0;
#pragma unroll
                  for (int i = 0; i < 2; ++i) { const float keep = up ? v4[i + 2] : v4[i], snd = up ? v4[i] : v4[i + 2]; v2[i] = keep + __shfl_xor(snd, 16); } }
                { const bool up = (lane & 8) != 0; const float keep = up ? v2[1] : v2[0], snd = up ? v2[0] : v2[1]; v1 = keep + __shfl_xor(snd, 8); }
                v1 += __shfl_xor(v1, 4); v1 += __shfl_xor(v1, 2); v1 += __shfl_xor(v1, 1);
                const int ek = 4 * (lane >> 5) + 2 * ((lane >> 4) & 1) + ((lane >> 3) & 1);
                const unsigned rk = rcw[g0 + ek], sk = rc2[g0 + ek];
                const float cf = __uint_as_float(rk & 0xffff0000u) * gelu_tanh(v1 * __uint_as_float(sk & 0xffff0000u)) * __uint_as_float(sk << 16);
#pragma unroll
                for (int p = 0; p < PEER_P; ++p) {
                    const float ck = __int_as_float(__builtin_amdgcn_readlane(__float_as_int(cf), (((p >> 2) & 1) << 5) | (((p >> 1) & 1) << 4) | ((p & 1) << 3)));
                    const f32x2 ck2 = {ck, ck};
                    const v6u_t vp6 = {vra[p].x, vra[p].y, vra[p].z, vra[p].w, vrb[p].x, vrb[p].y};
                    const v32f_t vf = fp6_to_f32x32(vp6);
#pragma unroll
                    for (int i = 0; i < 16; ++i) acc[i] = __builtin_elementwise_fma((f32x2){vf[2 * i], vf[2 * i + 1]}, ck2, acc[i]);
                }
            }
            if (DRY) {
#pragma unroll
                for (int i = 0; i < 16; ++i) asm volatile("" :: "v"(acc[i]));
                continue;
            }
            bf16* xr = xbuf + row * 2048 + lane * 32; const float* gt = gate + (size_t)(row >> 13) * 6144 + lane * 32;
            float ss = 0.f;
#pragma unroll
            for (int c4 = 0; c4 < 4; ++c4) {
                const u32x4 xw = *(const u32x4*)(xr + 8 * c4); const f32x4 g0 = *(const f32x4*)(gt + 8 * c4), g1 = *(const f32x4*)(gt + 8 * c4 + 4);
                f32x4 xa, xb2;
                xa.x = bflo(xw.x) + g0.x * acc[4 * c4].x; xa.y = bfhi(xw.x) + g0.y * acc[4 * c4].y; xa.z = bflo(xw.y) + g0.z * acc[4 * c4 + 1].x; xa.w = bfhi(xw.y) + g0.w * acc[4 * c4 + 1].y;
                xb2.x = bflo(xw.z) + g1.x * acc[4 * c4 + 2].x; xb2.y = bfhi(xw.z) + g1.y * acc[4 * c4 + 2].y; xb2.z = bflo(xw.w) + g1.z * acc[4 * c4 + 3].x; xb2.w = bfhi(xw.w) + g1.w * acc[4 * c4 + 3].y;
                if (MODE == 0) {
                    const u32x4 pw = pack8(xa, xb2); *(u32x4*)(xr + 8 * c4) = pw;
                    xa = (f32x4){bflo(pw.x), bfhi(pw.x), bflo(pw.y), bfhi(pw.y)}; xb2 = (f32x4){bflo(pw.z), bfhi(pw.z), bflo(pw.w), bfhi(pw.w)};
                }
                acc[4 * c4] = (f32x2){xa.x, xa.y}; acc[4 * c4 + 1] = (f32x2){xa.z, xa.w}; acc[4 * c4 + 2] = (f32x2){xb2.x, xb2.y}; acc[4 * c4 + 3] = (f32x2){xb2.z, xb2.w};
                ss += (xa.x * xa.x + xa.y * xa.y) + (xa.z * xa.z + xa.w * xa.w) + (xb2.x * xb2.x + xb2.y * xb2.y) + (xb2.z * xb2.z + xb2.w * xb2.w);
            }
            const float rn = 1.0f / sqrtf(wave_sum(ss) * (1.f / DM) + NORM_EPS);
            if (MODE == 0) {
                const float* md = mod_next + (size_t)(row >> 13) * 6144 + lane * 32; const float* gn = g_next + lane * 32;
                unsigned ow[16];
#pragma unroll
                for (int q4 = 0; q4 < 8; ++q4) { const f32x4 gg = *(const f32x4*)(gn + 4 * q4), sc4 = *(const f32x4*)(md + 2048 + 4 * q4), sh4 = *(const f32x4*)(md + 4 * q4);
                    ow[2 * q4] = cvtpk(acc[2 * q4].x * rn * gg.x * (1.f + sc4.x) + sh4.x, acc[2 * q4].y * rn * gg.y * (1.f + sc4.y) + sh4.y);
                    ow[2 * q4 + 1] = cvtpk(acc[2 * q4 + 1].x * rn * gg.z * (1.f + sc4.z) + sh4.z, acc[2 * q4 + 1].y * rn * gg.w * (1.f + sc4.w) + sh4.w); }
                bf16* hw = hbuf + row * 2048 + lane * 32;
#pragma unroll
                for (int q4 = 0; q4 < 4; ++q4) *(u32x4*)(hw + 8 * q4) = (u32x4){ow[4 * q4], ow[4 * q4 + 1], ow[4 * q4 + 2], ow[4 * q4 + 3]};
            } else {
                const float* gn = g_next + lane * 32;
#pragma unroll
                for (int q4 = 0; q4 < 8; ++q4) { const f32x4 gg = *(const f32x4*)(gn + 4 * q4); f32x4 o;
                    o.x = acc[2 * q4].x * rn * gg.x; o.y = acc[2 * q4].y * rn * gg.y; o.z = acc[2 * q4 + 1].x * rn * gg.z; o.w = acc[2 * q4 + 1].y * rn * gg.w;
                    *(f32x4*)(fout + row * 2048 + lane * 32 + 4 * q4) = o; }
            }
        }
    }
    __syncthreads();
#undef PWS
#undef q
#undef subk
#undef utab
#undef vtab
#undef tscale
#undef hbuf
#undef xbuf
#undef fout
#undef gate
#undef g_next
#undef mod_next
}
namespace flow {
constexpr size_t WS_FLOW = WS_CTL + 40960;
constexpr int SLOT_LDS = LDS_BYTES - 16;
#define FLOW_RLX __ATOMIC_RELAXED, __HIP_MEMORY_SCOPE_AGENT
#ifndef FLOW_BFS
#define FLOW_BFS 0
#endif
#ifndef FLOW_PCAP
#define FLOW_PCAP 24
#endif
struct R1 {
    static constexpr int NST = 5, BASE = 0, PST = 3;
    static __device__ __forceinline__ int cnt(int st) { return st == 1 ? 4 : st == 4 ? 15 : 8; }
    static __device__ __forceinline__ int dep(int st) { return st - 1; }
    static __device__ __forceinline__ int depn(int st) { return st == 2 ? 4 : 8; }
    static __device__ __forceinline__ int prio(int p) { return p == 4 ? 4 : 3 - p; }
};
struct R2 {
    static constexpr int NST = 4, BASE = 1024, PST = 3;
    static __device__ __forceinline__ int cnt(int st) { return st == 1 ? 4 : 8; }
    static __device__ __forceinline__ int dep(int st) { return st - 1; }
    static __device__ __forceinline__ int depn(int st) { return st == 2 ? 4 : 8; }
    static __device__ __forceinline__ int prio(int p) { return FLOW_BFS ? p : 3 - p; }
};
struct Q { unsigned* base; int home; unsigned par; };
__device__ __forceinline__ unsigned* arrive_ctr(const Q& q, int st, int rt) { return q.base + (rt & 7) * 64 + 16 + st * 8 + (rt >> 3); }
__device__ __forceinline__ unsigned* pact_ctr(const Q& q, int xq) { return q.base + xq * 64 + 8; }
template <class R>
__device__ __forceinline__ int scan_xcd(const Q& q, int xq, int only) {
    const int lane = threadIdx.x & 63; const bool l0 = (lane == 0);
    unsigned* blk = q.base + xq * 64;
    const int v = (int)__hip_atomic_load(blk + lane, FLOW_RLX);
    bool all_ex = true;
    for (int p = 0; p < R::NST; ++p) {
        const int st = only >= 0 ? only : R::prio(p), c = R::cnt(st);
        const int h = __builtin_amdgcn_readlane(v, st);
        if (h < 8 * c) {
            all_ex = false;
            const int kk = h / c, ix = h - kk * c;
            const bool dep_ok = R::dep(st) < 0 || __builtin_amdgcn_readlane(v, 16 + R::dep(st) * 8 + kk) >= R::depn(st);
            const bool cap_ok = st != R::PST || __builtin_amdgcn_readlane(v, 8) < FLOW_PCAP;
            if (dep_ok && cap_ok) {
                unsigned ok = 0u; if (l0) { unsigned ex = (unsigned)h; ok = __hip_atomic_compare_exchange_strong(blk + st, &ex, (unsigned)h + 1u, __ATOMIC_RELAXED, __ATOMIC_RELAXED, __HIP_MEMORY_SCOPE_AGENT) ? 1u : 0u; }
                if (!__builtin_amdgcn_readfirstlane((int)ok)) return -3;
                if (st == R::PST && l0) (void)__hip_atomic_fetch_add(blk + 8, 1u, FLOW_RLX);
                return (xq << 24) | (st << 16) | ((kk * 8 + xq) << 8) | ix;
            }
        }
        if (only >= 0) break;
    }
    return all_ex ? -2 : -1;
}
template <class R, bool IN_GEMM>
__device__ __forceinline__ int pop(LAS unsigned char* lds, Q& q, int only) {
    if (!IN_GEMM) __syncthreads();
    LAS volatile int* slot = (LAS volatile int*)(lds + SLOT_LDS) + (q.par & 1u);
    if (__builtin_amdgcn_readfirstlane((int)(threadIdx.x >> 6)) == 0) {
        int r = -1;
        if (IN_GEMM) { do { r = scan_xcd<R>(q, q.home, only); } while (r == -3); if (r < 0) r = -1; }
        else for (;;) {
            bool all_ex = true;
            for (int xi = 0; xi < 8; ++xi) { const int xq = (q.home + xi) & 7; int c;
                do { c = scan_xcd<R>(q, xq, -1); } while (c == -3);
                if (c >= 0) { r = c; break; } if (c == -1) all_ex = false; }
            if (r >= 0 || all_ex) break;
            r = -1; __builtin_amdgcn_s_sleep(64);
        }
        if (threadIdx.x == 0) *slot = r;
        asm volatile("s_waitcnt lgkmcnt(0)" ::: "memory");
    }
    __builtin_amdgcn_s_barrier();
    const int r = __builtin_amdgcn_readfirstlane(*slot);
    ++q.par;
    return r;
}
__device__ __forceinline__ void acquire() { __builtin_amdgcn_fence(__ATOMIC_ACQUIRE, "agent"); }
template <bool RAW_BAR>
__device__ __forceinline__ void publish(unsigned* c, unsigned* dec) {
    asm volatile("s_waitcnt vmcnt(0)" ::: "memory");
    if (RAW_BAR) __builtin_amdgcn_s_barrier(); else __syncthreads();
    if (threadIdx.x == 0) { __builtin_amdgcn_fence(__ATOMIC_RELEASE, "agent"); asm volatile("s_waitcnt vmcnt(0)" ::: "memory"); (void)__hip_atomic_fetch_add(c, 1u, FLOW_RLX);
        if (dec) (void)__hip_atomic_fetch_sub(dec, 1u, FLOW_RLX); }
}
template <class R, int ST>
struct GOrder {
    LAS unsigned char* lds; Q* q; int first;
    __device__ __forceinline__ bool next(int i, pg8::Unit& u) {
        const int t = (i == 0) ? first : pop<R, true>(lds, *q, ST);
        if (t >= 0) { u.pm = (t >> 8) & 255; u.pn = t & 255; return true; }
        return false;
    }
    __device__ __forceinline__ void a_ready(const pg8::Unit&) const { if (R::dep(ST) >= 0) acquire(); }
    __device__ __forceinline__ void done(const pg8::Unit& u) const { publish<true>(arrive_ctr(*q, ST, u.pm), nullptr); }
};
}
#ifndef PRO_SKIP
#define PRO_SKIP 0
#endif
#ifndef DEFER_PRO
#define DEFER_PRO 0
#endif


constexpr int N_PHASES = 17;
#ifndef STOP_AFTER
#define STOP_AFTER 15
#endif
#ifndef N_LAUNCH_MODE
#define N_LAUNCH_MODE 1
#endif

__device__ __forceinline__ void cvt_rows_bf16(const float* src, bf16* dst, size_t nvec8, size_t gtid, size_t nthr) {
    for (size_t i = gtid; i < nvec8; i += nthr) {
        const f32x4 a = *(const f32x4*)(src + i * 8), b = *(const f32x4*)(src + i * 8 + 4);
        u32x4 w; w.x = cvtpk(a.x, a.y); w.y = cvtpk(a.z, a.w); w.z = cvtpk(b.x, b.y); w.w = cvtpk(b.z, b.w);
        *(u32x4*)(dst + i * 8) = w;
    }
}
typedef float v16f_t __attribute__((ext_vector_type(16)));

#ifndef FP6_INTERLEAVED
#define FP6_INTERLEAVED 1
#endif
__device__ __forceinline__ void row_to_fp6_pre(const float* src, f32x4 (&v)[8], int lane) {
#pragma unroll
    for (int q = 0; q < 8; ++q) v[q] = NT_ONCE ? __builtin_nontemporal_load((const f32x4*)(src + lane * 32 + 4 * q)) : *(const f32x4*)(src + lane * 32 + 4 * q);
}
__device__ __forceinline__ void row_to_fp6(const float* src, unsigned char* dst, float* scale, int lane, const f32x4 (*pre)[8] = nullptr) {
    f32x4 v[8]; float am = 0.f;
#pragma unroll
    for (int q = 0; q < 8; ++q) { v[q] = pre ? (*pre)[q] : (NT_ONCE ? __builtin_nontemporal_load((const f32x4*)(src + lane * 32 + 4 * q)) : *(const f32x4*)(src + lane * 32 + 4 * q)); const f32x4 a = __builtin_elementwise_abs(v[q]); am = fmaxf(am, fmaxf(fmaxf(a.x, a.y), fmaxf(a.z, a.w))); }
#pragma unroll
    for (int o = 1; o < 64; o <<= 1) am = fmaxf(am, __shfl_xor(am, o));
    const float sc = am > 0.f ? am * (1.f / 7.5f) : 1.f, inv = 1.f / sc;
    if (lane == 0) *scale = sc;
    v16f_t x, y;
#pragma unroll
    for (int i = 0; i < 16; ++i) {
        const int ex = FP6_INTERLEAVED ? 2 * i : i, ey = FP6_INTERLEAVED ? 2 * i + 1 : 16 + i;
        x[i] = v[ex >> 2][ex & 3] * inv; y[i] = v[ey >> 2][ey & 3] * inv;
    }
    const v6u_t p = __builtin_amdgcn_cvt_scalef32_2xpk16_fp6_f32(x, y, 1.0f);
    *(u32x4*)(dst + lane * 16) = (u32x4){p[0], p[1], p[2], p[3]}; *(u32x2*)(dst + 1024 + lane * 8) = (u32x2){p[4], p[5]};
}
__device__ __forceinline__ void ada_item(KArgs Ap, LAS unsigned char* lds, int it) {
    LAS float* sv = (LAS float*)lds; LAS float* red = (LAS float*)(lds + 32768); float* mod = (float*)((*Ap).ws + WS_MOD);
    const int li = it / 48, cgp = it % 48;
    for (int k = threadIdx.x; k < 4096; k += NTHREADS) sv[k] = siluf_((*Ap).in[1][k]);
    __syncthreads();
    gemv_item(sv, 2048, (*Ap).in[2] + (size_t)li * 2048 * 6144, 6144, cgp * 128, red, mod + (size_t)(li * 2) * 6144, mod + (size_t)(li * 2 + 1) * 6144, (*Ap).in[3] + (size_t)li * 6144);
}
__device__ __forceinline__ void phase_prologue(KArgs Ap, LAS unsigned char* lds, int vcu, int G, int skip = 0) {
    const int tid = threadIdx.x, lane = tid & 63, wave = __builtin_amdgcn_readfirstlane(tid >> 6), bx = blockIdx.x;
    unsigned char* ws = Ap->ws;
#define A (*Ap)
    {
        LAS float* sv = (LAS float*)lds; LAS float* red = (LAS float*)(lds + 32768);
        float* mod = (float*)(ws + WS_MOD); float* bias1 = (float*)(ws + WS_BIAS1);
        if (!(skip & 1)) for (int it = bx; it < 196; it += G) {
            __syncthreads();
            if (it < 192) {
                if (DEFER_PRO && G == 256 && it >= 48) continue;
                ada_item(Ap, lds, it);
            } else {
                const int kv = (it - 192) >> 1, cgp = (it - 192) & 1;
                for (int k = tid; k < 4096; k += NTHREADS) { const float p = A.in[12][(size_t)kv * 4096 + k]; sv[k] = p; sv[4096 + k] = p; }
                __syncthreads();
                gemv_item(sv, 4096, A.in[13] + (size_t)kv * 4096 * 256, 256, cgp * 128, red, bias1 + kv * 256, bias1 + 512, nullptr);
            }
        }
        __syncthreads();
    }
    {
        LAS float* scr = (LAS float*)(lds + wave * 16384);
        const int gw = vcu * NWAVES + wave, NGW = G * NWAVES;
        constexpr int I0 = 4608, I1 = I0 + 2048, I2 = I1 + 3648, I3 = I2 + 2048, I4 = I3 + 2048, I5 = I4 + 2048, I6 = I5 + 512, I7 = I6 + 512, I8 = I7 + 16, I9 = I8 + 16;
        if (!(skip & 2)) for (int it = gw; it < I9; it += NGW) {
            if (it < I0) transpose_item(A.in[5], 2048, 4608, (bf16*)(ws + WS_WIN0), 1, scr, it, lane);
            else if (it < I1) transpose_item(A.in[6], 2048, 2048, (bf16*)(ws + WS_WOUT0), 0, scr, it - I0, lane);
            else if (it < I2) transpose_item(A.in[10], 2048, 3632, (bf16*)(ws + WS_WIN1), 2, scr, it - I1, lane);
            else if (it < I3) { if (!(DEFER_PRO && G == 256)) transpose_item(A.in[11], 2048, 2048, (bf16*)(ws + WS_WOUT1), 0, scr, it - I2, lane); }
            else if (it < I4) transpose_item(A.in[15], 2048, 2048, (bf16*)(ws + WS_WQ0), 0, scr, it - I3, lane);
            else if (it < I5) { if (!(DEFER_PRO && G == 256)) transpose_item(A.in[15] + (size_t)2048 * 2048, 2048, 2048, (bf16*)(ws + WS_WQ1), 0, scr, it - I4, lane); }
            else if (it < I6) transpose_item(A.in[13], 4096, 256, (bf16*)(ws + WS_W1T), 0, scr, it - I5, lane);
            else if (it < I7) transpose_item(A.in[13] + (size_t)4096 * 256, 4096, 256, (bf16*)(ws + WS_W1T) + (size_t)256 * 4096, 0, scr, it - I6, lane);
            else if (it < I8) transpose_item(A.in[14], 256, 128, (bf16*)(ws + WS_W2T), 3, scr, it - I7, lane);
            else transpose_item(A.in[14] + (size_t)256 * 128, 256, 128, (bf16*)(ws + WS_W2T) + (size_t)256 * 256, 0, scr, it - I8, lane);
        }
    }
    {
        const size_t gtid = (size_t)vcu * NTHREADS + tid, nthr = (size_t)G * NTHREADS;
        {
            const int gw2 = vcu * NWAVES + wave, NGW2 = G * NWAVES;
            if (!(skip & 4)) for (int r = gw2; r < 2 * 16384; r += 2 * NGW2) {
                const int r2 = r + NGW2;
                const int tb = r >> 14, e = r & 16383; const float* src = (tb & 1 ? A.in[18] : A.in[17]) + ((size_t)(tb >> 1) * 16384 + e) * 2048;
                const int tb2 = r2 >> 14, e2 = r2 & 16383; const float* src2 = (tb2 & 1 ? A.in[18] : A.in[17]) + ((size_t)(tb2 >> 1) * 16384 + e2) * 2048;
                f32x4 pa[8], pb[8]; row_to_fp6_pre(src, pa, lane); row_to_fp6_pre(src2, pb, lane);
                row_to_fp6(src, ws + WS_TAB + (size_t)tb * 24 * MiB + (size_t)e * 1536, (float*)(ws + WS_TSCALE) + r, lane, &pa);
                row_to_fp6(src2, ws + WS_TAB + (size_t)tb2 * 24 * MiB + (size_t)e2 * 1536, (float*)(ws + WS_TSCALE) + r2, lane, &pb);
            }
        }
        cvt_rows_bf16(A.in[16], (bf16*)(ws + WS_SUBK), (size_t)2 * 8 * 2 * 128 * 128 / 8, gtid, nthr);
        f32x2* t64 = (f32x2*)(ws + WS_TAB64); f32x2* t128 = (f32x2*)(ws + WS_TAB128);
        if (!(skip & 8)) for (size_t i = gtid; i < (size_t)SEQ * 96; i += nthr) {
            const int pos = (int)(i / 96), r = (int)(i % 96);
            const bool is64 = r < 32; const int fi = is64 ? r : r - 32; const float dim = is64 ? 64.f : 128.f;
            const float inv = exp2f(-(2.f * (float)fi / dim) * 13.287712379549449f);
            const float ang = (float)pos * inv; float sn, cs; sincosf(ang, &sn, &cs);
            if (is64) t64[(size_t)pos * 32 + fi] = (f32x2){cs, sn}; else t128[(size_t)pos * 64 + fi] = (f32x2){cs, sn};
        }
        u32x4 z = {0u, 0u, 0u, 0u};
        for (size_t i = gtid; i < (size_t)208 * 2048 / 8; i += nthr) *(u32x4*)((bf16*)(ws + WS_WIN1) + (size_t)3632 * 2048 + i * 8) = z;
        for (size_t i = gtid; i < (size_t)2 * 128 * 256 / 8; i += nthr) { const size_t half = i / (128 * 256 / 8), r = i % (128 * 256 / 8); *(u32x4*)((bf16*)(ws + WS_W2T) + (half * 256 + 128) * 256 + r * 8) = z; }
    }
}
#undef A
template <bool XF32, bool ADDY = false>
__device__ __forceinline__ void adaln_rows(const void* X, const float* g, const float* mod, bf16* H, int vcu, int G, const bf16* Y = nullptr, bf16* XB = nullptr) {
    int tid_ = threadIdx.x; asm volatile("" : "+v"(tid_));
    const int lane = tid_ & 63, wave = __builtin_amdgcn_readfirstlane(tid_ >> 6);
    const int stride = G * NWAVES;
#pragma unroll 1
    for (int b = 0; b < T / SEQ; ++b) {
        f32x4 cs[8], sh[8];
#pragma unroll
        for (int j = 0; j < 8; ++j) { const int idx = lane * 8 + 512 * (j >> 1) + 4 * (j & 1);
            const f32x4 gg = *(const f32x4*)(g + idx), sc = *(const f32x4*)(mod + (size_t)b * 6144 + 2048 + idx);
            cs[j] = gg * (1.f + sc); sh[j] = *(const f32x4*)(mod + (size_t)b * 6144 + idx); }
        int row = b * SEQ + vcu * NWAVES + wave;
        if (row >= (b + 1) * SEQ) continue;
        f32x4 v[8];
        auto ld = [&](int r, f32x4 (&d)[8]) {
            if (XF32) { const float* xr = (const float*)X + (size_t)r * 2048;
#pragma unroll
                for (int j = 0; j < 8; ++j) d[j] = *(const f32x4*)(xr + lane * 8 + 512 * (j >> 1) + 4 * (j & 1)); }
            else { const bf16* xr = (const bf16*)X + (size_t)r * 2048;
#pragma unroll
                for (int j = 0; j < 4; ++j) { const u32x4 w = *(const u32x4*)(xr + lane * 8 + 512 * j);
                    d[2 * j] = (f32x4){bflo(w.x), bfhi(w.x), bflo(w.y), bfhi(w.y)}; d[2 * j + 1] = (f32x4){bflo(w.z), bfhi(w.z), bflo(w.w), bfhi(w.w)}; } }
            if (ADDY) {
                const bf16* yr = Y + (size_t)r * 2048; bf16* xo = XB + (size_t)r * 2048;
#pragma unroll
                for (int j = 0; j < 4; ++j) { const u32x4 w = *(const u32x4*)(yr + lane * 8 + 512 * j);
                    const f32x4 s0 = d[2 * j] + (f32x4){bflo(w.x), bfhi(w.x), bflo(w.y), bfhi(w.y)}, s1 = d[2 * j + 1] + (f32x4){bflo(w.z), bfhi(w.z), bflo(w.w), bfhi(w.w)};
                    const u32x4 pw = pack8(s0, s1); *(u32x4*)(xo + lane * 8 + 512 * j) = pw;
                    d[2 * j] = (f32x4){bflo(pw.x), bfhi(pw.x), bflo(pw.y), bfhi(pw.y)}; d[2 * j + 1] = (f32x4){bflo(pw.z), bfhi(pw.z), bflo(pw.w), bfhi(pw.w)}; }
            }
        };
        ld(row, v);
#pragma unroll 1
        for (; row < (b + 1) * SEQ; row += stride) {
            f32x4 nx[8]; const int rn = row + stride; const bool more = rn < (b + 1) * SEQ;
            if (!ADDY || more) ld(more ? rn : row, nx);
            float ss = 0.f;
#pragma unroll
            for (int j = 0; j < 8; ++j) ss += v[j].x * v[j].x + v[j].y * v[j].y + v[j].z * v[j].z + v[j].w * v[j].w;
            const float r = 1.0f / sqrtf(wave_sum(ss) * (1.f / DM) + NORM_EPS);
            bf16* hrow = H + (size_t)row * 2048;
#pragma unroll
            for (int j = 0; j < 4; ++j) {
                const f32x4 o0 = v[2 * j] * r * cs[2 * j] + sh[2 * j], o1 = v[2 * j + 1] * r * cs[2 * j + 1] + sh[2 * j + 1];
                u32x4 w; w.x = cvtpk(o0.x, o0.y); w.y = cvtpk(o0.z, o0.w); w.z = cvtpk(o1.x, o1.y); w.w = cvtpk(o1.z, o1.w);
                *(u32x4*)(hrow + lane * 8 + 512 * j) = w;
            }
#pragma unroll
            for (int j = 0; j < 8; ++j) v[j] = nx[j];
        }
    }
}
__device__ __forceinline__ void phase_adaln_bf(KArgs Ap, int li, int vcu, int G) {
    adaln_rows<false>((*Ap).ws + WS_XB, (*Ap).in[4] + (size_t)li * 2048, (const float*)((*Ap).ws + WS_MOD) + (size_t)li * 2 * 6144, (bf16*)((*Ap).ws + WS_H), vcu, G);
}
template <bool XF32>
__device__ __forceinline__ void phase_adaln_add(KArgs Ap, const void* xold, int li, int vcu, int G) {
    adaln_rows<XF32, true>(xold, (*Ap).in[4] + (size_t)li * 2048, (const float*)((*Ap).ws + WS_MOD) + (size_t)li * 2 * 6144, (bf16*)((*Ap).ws + WS_H), vcu, G, (const bf16*)((*Ap).ws + WS_Y), (bf16*)((*Ap).ws + WS_XB));
}
__device__ __forceinline__ void phase_adaln(KArgs Ap, const float* xsrc, int li, int vcu, int G) {
    adaln_rows<true>(xsrc, (*Ap).in[4] + (size_t)li * 2048, (const float*)((*Ap).ws + WS_MOD) + (size_t)li * 2 * 6144, (bf16*)((*Ap).ws + WS_H), vcu, G);
}
__device__ __forceinline__ void phase_final(KArgs Ap, const float* xsrc, int vcu, int G) {
    const int lane = threadIdx.x & 63, wave = __builtin_amdgcn_readfirstlane(threadIdx.x >> 6);
    for (int row = vcu * NWAVES + wave; row < T; row += G * NWAVES) final_row(xsrc + (size_t)row * 2048, (*Ap).in[19], (*Ap).out + (size_t)row * 2048, lane);
}

#undef A
__global__ void __launch_bounds__(NTHREADS, 2) fwd_kernel(Args Aunused) {
    extern __shared__ __attribute__((aligned(16))) unsigned char lds_raw[];
    LAS unsigned char* lds = (LAS unsigned char*)lds_raw;
    const int G = gridDim.x, bx = blockIdx.x;
    const int vcu = (G % 8 == 0) ? (bx % 8) * (G / 8) + bx / 8 : bx;
    cg::grid_group grid = cg::this_grid();
    const XcdBarrier xbar = xcd_barrier_post((unsigned*)(kargs()->ws + WS_CTL), (volatile unsigned*)(kargs()->ws + WS_CTL + 16384) + 16 * bx);
#define A (*kargs())
#define ws (kargs()->ws)
#define mod ((const float*)(ws + WS_MOD))
#define tab64 ((const f32x2*)(ws + WS_TAB64))
#define tab128 ((const f32x2*)(ws + WS_TAB128))
#define H ((bf16*)(ws + WS_H))
#define ATT ((bf16*)(ws + WS_ATT))
#define xbuf (kargs()->out)
#ifndef PHASE_MASK
#define PHASE_MASK 0x1FFFF
#endif
#define PH(k) ((((PHASE_MASK) >> (k)) & 1) && A.ph_lo <= (k) && (k) < A.ph_hi)
#define SEAM(k) do { if (PH(k) && PH((k) + 1)) { if ((k) == 0) grid.sync(); else xcd_barrier(xbar); } } while (0)
#ifndef PEER_SELONLY
#define PEER_SELONLY 0
#endif
#ifndef FLOW1
#define FLOW1 0
#endif
#ifndef P9_ALT
#define P9_ALT 1
#endif
#ifndef CMP_FUSED
#define CMP_FUSED 0
#endif
#ifndef P9_BAL
#define P9_BAL 0
#endif
#ifndef RESID_IN_NORM
#define RESID_IN_NORM 0
#endif
#ifndef FLOW2
#define FLOW2 0
#endif
#ifndef PEER_HALF_PROBE
#define PEER_HALF_PROBE 0
#endif
#ifndef REPEAT_PHASE
#define REPEAT_PHASE -1
#endif
#define REP(k) for (int rep_ = 0; rep_ < ((REPEAT_PHASE) == (k) ? 2 : 1); ++rep_, (((REPEAT_PHASE) == (k) && rep_ == 1) ? xcd_barrier(xbar) : (void)0))
    if (PH(0)) REP(0) { phase_prologue(kargs(), lds, vcu, G, rep_ ? (PRO_SKIP) : 0); }
    SEAM(0);
    if (PH(1)) REP(1) { phase_adaln(kargs(), A.in[0], 0, vcu, G); }
    SEAM(1);
    if (PH(2)) REP(2) { pg8::Gemm g{H, (const bf16*)(ws + WS_WIN0), T, 4608, 2048, 2048}; pg8::StaticOrder S; S.init(T, 4608, G, bx);
        EpiQKV0 E{(bf16*)(ws + WS_QKV), tab64}; pg8::gemm_phase<EpiQKV0, pg8::StaticOrder, true, true>(lds, g, S, E); }
    if (DEFER_PRO && PH(2) && bx >= 128 && G == 256) {
        for (int it = 48 + (bx - 128); it < 192; it += 128) { __syncthreads(); ada_item(kargs(), lds, it); }
        __syncthreads();
    }
    SEAM(2);
    if (PH(3)) REP(3) {
        const bf16* qkv = (const bf16*)(ws + WS_QKV);
        float lam;
        { const float* lv = A.in[7]; const int lane = threadIdx.x & 63; const float d1 = wave_sum(lv[lane] * lv[64 + lane]), d2 = wave_sum(lv[128 + lane] * lv[192 + lane]); lam = __expf(d1) - __expf(d2) + 0.2f; }
#ifndef SKIP_DA
#define SKIP_DA 0
#endif
        if (SKIP_DA) { for (size_t i = (size_t)vcu * NTHREADS + threadIdx.x; i < (size_t)T * 128; i += (size_t)G * NTHREADS) { const size_t r = i >> 7, cc = i & 127; *(u32x4*)(ATT + r * 2048 + cc * 8) = (u32x4){0u, 0u, 0u, 0u}; } }
        else for (int n = vcu; n < 256; n += G)
            for (int i = 0; i < 2; ++i) { const int bh = n >> 4, s = n & 15, qb = i == 0 ? s : 31 - s; __syncthreads(); da_unit(lds, qkv, ATT, bh >> 3, bh & 7, qb, lam, A.in[8], (float*)(ws + WS_SLOT)); }
#ifndef NAIVE_SWA
#define NAIVE_SWA 0
#endif
#ifndef SKIP_SWA
#define SKIP_SWA 0
#endif
        if (SKIP_SWA) { for (size_t i = (size_t)vcu * NTHREADS + threadIdx.x; i < (size_t)T * 128; i += (size_t)G * NTHREADS) { const size_t r = i >> 7, cc = i & 127; *(u32x4*)(ATT + r * 2048 + 1024 + cc * 8) = (u32x4){0u, 0u, 0u, 0u}; } }
        else if (NAIVE_SWA) { const int wv = __builtin_amdgcn_readfirstlane(threadIdx.x >> 6);
            for (int it = vcu * NWAVES + wv; it < T * 16; it += G * NWAVES) swa_naive(qkv, ATT, (it >> 4) >> 13, (it >> 4) & (SEQ - 1), it & 15, A.in[9], threadIdx.x & 63); }
        else
        for (int n = vcu; n < 1024; n += G) { __syncthreads(); swa_unit(lds, qkv, ATT, n >> 9, (n >> 7) & 3, n & 127, A.in[9]); }
    }
    SEAM(3);
#if FLOW1
    if (PH(4)) {
        using R = flow::R1;
        flow::Q fq{(unsigned*)(ws + flow::WS_FLOW) + R::BASE, (int)(xbar.x & 7u), 0u};
        for (int t = flow::pop<R, false>(lds, fq, -1); t >= 0; t = flow::pop<R, false>(lds, fq, -1)) {
            const int xq = (t >> 24) & 7, st = (t >> 16) & 255, rt = (t >> 8) & 255, ix = t & 255;
            if (st == 0) { pg8::Gemm g{ATT, (const bf16*)(ws + WS_WOUT0), T, 2048, 2048, 2048}; EpiResid<true> E{A.in[0], (bf16*)(ws + WS_XB), mod + 4096};
                flow::GOrder<R, 0> S{lds, &fq, t}; pg8::gemm_phase<EpiResid<true>, flow::GOrder<R, 0>, true, true>(lds, g, S, E); }
            else if (st == 2) { pg8::Gemm g{H, (const bf16*)(ws + WS_WQ0), T, 2048, 2048, 2048}; EpiPlain E{(bf16*)(ws + WS_Q1), 2048};
                flow::GOrder<R, 2> S{lds, &fq, t}; pg8::gemm_phase<EpiPlain, flow::GOrder<R, 2>, true, true>(lds, g, S, E); }
            else if (st == 4) { pg8::Gemm g{H, (const bf16*)(ws + WS_WIN1), T, 3840, 2048, 2048}; EpiQKV1 E{ws, tab128};
                flow::GOrder<R, 4> S{lds, &fq, t}; pg8::gemm_phase<EpiQKV1, flow::GOrder<R, 4>, true, true>(lds, g, S, E); }
            else if (st == 1) {
                flow::acquire();
                int tid_ = threadIdx.x; asm volatile("" : "+v"(tid_));
                const int lane = tid_ & 63, wave = __builtin_amdgcn_readfirstlane(tid_ >> 6);
                const float* md = mod + (size_t)1 * 2 * 6144; const float* gg = A.in[4] + (size_t)1 * 2048;
                for (int i = 0; i < 8; ++i) { const int row = rt * 256 + ix * 64 + wave * 8 + i; adaln_row_bf((const bf16*)(ws + WS_XB) + (size_t)row * 2048, gg, md + (size_t)(row >> 13) * 6144, H + (size_t)row * 2048, lane); }
                flow::publish<false>(flow::arrive_ctr(fq, 1, rt), nullptr);
            } else {
                flow::acquire();
                peer_tile<0>(lds, rt * 8 + ix, 0, xbar);
                flow::publish<false>(flow::arrive_ctr(fq, 3, rt), flow::pact_ctr(fq, xq));
            }
        }
    }
#else
#if RESID_IN_NORM
    if (PH(4)) REP(4) { pg8::Gemm g{ATT, (const bf16*)(ws + WS_WOUT0), T, 2048, 2048, 2048}; pg8::StaticOrder S; S.init(T, 2048, G, bx);
        EpiGate E{(bf16*)(ws + WS_Y), mod + 4096}; pg8::gemm_phase<EpiGate, pg8::StaticOrder, true, true>(lds, g, S, E); }
    SEAM(4);
    if (PH(5)) { phase_adaln_add<true>(kargs(), A.in[0], 1, vcu, G); }
#else
    if (PH(4)) REP(4) { pg8::Gemm g{ATT, (const bf16*)(ws + WS_WOUT0), T, 2048, 2048, 2048}; pg8::StaticOrder S; S.init(T, 2048, G, bx);
        EpiResid<true> E{A.in[0], (bf16*)(ws + WS_XB), mod + 4096}; pg8::gemm_phase<EpiResid<true>, pg8::StaticOrder, true, true>(lds, g, S, E); }
    SEAM(4);
    if (PH(5)) REP(5) { phase_adaln_bf(kargs(), 1, vcu, G); }
#endif
    SEAM(5);
    if (PH(6)) REP(6) { pg8::Gemm g{H, (const bf16*)(ws + WS_WQ0), T, 2048, 2048, 2048}; pg8::StaticOrder S; S.init(T, 2048, G, bx);
        EpiPlain E{(bf16*)(ws + WS_Q1), 2048}; pg8::gemm_phase<EpiPlain, pg8::StaticOrder, true, true>(lds, g, S, E); }
    SEAM(6);
    if (PH(7)) REP(7) {
        if (REPEAT_PHASE == 7 && rep_ == 0 && PEER_HALF_PROBE >= 2) {
            if (((bx >> 3) & 1) == 0) { if (PEER_HALF_PROBE == 2) for (int tile = vcu; tile < 512; tile += G) peer_tile<0, true, false>(lds, tile, 0, xbar); }
            else { const int c = (bx >> 4) * 8 + (bx & 7);
                for (int r2 = 0; r2 < 2; ++r2) { pg8::Gemm g{H, (const bf16*)(ws + WS_WQ0), T, 2048, 2048, 2048}; pg8::StaticOrder S; S.init(T, 2048, 128, c);
                    EpiPlain E{ATT, 2048}; pg8::gemm_phase<EpiPlain, pg8::StaticOrder, true, true>(lds, g, S, E); } }
        } else
        for (int tile = vcu; tile < 512; tile += G)
            if (REPEAT_PHASE == 7 && rep_ == 0) { if (!(PEER_HALF_PROBE) || ((bx >> 3) & 1) == 0) peer_tile<0, true, (PEER_SELONLY != 0)>(lds, tile, 0, xbar); }
            else peer_tile<0>(lds, tile, 0, xbar);
    }
    SEAM(7);
    if (PH(8)) REP(8) { pg8::Gemm g{H, (const bf16*)(ws + WS_WIN1), T, 3840, 2048, 2048}; pg8::StaticOrder S; S.init(T, 3840, G, bx);
        EpiQKV1 E{ws, tab128}; pg8::gemm_phase<EpiQKV1, pg8::StaticOrder, true, true>(lds, g, S, E); }
#endif
    if (DEFER_PRO && PH(8) && bx >= 192 && G == 256) {
        __syncthreads();
        const int lane = threadIdx.x & 63, wv = __builtin_amdgcn_readfirstlane(threadIdx.x >> 6);
        LAS float* scr = (LAS float*)(lds + wv * 16384);
        for (int it = (bx - 192) * NWAVES + wv; it < 4096; it += 64 * NWAVES) {
            if (it < 2048) transpose_item(A.in[11], 2048, 2048, (bf16*)(ws + WS_WOUT1), 0, scr, it, lane);
            else transpose_item(A.in[15] + (size_t)2048 * 2048, 2048, 2048, (bf16*)(ws + WS_WQ1), 0, scr, it - 2048, lane);
        }
        __syncthreads();
    }
    SEAM(8);
    if (PH(9) && bx >= 16) {
        const int lane = threadIdx.x & 63, wv = __builtin_amdgcn_readfirstlane(threadIdx.x >> 6);
#pragma unroll 1
        for (int half = 0; half < 2; ++half) {
            if ((half == 0) == (((bx >> 3) & 1) == 0 || !P9_ALT)) {
                for (int un = bx - 16; un < 1024; un += G - 16) nsa_window_unit(lds, un >> 9, (un >> 8) & 1, un & 255);
                __syncthreads();
            } else if (P9_BAL && G == 256) {
                int start, cnt; { const int hb = bx - 16;
                    if (hb < 64) { const int w5 = hb * NWAVES + wv; start = 27648 + w5 * 10; cnt = 10; }
                    else { const int w4 = (hb - 64) * NWAVES + wv; start = w4 * 19 + (w4 < 896 ? w4 : 896); cnt = 19 + (w4 < 896 ? 1 : 0); } }
                auto srcp = [&](int r) { const int rr = 2 * 16384 + r, tb = rr >> 14, e = rr & 16383; return (tb & 1 ? A.in[18] : A.in[17]) + ((size_t)(tb >> 1) * 16384 + e) * 2048; };
                auto conv = [&](int r, const f32x4 (&p)[8]) { const int rr = 2 * 16384 + r, tb = rr >> 14, e = rr & 16383;
                    row_to_fp6(nullptr, ws + WS_TAB + (size_t)tb * 24 * MiB + (size_t)e * 1536, (float*)(ws + WS_TSCALE) + rr, lane, &p); };
                f32x4 pa[8], pb[8]; row_to_fp6_pre(srcp(start), pa, lane); row_to_fp6_pre(srcp(start + 1), pb, lane);
#pragma unroll 1
                for (int i = 0; i < cnt; i += 2) {
                    f32x4 na[8], nb[8]; const int j0 = i + 2 < cnt ? i + 2 : i, j1 = i + 3 < cnt ? i + 3 : i;
                    row_to_fp6_pre(srcp(start + j0), na, lane); row_to_fp6_pre(srcp(start + j1), nb, lane);
                    conv(start + i, pa); if (i + 1 < cnt) conv(start + i + 1, pb);
#pragma unroll
                    for (int q = 0; q < 8; ++q) { pa[q] = na[q]; pb[q] = nb[q]; }
                }
            } else {
                for (int r = 2 * 16384 + (bx - 16) * NWAVES + wv; r < 4 * 16384; r += 2 * (G - 16) * NWAVES) {
                    const int r2 = r + (G - 16) * NWAVES; const bool two = r2 < 4 * 16384;
                    const int tb = r >> 14, e = r & 16383; const float* src = (tb & 1 ? A.in[18] : A.in[17]) + ((size_t)(tb >> 1) * 16384 + e) * 2048;
                    const int rr = two ? r2 : r, tb2 = rr >> 14, e2 = rr & 16383; const float* src2 = (tb2 & 1 ? A.in[18] : A.in[17]) + ((size_t)(tb2 >> 1) * 16384 + e2) * 2048;
                    f32x4 pa[8], pb[8]; row_to_fp6_pre(src, pa, lane); row_to_fp6_pre(src2, pb, lane);
                    row_to_fp6(src, ws + WS_TAB + (size_t)tb * 24 * MiB + (size_t)e * 1536, (float*)(ws + WS_TSCALE) + r, lane, &pa);
                    if (two) row_to_fp6(src2, ws + WS_TAB + (size_t)tb2 * 24 * MiB + (size_t)e2 * 1536, (float*)(ws + WS_TSCALE) + rr, lane, &pb);
                }
            }
        }
    }
    if (PH(9)) REP(9) { pg8::Gemm g{(const bf16*)(ws + WS_KCVC), (const bf16*)(ws + WS_W1T), 4096, 512, 4096, 2048}; CmpOrder S{bx};
        EpiCmp1 E{(bf16*)(ws + WS_HID), (const float*)(ws + WS_BIAS1)}; pg8::gemm_phase<EpiCmp1, CmpOrder, false, true>(lds, g, S, E); }
#if CMP_FUSED
    if (PH(9) && bx < 16) { __threadfence(); __syncthreads();
        pg8::Gemm g{(const bf16*)(ws + WS_HID), (const bf16*)(ws + WS_W2T), 4096, 512, 256, 256}; CmpOrder S{bx};
        EpiCmp2 E{(bf16*)(ws + WS_KCMP), (bf16*)(ws + WS_VCMP), tab128}; pg8::gemm_phase<EpiCmp2, CmpOrder, false, true>(lds, g, S, E); }
    if (PH(9) && PH(11)) xcd_barrier(xbar);
#else
    SEAM(9);
    if (PH(10)) { pg8::Gemm g{(const bf16*)(ws + WS_HID), (const bf16*)(ws + WS_W2T), 4096, 512, 256, 256}; CmpOrder S{bx};
        EpiCmp2 E{(bf16*)(ws + WS_KCMP), (bf16*)(ws + WS_VCMP), tab128}; pg8::gemm_phase<EpiCmp2, CmpOrder, false, true>(lds, g, S, E); }
    SEAM(10);
#endif
    if (PH(11)) REP(11) {
        if (vcu < 256) {
#pragma unroll 1
            for (int i = 0; i < 4; ++i) nsa_unit(lds, i >> 1, i & 1, (i & 1) ? 255 - vcu : vcu);
        }
    }
    SEAM(11);
#if FLOW2
    if (PH(12)) {
        using R = flow::R2;
        flow::Q fq{(unsigned*)(ws + flow::WS_FLOW) + R::BASE, (int)(xbar.x & 7u), 0u};
        for (int t = flow::pop<R, false>(lds, fq, -1); t >= 0; t = flow::pop<R, false>(lds, fq, -1)) {
            const int xq = (t >> 24) & 7, st = (t >> 16) & 255, rt = (t >> 8) & 255, ix = t & 255;
            if (st == 0) { pg8::Gemm g{ATT, (const bf16*)(ws + WS_WOUT1), T, 2048, 2048, 2048}; EpiResid<false> E{(const bf16*)(ws + WS_XB), (bf16*)(ws + WS_XB), mod + (size_t)2 * 2 * 6144 + 4096};
                flow::GOrder<R, 0> S{lds, &fq, t}; pg8::gemm_phase<EpiResid<false>, flow::GOrder<R, 0>, true, true>(lds, g, S, E); }
            else if (st == 2) { pg8::Gemm g{H, (const bf16*)(ws + WS_WQ1), T, 2048, 2048, 2048}; EpiPlain E{(bf16*)(ws + WS_Q1), 2048};
                flow::GOrder<R, 2> S{lds, &fq, t}; pg8::gemm_phase<EpiPlain, flow::GOrder<R, 2>, true, true>(lds, g, S, E); }
            else if (st == 1) {
                flow::acquire();
                int tid_ = threadIdx.x; asm volatile("" : "+v"(tid_));
                const int lane = tid_ & 63, wave = __builtin_amdgcn_readfirstlane(tid_ >> 6);
                const float* md = mod + (size_t)3 * 2 * 6144; const float* gg = A.in[4] + (size_t)3 * 2048;
                for (int i = 0; i < 8; ++i) { const int row = rt * 256 + ix * 64 + wave * 8 + i; adaln_row_bf((const bf16*)(ws + WS_XB) + (size_t)row * 2048, gg, md + (size_t)(row >> 13) * 6144, H + (size_t)row * 2048, lane); }
                flow::publish<false>(flow::arrive_ctr(fq, 1, rt), nullptr);
            } else {
                flow::acquire();
                peer_tile<1>(lds, rt * 8 + ix, 1, xbar);
                flow::publish<false>(flow::arrive_ctr(fq, 3, rt), flow::pact_ctr(fq, xq));
            }
        }
    }
#else
#if RESID_IN_NORM
    if (PH(12)) REP(12) { pg8::Gemm g{ATT, (const bf16*)(ws + WS_WOUT1), T, 2048, 2048, 2048}; pg8::StaticOrder S; S.init(T, 2048, G, bx);
        EpiGate E{(bf16*)(ws + WS_Y), mod + (size_t)2 * 2 * 6144 + 4096}; pg8::gemm_phase<EpiGate, pg8::StaticOrder, true, true>(lds, g, S, E); }
    SEAM(12);
    if (PH(13)) phase_adaln_add<false>(kargs(), ws + WS_XB, 3, vcu, G);
#else
    if (PH(12)) REP(12) { pg8::Gemm g{ATT, (const bf16*)(ws + WS_WOUT1), T, 2048, 2048, 2048}; pg8::StaticOrder S; S.init(T, 2048, G, bx);
        EpiResid<false> E{(const bf16*)(ws + WS_XB), (bf16*)(ws + WS_XB), mod + (size_t)2 * 2 * 6144 + 4096}; pg8::gemm_phase<EpiResid<false>, pg8::StaticOrder, true, true>(lds, g, S, E); }
    SEAM(12);
    if (PH(13)) phase_adaln_bf(kargs(), 3, vcu, G);
#endif
    SEAM(13);
    if (PH(14)) REP(14) { pg8::Gemm g{H, (const bf16*)(ws + WS_WQ1), T, 2048, 2048, 2048}; pg8::StaticOrder S; S.init(T, 2048, G, bx);
        EpiPlain E{(bf16*)(ws + WS_Q1), 2048}; pg8::gemm_phase<EpiPlain, pg8::StaticOrder, true, true>(lds, g, S, E); }
    SEAM(14);
    if (PH(15)) REP(15) {
        for (int tile = vcu; tile < 512; tile += G)
            peer_tile<1>(lds, tile, 1, xbar);
    }
#endif
    SEAM(15);
    if (PH(16)) phase_final(kargs(), (STOP_AFTER < 4) ? A.in[0] : (const float*)xbuf, vcu, G);
#undef PH
#undef SEAM
#undef A
#undef ws
#undef mod
#undef tab64
#undef tab128
#undef H
#undef ATT
#undef xbuf
}

extern "C" void kernel_launch(void* const* d_in, const int* in_sizes, int n_in, void* d_out, int out_size, void* d_ws, size_t ws_size, hipStream_t stream) {
    static int grid = 0;
    if (grid == 0) {
        if (n_in != 20 || out_size != T * DM || ws_size < WS_END) { fprintf(stderr, "kernel_launch: unexpected problem (n_in %d out %d ws %zu)\n", n_in, out_size, ws_size); grid = -1; return; }
        int dev = 0, cus = 0, per_cu = 0;
        hipGetDevice(&dev); hipDeviceGetAttribute(&cus, hipDeviceAttributeMultiprocessorCount, dev);
        hipFuncSetAttribute((const void*)fwd_kernel, hipFuncAttributeMaxDynamicSharedMemorySize, LDS_BYTES);
        hipOccupancyMaxActiveBlocksPerMultiprocessor(&per_cu, (const void*)fwd_kernel, NTHREADS, LDS_BYTES);
        (void)hipGetLastError();
        if (per_cu < 1) { fprintf(stderr, "kernel_launch: occupancy query says %d blocks per CU\n", per_cu); per_cu = 1; }
        grid = cus;
        if (grid > 256) grid = 256;
    }
    if (grid < 0) return;
    (void)hipMemsetAsync((char*)d_ws + WS_CTL, 0, 65536, stream);
    Args a{};
    for (int i = 0; i < 20; ++i) a.in[i] = (const float*)d_in[i];
    a.out = (float*)d_out; a.ws = (unsigned char*)d_ws;
#if N_LAUNCH_MODE == 1
    a.ph_lo = 0; a.ph_hi = (STOP_AFTER < 15) ? N_PHASES : 16;
    if (STOP_AFTER < 15) {
        a.ph_hi = STOP_AFTER + 1; void* args1[] = {&a};
        hipLaunchCooperativeKernel((const void*)fwd_kernel, dim3(grid), dim3(NTHREADS), args1, LDS_BYTES, stream);
        Args b = a; b.ph_lo = 16; b.ph_hi = 17; void* args2[] = {&b};
        hipLaunchCooperativeKernel((const void*)fwd_kernel, dim3(grid), dim3(NTHREADS), args2, LDS_BYTES, stream);
    } else {
        void* args[] = {&a};
        hipError_t e = hipLaunchCooperativeKernel((const void*)fwd_kernel, dim3(grid), dim3(NTHREADS), args, LDS_BYTES, stream);
        if (e != hipSuccess) fprintf(stderr, "cooperative launch failed: %s (grid %d)\n", hipGetErrorString(e), grid);
    }
#else
    for (int p = 0; p < N_PHASES; ++p) {
        if (p > STOP_AFTER && p != 16) continue;
        if (p == 16 && STOP_AFTER >= 15) continue;
        Args b = a; b.ph_lo = p; b.ph_hi = p + 1;
        hipLaunchKernelGGL(fwd_kernel, dim3(grid), dim3(NTHREADS), LDS_BYTES, stream, b);
    }
#endif
}
```

```cpp
#include <hip/hip_runtime.h>
#include <hip/hip_cooperative_groups.h>
#include <cstdio>
#include <cstdint>
namespace pg8 {
#define PG8_LAS __attribute__((address_space(3)))
typedef unsigned short bf16_t;
typedef short bf16x8 __attribute__((ext_vector_type(8)));
typedef float f32x4 __attribute__((ext_vector_type(4)));
typedef unsigned u32x4 __attribute__((ext_vector_type(4)));
constexpr int BM = 256, BK = 64, HALF = 128, HTB = HALF * BK * 2  , STAGE_BYTES = 8 * HTB, NXCD = 8, WGM = 8;

__host__ __device__ __forceinline__ int lds_byte(int r, int c) { const int st = (r >> 4) * 2 + (c >> 5), rr = r & 15, cc = c & 31, ob = rr * 64 + cc * 2; return st * 1024 + (ob ^ (((ob >> 9) & 1) << 5)); }
__host__ __device__ __forceinline__ void stage_rc(int b, int& R, int& C) { const int st = b / 1024, sb = b % 1024, swz = sb ^ (((sb >> 9) & 1) << 5); R = (st >> 1) * 16 + swz / 64; C = (st & 1) * 32 + (swz % 64) / 2; }
__host__ __device__ __forceinline__ int perm32(int rho) { const int n = rho >> 4, i = rho & 15; return 8 * (i >> 2) + 4 * n + (i & 3); }

struct Unit { int pm, pn; };
struct Gemm { const bf16_t* A; const bf16_t* Bt; int M, N, K, lda; };

struct StaticOrder {
    int nM, nN, nwg, G, c;
    __host__ __device__ void init(int M, int N, int G_, int c_) { nM = M / BM; nN = N / BM; nwg = nM * nN; G = G_; c = c_; }
    __host__ __device__ bool next(int i, Unit& u) const {
        const long L = (long)i * G + c; if (L >= nwg) return false;
        int wgid = (int)L; { const int q = nwg / NXCD, r = nwg % NXCD, xcd = wgid % NXCD, off = wgid / NXCD; wgid = (xcd < r ? xcd * (q + 1) : r * (q + 1) + (xcd - r) * q) + off; }
        const int nig = WGM * nN, gid = wgid / nig, fm = gid * WGM, gsz = (nM - fm) < WGM ? (nM - fm) : WGM;
        u.pm = fm + ((wgid % nig) % gsz); u.pn = (wgid % nig) / gsz; return true;
    }
    __device__ __forceinline__ void a_ready(const Unit&) const {}
    __device__ __forceinline__ void done(const Unit&) const {}
};

__device__ __forceinline__ unsigned cvt_pk_bf16(float lo, float hi) { unsigned r; asm volatile("v_cvt_pk_bf16_f32 %0, %1, %2" : "=v"(r) : "v"(lo), "v"(hi)); return r; }
typedef float f32x2 __attribute__((ext_vector_type(2)));
template <class Epi, class Sched, bool ALIGN_EPI = false, bool SP2 = false>
__device__ __forceinline__ void gemm_phase(PG8_LAS unsigned char* lds, const Gemm g, Sched& S, const Epi& E) {
    int tid_ = threadIdx.x; asm volatile("" : "+v"(tid_));
    const int tid = tid_, wid = __builtin_amdgcn_readfirstlane(tid >> 6), lane = tid & 63, wr = wid >> 2, wc = wid & 3, fr = lane & 15, fq = lane >> 4;
    const int K = g.K, nt = K / BK, LDA = g.lda;
    unsigned voffA[2], voffB[2];
#pragma unroll
    for (int i = 0; i < 2; ++i) { int R, C; stage_rc(tid * 16 + i * 8192, R, C); const int Rb = Epi::PERM ? ((R & ~31) + perm32(R & 31)) : R;
        voffA[i] = (unsigned)(R * LDA + C) * 2u; voffB[i] = (unsigned)(Rb * K + C) * 2u; }
    const size_t kstep = (size_t)(BK * 2);
    const size_t hstepB = (size_t)HALF * K * 2, hstepA = (size_t)HALF * LDA * 2;
    const size_t tstepA = 2 * hstepA, tstepB = 2 * hstepB;
    const unsigned ldsw = (unsigned)wid * 1024u;
    const int aoff = lds_byte(wr * 64 + fr, fq * 8), boff = lds_byte(wc * 32 + fr, fq * 8);
#define PG8_SA(b, h) (((b) * 2 + (h)) * HTB)
#define PG8_SB(b, h) ((4 + (b) * 2 + (h)) * HTB)
#define PG8_STAGE(bufoff, gbase, voff) do { _Pragma("unroll") for (int _i = 0; _i < 2; ++_i) \
        __builtin_amdgcn_global_load_lds((const unsigned*)((const char*)(gbase) + (voff)[_i]), (PG8_LAS unsigned*)(lds + (bufoff) + ldsw + _i * 8192), 16, 0, 0); } while (0)
#define PG8_LDA(dst, b, h) do { _Pragma("unroll") for (int m = 0; m < 4; ++m) _Pragma("unroll") for (int k = 0; k < 2; ++k) dst[m][k] = *(const PG8_LAS bf16x8*)(lds + PG8_SA(b, h) + aoff + m * 2048 + k * 1024); } while (0)
#define PG8_LDB(dst, b, h) do { _Pragma("unroll") for (int n = 0; n < 2; ++n) _Pragma("unroll") for (int k = 0; k < 2; ++k) dst[n][k] = *(const PG8_LAS bf16x8*)(lds + PG8_SB(b, h) + boff + n * 2048 + k * 1024); } while (0)
#define PG8_MMA(ai, bj, At, Bt) do { __builtin_amdgcn_s_setprio(1); _Pragma("unroll") for (int m = 0; m < 4; ++m) _Pragma("unroll") for (int n = 0; n < 2; ++n) _Pragma("unroll") for (int k = 0; k < 2; ++k) \
        acc[ai][bj][m][n] = __builtin_amdgcn_mfma_f32_16x16x32_bf16(Bt[n][k], At[m][k], acc[ai][bj][m][n], 0, 0, 0); __builtin_amdgcn_s_setprio(0); } while (0)
#define PG8_WAIT_V(n) asm volatile("s_waitcnt vmcnt(" #n ")" ::: "memory")
#define PG8_WAIT_L(n) asm volatile("s_waitcnt lgkmcnt(" #n ")" ::: "memory")
#define PG8_BAR __builtin_amdgcn_s_barrier()
#define PG8_SCHED __builtin_amdgcn_sched_barrier(0)
    Unit cur, nxt; int ui = 0;
    if (!S.next(0, cur)) return;
    f32x4 acc[2][2][4][2];
#pragma unroll
    for (int a = 0; a < 2; ++a)
#pragma unroll
        for (int b = 0; b < 2; ++b)
#pragma unroll
            for (int m = 0; m < 4; ++m)
#pragma unroll
                for (int n = 0; n < 2; ++n) acc[a][b][m][n] = (f32x4){0.f, 0.f, 0.f, 0.f};
    bf16x8 At[4][2], B0[2][2], B1[2][2];
    const char* cA = (const char*)g.A + (size_t)cur.pm * tstepA; const char* cB = (const char*)g.Bt + (size_t)cur.pn * tstepB;
    S.a_ready(cur);
    if constexpr (SP2) {
        PG8_STAGE(PG8_SB(0, 0), cB, voffB); PG8_STAGE(PG8_SB(0, 1), cB + hstepB, voffB); PG8_STAGE(PG8_SA(0, 0), cA, voffA); PG8_STAGE(PG8_SA(0, 1), cA + hstepA, voffA);
        if (wr == 1) PG8_BAR;
        PG8_WAIT_V(2); PG8_BAR;
        PG8_STAGE(PG8_SB(1, 0), cB + kstep, voffB); PG8_STAGE(PG8_SA(1, 0), cA + kstep, voffA); PG8_STAGE(PG8_SB(1, 1), cB + hstepB + kstep, voffB);
        PG8_WAIT_V(6); PG8_BAR;
    } else {
        PG8_STAGE(PG8_SB(0, 0), cB, voffB); PG8_STAGE(PG8_SA(0, 0), cA, voffA); PG8_STAGE(PG8_SB(0, 1), cB + hstepB, voffB); PG8_STAGE(PG8_SA(0, 1), cA + hstepA, voffA);
        if (wr == 1) PG8_BAR;
        PG8_WAIT_V(4); PG8_BAR;
        PG8_STAGE(PG8_SB(1, 0), cB + kstep, voffB); PG8_STAGE(PG8_SA(1, 0), cA + kstep, voffA); PG8_STAGE(PG8_SB(1, 1), cB + hstepB + kstep, voffB);
        PG8_WAIT_V(6); PG8_BAR;
    }
    for (;;) {
        const bool has_next = S.next(ui + 1, nxt);
        const char* nA = has_next ? (const char*)g.A + (size_t)nxt.pm * tstepA : cA; const char* nB = has_next ? (const char*)g.Bt + (size_t)nxt.pn * tstepB : cB;
        for (int t = 0; t < nt; t += 2) {
            const bool last = (t == nt - 2);
            const char* a1 = cA + (size_t)(t + 1) * kstep;
            const char* a2 = last ? nA : cA + (size_t)(t + 2) * kstep; const char* b2 = last ? nB : cB + (size_t)(t + 2) * kstep;
            const char* a3 = a2 + kstep; const char* b3 = b2 + kstep;
            if (last && has_next) S.a_ready(nxt);
            if constexpr (SP2) {
            PG8_LDB(B0, 0, 0); PG8_LDB(B1, 0, 1); PG8_SCHED; PG8_LDA(At, 0, 0); PG8_STAGE(PG8_SA(1, 1), a1 + hstepA, voffA);
            PG8_WAIT_V(8); PG8_WAIT_L(0); PG8_BAR; PG8_MMA(0, 0, At, B0); PG8_MMA(0, 1, At, B1); PG8_BAR; PG8_SCHED;
            PG8_LDA(At, 0, 1); PG8_STAGE(PG8_SB(0, 0), b2, voffB); PG8_STAGE(PG8_SB(0, 1), b2 + hstepB, voffB); PG8_STAGE(PG8_SA(0, 0), a2, voffA);
            PG8_WAIT_V(8); PG8_WAIT_L(0); PG8_BAR; PG8_MMA(1, 0, At, B0); PG8_MMA(1, 1, At, B1); PG8_BAR; PG8_SCHED;
            PG8_LDB(B0, 1, 0); PG8_LDB(B1, 1, 1); PG8_SCHED; PG8_LDA(At, 1, 0); PG8_STAGE(PG8_SA(0, 1), a2 + hstepA, voffA);
            PG8_WAIT_V(8); PG8_WAIT_L(0); PG8_BAR; PG8_MMA(0, 0, At, B0); PG8_MMA(0, 1, At, B1); PG8_BAR; PG8_SCHED;
            PG8_LDA(At, 1, 1); PG8_STAGE(PG8_SB(1, 0), b3, voffB); PG8_STAGE(PG8_SB(1, 1), b3 + hstepB, voffB); PG8_STAGE(PG8_SA(1, 0), a3, voffA);
            PG8_WAIT_V(8); PG8_WAIT_L(0); PG8_BAR; PG8_MMA(1, 0, At, B0); PG8_MMA(1, 1, At, B1); PG8_BAR; PG8_SCHED;
            } else {
            PG8_LDB(B0, 0, 0); PG8_SCHED; PG8_LDA(At, 0, 0); PG8_STAGE(PG8_SA(1, 1), a1 + hstepA, voffA);
            PG8_WAIT_L(8); PG8_BAR; PG8_WAIT_L(0); PG8_MMA(0, 0, At, B0); PG8_BAR; PG8_SCHED;
            PG8_LDB(B1, 0, 1); PG8_STAGE(PG8_SB(0, 0), b2, voffB);
            PG8_BAR; PG8_WAIT_L(0); PG8_MMA(0, 1, At, B1); PG8_BAR;
            PG8_LDA(At, 0, 1); PG8_STAGE(PG8_SA(0, 0), a2, voffA);
            PG8_BAR; PG8_WAIT_L(0); PG8_MMA(1, 0, At, B0); PG8_BAR; PG8_SCHED;
            PG8_STAGE(PG8_SB(0, 1), b2 + hstepB, voffB);
            PG8_WAIT_V(6); PG8_BAR; PG8_MMA(1, 1, At, B1); PG8_BAR;
            PG8_LDB(B0, 1, 0); PG8_SCHED; PG8_LDA(At, 1, 0); PG8_STAGE(PG8_SA(0, 1), a2 + hstepA, voffA);
            PG8_WAIT_L(8); PG8_BAR; PG8_WAIT_L(0); PG8_MMA(0, 0, At, B0); PG8_BAR; PG8_SCHED;
            PG8_LDB(B1, 1, 1); PG8_STAGE(PG8_SB(1, 0), b3, voffB);
            PG8_BAR; PG8_WAIT_L(0); PG8_MMA(0, 1, At, B1); PG8_BAR;
            PG8_LDA(At, 1, 1); PG8_STAGE(PG8_SA(1, 0), a3, voffA);
            PG8_BAR; PG8_WAIT_L(0); PG8_MMA(1, 0, At, B0); PG8_BAR; PG8_SCHED;
            PG8_STAGE(PG8_SB(1, 1), b3 + hstepB, voffB);
            PG8_WAIT_V(6); PG8_BAR; PG8_MMA(1, 1, At, B1); PG8_BAR;
            }
        }
        if constexpr (ALIGN_EPI) { if (wr == 0) PG8_BAR; }
        if constexpr (!Epi::AFTER_DRAIN) { E(acc, cur, wr, wc, fr, fq); S.done(cur); }
        if (!has_next) break;
#pragma unroll
        for (int a = 0; a < 2; ++a)
#pragma unroll
            for (int b = 0; b < 2; ++b)
#pragma unroll
                for (int m = 0; m < 4; ++m)
#pragma unroll
                    for (int n = 0; n < 2; ++n) acc[a][b][m][n] = (f32x4){0.f, 0.f, 0.f, 0.f};
        cur = nxt; cA = nA; cB = nB; ++ui;
        if constexpr (ALIGN_EPI) { if (wr == 1) PG8_BAR; }
    }
    PG8_WAIT_V(0);
    if constexpr (!ALIGN_EPI) { if (wr == 0) PG8_BAR; }
    PG8_BAR;
    if constexpr (Epi::AFTER_DRAIN) { E.fused(acc, cur, wr, wc, fr, fq, lds, wid, lane); S.done(cur); }
#undef PG8_SA
#undef PG8_SB
#undef PG8_STAGE
#undef PG8_LDA
#undef PG8_LDB
#undef PG8_MMA
#undef PG8_WAIT_V
#undef PG8_WAIT_L
#undef PG8_BAR
#undef PG8_SCHED
}
}

namespace cg = cooperative_groups;
#define LAS __attribute__((address_space(3)))
typedef unsigned short bf16;
typedef short bf16x8 __attribute__((ext_vector_type(8)));
typedef short s16x4 __attribute__((ext_vector_type(4)));
typedef float f32x2 __attribute__((ext_vector_type(2)));
typedef float f32x4 __attribute__((ext_vector_type(4)));
typedef float f32x16 __attribute__((ext_vector_type(16)));
typedef unsigned u32x2 __attribute__((ext_vector_type(2)));
typedef unsigned u32x4 __attribute__((ext_vector_type(4)));
typedef __bf16 bf16x2_t __attribute__((ext_vector_type(2)));

constexpr int NB = 2, SEQ = 8192, T = NB * SEQ, DM = 2048;
constexpr float LOG2E = 1.4426950408889634f;
constexpr float NORM_EPS = 1e-6f;
constexpr int NTHREADS = 512, NWAVES = 8;
constexpr int LDS_BYTES = 160 * 1024;
constexpr float NEG_BIG = -1e30f;

constexpr size_t MiB = 1u << 20;
constexpr size_t WS_CTL = 0;
constexpr size_t WS_ROWSQ = 656 * MiB;
constexpr size_t WS_SW = 1 * MiB + 512 * 1024;
constexpr size_t WS_MOD = 1 * MiB;
constexpr size_t WS_TAB64 = 2 * MiB;
constexpr size_t WS_TAB128 = 4 * MiB;
constexpr size_t WS_BIAS1 = 8 * MiB;
constexpr size_t WS_SUBK = 9 * MiB;
constexpr size_t WS_W2T = 10 * MiB;
constexpr size_t WS_W1T = 11 * MiB;
constexpr size_t WS_WIN0 = 16 * MiB;
constexpr size_t WS_WOUT0 = 34 * MiB;
constexpr size_t WS_WIN1 = 42 * MiB;
constexpr size_t WS_WOUT1 = 57 * MiB;
constexpr size_t WS_WQ0 = 65 * MiB;
constexpr size_t WS_WQ1 = 73 * MiB;
constexpr size_t WS_SLOT = 81 * MiB;
constexpr size_t WS_U0 = 128 * MiB;
constexpr size_t WS_TAB = WS_U0;
constexpr size_t WS_TSCALE = WS_U0 + 128 * MiB;
constexpr size_t WS_H = 384 * MiB;
constexpr size_t WS_ATT = 448 * MiB;
constexpr size_t WS_QKV = 512 * MiB;
constexpr size_t WS_Q1 = 512 * MiB;
constexpr size_t WS_KSL = 576 * MiB;
constexpr size_t WS_VSL = 584 * MiB;
constexpr size_t WS_KW = 592 * MiB;
constexpr size_t WS_VW = 600 * MiB;
constexpr size_t WS_KCVC = 608 * MiB;
constexpr size_t WS_GATES = 626 * MiB;
constexpr size_t WS_HID = 630 * MiB;
constexpr size_t WS_KCMP = 633 * MiB;
constexpr size_t WS_VCMP = 634 * MiB;
constexpr size_t WS_Y = 576 * MiB;
constexpr size_t WS_XB = 656 * MiB;
constexpr size_t WS_END = 720 * MiB;

__device__ __forceinline__ unsigned cvtpk(float lo, float hi) { f32x2 v = {lo, hi}; bf16x2_t b = __builtin_convertvector(v, bf16x2_t); return __builtin_bit_cast(unsigned, b); }
__device__ __forceinline__ float bf2f(unsigned short b) { return __uint_as_float((unsigned)b << 16); }
__device__ __forceinline__ float bflo(unsigned w) { return __uint_as_float(w << 16); }
__device__ __forceinline__ float bfhi(unsigned w) { return __uint_as_float(w & 0xffff0000u); }
__device__ __forceinline__ float wave_sum(float v) {
#pragma unroll
    for (int o = 1; o < 64; o <<= 1) v += __shfl_xor(v, o);
    return v;
}
__device__ __forceinline__ float sum32(float v) {
    auto rr = __builtin_amdgcn_permlane32_swap(__float_as_uint(v), __float_as_uint(v), false, false);
    return __uint_as_float(rr[0]) + __uint_as_float(rr[1]);
}
__device__ __forceinline__ float max32(float v) {
    auto rr = __builtin_amdgcn_permlane32_swap(__float_as_uint(v), __float_as_uint(v), false, false);
    return fmaxf(__uint_as_float(rr[0]), __uint_as_float(rr[1]));
}
__device__ __forceinline__ float gelu_tanh(float x) {
    const float u = 0.7978845608028654f * (x + 0.044715f * x * x * x);
    const float e = __expf(2.f * u);
    const float th = 1.f - 2.f * __builtin_amdgcn_rcpf(e + 1.f);
    return 0.5f * x * (1.f + th);
}
__device__ __forceinline__ float sigmoidf_(float x) { return 1.f / (1.f + __expf(-x)); }
__device__ __forceinline__ float siluf_(float x) { return x / (1.f + __expf(-x)); }

#ifndef NT_ONCE
#define NT_ONCE 0
#endif
__device__ __forceinline__ void gemv_item(const LAS float* sv, int K, const float* W, int ldw, int col0, LAS float* red, float* out0, float* out1, const float* bias) {
    const int tid = threadIdx.x, lane = tid & 63, w = __builtin_amdgcn_readfirstlane(tid >> 6);
    const int kw = K / 8, kb = w * kw;
    float a00 = 0.f, a01 = 0.f, a10 = 0.f, a11 = 0.f;
    const float* wp = W + (size_t)kb * ldw + col0 + 2 * lane;
#pragma unroll 32
    for (int k = 0; k < kw; ++k) {
        const f32x2 wv = NT_ONCE ? __builtin_nontemporal_load((const f32x2*)(wp + (size_t)k * ldw)) : *(const f32x2*)(wp + (size_t)k * ldw);
        const float s0 = sv[kb + k], s1 = sv[K + kb + k];
        a00 += s0 * wv.x; a01 += s0 * wv.y; a10 += s1 * wv.x; a11 += s1 * wv.y;
    }
    red[(w * 2 + 0) * 128 + 2 * lane] = a00; red[(w * 2 + 0) * 128 + 2 * lane + 1] = a01;
    red[(w * 2 + 1) * 128 + 2 * lane] = a10; red[(w * 2 + 1) * 128 + 2 * lane + 1] = a11;
    __syncthreads();
    if (tid < 256) {
        const int v = tid >> 7, c = tid & 127; float s = 0.f;
#pragma unroll
        for (int ww = 0; ww < 8; ++ww) s += red[(ww * 2 + v) * 128 + c];
        if (bias) s += bias[col0 + c];
        (v == 0 ? out0 : out1)[col0 + c] = s;
    }
    __syncthreads();
}
__device__ __forceinline__ int rope64_pos(int n) { const int d = n & 63; return (n & ~63) | ((d < 32) ? 2 * d : 2 * (d - 32) + 1); }
__device__ __forceinline__ int rope128_pos(int n) { const int d = n & 127; return (n & ~127) | ((d < 64) ? 2 * d : 2 * (d - 64) + 1); }
__device__ __forceinline__ int dst_row(int mode, int n) {
    if (mode == 1) {
        if (n < 2048) return rope64_pos(n);
        if (n < 3072) return n;
        if (n < 4352) return rope64_pos(n);
        return n;
    }
    if (mode == 2) {
        if (n < 2048) return rope128_pos(n);
        if (n < 2560) return n;
        if (n < 2816) return rope128_pos(n);
        if (n < 3072) return n;
        if (n < 3328) return rope128_pos(n);
        return n;
    }
    if (mode == 3) return rope128_pos(n);
    return n;
}
__device__ __forceinline__ void transpose_item(const float* W, int K, int N, bf16* WT, int mode, LAS float* scr, int item, int lane) {
    const int nblk = (N + 31) / 32, kb = item / nblk, nb = item % nblk, k0 = 64 * kb, n0 = 32 * nb;
    const int nn = n0 + (lane & 31); const bool okn = nn < N;
    float tv[32];
#pragma unroll
    for (int i = 0; i < 32; ++i) { const int kk = 2 * i + (lane >> 5); tv[i] = okn ? (NT_ONCE ? __builtin_nontemporal_load(W + (size_t)(k0 + kk) * N + nn) : W[(size_t)(k0 + kk) * N + nn]) : 0.f; }
#pragma unroll
    for (int i = 0; i < 32; ++i) { const int kk = 2 * i + (lane >> 5); scr[kk * 33 + (lane & 31)] = tv[i]; }
    asm volatile("s_waitcnt lgkmcnt(0)" ::: "memory");
    const int c = lane & 7;
#pragma unroll
    for (int j = 0; j < 4; ++j) {
        const int nl = (lane >> 3) + 8 * j, n = n0 + nl; const LAS float* s = scr + (8 * c) * 33 + nl;
        u32x4 o; o.x = cvtpk(s[0 * 33], s[1 * 33]); o.y = cvtpk(s[2 * 33], s[3 * 33]); o.z = cvtpk(s[4 * 33], s[5 * 33]); o.w = cvtpk(s[6 * 33], s[7 * 33]);
        if (n < N) *(u32x4*)(WT + (size_t)dst_row(mode, n) * K + k0 + 8 * c) = o;
    }
    asm volatile("s_waitcnt lgkmcnt(0)" ::: "memory");
}

__device__ __forceinline__ void adaln_row(const float* xrow, const float* g, const float* mod, bf16* hrow, int lane) {
    f32x4 v[8]; float ss = 0.f;
#pragma unroll
    for (int j = 0; j < 4; ++j) {
        v[2 * j] = *(const f32x4*)(xrow + lane * 8 + 512 * j); v[2 * j + 1] = *(const f32x4*)(xrow + lane * 8 + 512 * j + 4);
        ss += v[2 * j].x * v[2 * j].x + v[2 * j].y * v[2 * j].y + v[2 * j].z * v[2 * j].z + v[2 * j].w * v[2 * j].w;
        ss += v[2 * j + 1].x * v[2 * j + 1].x + v[2 * j + 1].y * v[2 * j + 1].y + v[2 * j + 1].z * v[2 * j + 1].z + v[2 * j + 1].w * v[2 * j + 1].w;
    }
    const float r = 1.0f / sqrtf(wave_sum(ss) * (1.f / DM) + NORM_EPS);
#pragma unroll
    for (int j = 0; j < 4; ++j) {
        const int idx = lane * 8 + 512 * j;
        f32x4 o[2];
#pragma unroll
        for (int q = 0; q < 2; ++q) {
            const f32x4 gg = *(const f32x4*)(g + idx + 4 * q), sh = *(const f32x4*)(mod + idx + 4 * q), sc = *(const f32x4*)(mod + 2048 + idx + 4 * q);
            o[q] = v[2 * j + q] * r * gg * (1.f + sc) + sh;
        }
        u32x4 w; w.x = cvtpk(o[0].x, o[0].y); w.y = cvtpk(o[0].z, o[0].w); w.z = cvtpk(o[1].x, o[1].y); w.w = cvtpk(o[1].z, o[1].w);
        *(u32x4*)(hrow + idx) = w;
    }
}
__device__ __forceinline__ void adaln_row2(const float* xa, const float* xb, const float* g, const float* moda, const float* modb, bf16* ha, bf16* hb, int lane) {
    f32x4 va[8], vb[8]; float sa = 0.f, sb = 0.f;
#pragma unroll
    for (int j = 0; j < 8; ++j) { va[j] = *(const f32x4*)(xa + lane * 8 + 512 * (j >> 1) + 4 * (j & 1)); vb[j] = *(const f32x4*)(xb + lane * 8 + 512 * (j >> 1) + 4 * (j & 1)); }
#pragma unroll
    for (int j = 0; j < 8; ++j) { sa += va[j].x * va[j].x + va[j].y * va[j].y + va[j].z * va[j].z + va[j].w * va[j].w; sb += vb[j].x * vb[j].x + vb[j].y * vb[j].y + vb[j].z * vb[j].z + vb[j].w * vb[j].w; }
    const float ra = 1.0f / sqrtf(wave_sum(sa) * (1.f / DM) + NORM_EPS), rb = 1.0f / sqrtf(wave_sum(sb) * (1.f / DM) + NORM_EPS);
#pragma unroll
    for (int j = 0; j < 4; ++j) {
        const int idx = lane * 8 + 512 * j;
        f32x4 oa[2], ob[2];
#pragma unroll
        for (int q = 0; q < 2; ++q) {
            const f32x4 gg = *(const f32x4*)(g + idx + 4 * q);
            oa[q] = va[2 * j + q] * ra * gg * (1.f + *(const f32x4*)(moda + 2048 + idx + 4 * q)) + *(const f32x4*)(moda + idx + 4 * q);
            ob[q] = vb[2 * j + q] * rb * gg * (1.f + *(const f32x4*)(modb + 2048 + idx + 4 * q)) + *(const f32x4*)(modb + idx + 4 * q);
        }
        u32x4 w; w.x = cvtpk(oa[0].x, oa[0].y); w.y = cvtpk(oa[0].z, oa[0].w); w.z = cvtpk(oa[1].x, oa[1].y); w.w = cvtpk(oa[1].z, oa[1].w);
        *(u32x4*)(ha + idx) = w;
        w.x = cvtpk(ob[0].x, ob[0].y); w.y = cvtpk(ob[0].z, ob[0].w); w.z = cvtpk(ob[1].x, ob[1].y); w.w = cvtpk(ob[1].z, ob[1].w);
        *(u32x4*)(hb + idx) = w;
    }
}
__device__ __forceinline__ void adaln_row_bf(const bf16* xrow, const float* g, const float* mod, bf16* hrow, int lane) {
    f32x4 v[8]; float ss = 0.f;
#pragma unroll
    for (int j = 0; j < 4; ++j) {
        const u32x4 w = *(const u32x4*)(xrow + lane * 8 + 512 * j);
        v[2 * j] = (f32x4){bflo(w.x), bfhi(w.x), bflo(w.y), bfhi(w.y)}; v[2 * j + 1] = (f32x4){bflo(w.z), bfhi(w.z), bflo(w.w), bfhi(w.w)};
        ss += v[2 * j].x * v[2 * j].x + v[2 * j].y * v[2 * j].y + v[2 * j].z * v[2 * j].z + v[2 * j].w * v[2 * j].w;
        ss += v[2 * j + 1].x * v[2 * j + 1].x + v[2 * j + 1].y * v[2 * j + 1].y + v[2 * j + 1].z * v[2 * j + 1].z + v[2 * j + 1].w * v[2 * j + 1].w;
    }
    const float r = 1.0f / sqrtf(wave_sum(ss) * (1.f / DM) + NORM_EPS);
#pragma unroll
    for (int j = 0; j < 4; ++j) {
        const int idx = lane * 8 + 512 * j;
        f32x4 o[2];
#pragma unroll
        for (int q = 0; q < 2; ++q) {
            const f32x4 gg = *(const f32x4*)(g + idx + 4 * q), sh = *(const f32x4*)(mod + idx + 4 * q), sc = *(const f32x4*)(mod + 2048 + idx + 4 * q);
            o[q] = v[2 * j + q] * r * gg * (1.f + sc) + sh;
        }
        u32x4 w; w.x = cvtpk(o[0].x, o[0].y); w.y = cvtpk(o[0].z, o[0].w); w.z = cvtpk(o[1].x, o[1].y); w.w = cvtpk(o[1].z, o[1].w);
        *(u32x4*)(hrow + idx) = w;
    }
}
__device__ __forceinline__ void final_row(const float* xrow, const float* g, float* orow, int lane) {
    f32x4 v[8]; float ss = 0.f;
#pragma unroll
    for (int j = 0; j < 8; ++j) { v[j] = *(const f32x4*)(xrow + lane * 8 + 512 * (j >> 1) + 4 * (j & 1)); ss += v[j].x * v[j].x + v[j].y * v[j].y + v[j].z * v[j].z + v[j].w * v[j].w; }
    const float r = 1.0f / sqrtf(wave_sum(ss) * (1.f / DM) + NORM_EPS);
#pragma unroll
    for (int j = 0; j < 8; ++j) { const int idx = lane * 8 + 512 * (j >> 1) + 4 * (j & 1); const f32x4 gg = *(const f32x4*)(g + idx); *(f32x4*)(orow + idx) = v[j] * r * gg; }
}

#define EPI_ROWS_BEGIN _Pragma("unroll") for (int ai = 0; ai < 2; ++ai) { _Pragma("unroll") for (int m = 0; m < 4; ++m) { const int row = u.pm * 256 + wr * 64 + fr + ai * 128 + m * 16; _Pragma("unroll") for (int bj = 0; bj < 2; ++bj) { \
        const int col = u.pn * 256 + bj * 128 + wc * 32 + 8 * fq; f32x4 v0 = acc[ai][bj][m][0], v1 = acc[ai][bj][m][1];
#define EPI_ROWS_END } } }
#define EPI_HALVES _Pragma("unroll") for (int ai = 0; ai < 2; ++ai)
#define EPI_CHUNKS _Pragma("unroll") for (int m = 0; m < 4; ++m) _Pragma("unroll") for (int bj = 0; bj < 2; ++bj)
#define EPI_RC const int ci = m * 2 + bj, row = u.pm * 256 + wr * 64 + fr + ai * 128 + m * 16, col = u.pn * 256 + bj * 128 + wc * 32 + 8 * fq; (void)ci;
#ifndef EPI_BATCH
#define EPI_BATCH 0
#endif
__device__ __forceinline__ void rope8t(f32x4& v0, f32x4& v1, const f32x4& t0, const f32x4& t1) {
    f32x4 a, b;
    a.x = v0.x * t0.x - v0.y * t0.y; a.y = v0.y * t0.x + v0.x * t0.y;
    a.z = v0.z * t0.z - v0.w * t0.w; a.w = v0.w * t0.z + v0.z * t0.w;
    b.x = v1.x * t1.x - v1.y * t1.y; b.y = v1.y * t1.x + v1.x * t1.y;
    b.z = v1.z * t1.z - v1.w * t1.w; b.w = v1.w * t1.z + v1.z * t1.w;
    v0 = a; v1 = b;
}
__device__ __forceinline__ void rope8(f32x4& v0, f32x4& v1, const f32x2* tab) {
    const f32x4 t0 = *(const f32x4*)tab, t1 = *(const f32x4*)(tab + 2);
    f32x4 a, b;
    a.x = v0.x * t0.x - v0.y * t0.y; a.y = v0.y * t0.x + v0.x * t0.y;
    a.z = v0.z * t0.z - v0.w * t0.w; a.w = v0.w * t0.z + v0.z * t0.w;
    b.x = v1.x * t1.x - v1.y * t1.y; b.y = v1.y * t1.x + v1.x * t1.y;
    b.z = v1.z * t1.z - v1.w * t1.w; b.w = v1.w * t1.z + v1.z * t1.w;
    v0 = a; v1 = b;
}
__device__ __forceinline__ u32x4 pack8(const f32x4& v0, const f32x4& v1) { u32x4 w; w.x = cvtpk(v0.x, v0.y); w.y = cvtpk(v0.z, v0.w); w.z = cvtpk(v1.x, v1.y); w.w = cvtpk(v1.z, v1.w); return w; }

constexpr float QSCALE64 = 0.125f * LOG2E;
constexpr float QSCALE128 = 0.08838834764831845f * LOG2E;

struct EpiQKV0 {
    static constexpr bool PERM = true, AFTER_DRAIN = false;
    bf16* out; const f32x2* tab64;
    __device__ __forceinline__ void operator()(const f32x4 (&acc)[2][2][4][2], const pg8::Unit& u, int wr, int wc, int fr, int fq) const {
        const int pn = u.pn;
        const bool rope = (pn < 8) || (pn >= 12 && pn < 17);
        const float sc = (pn < 4 || (pn >= 12 && pn < 16)) ? QSCALE64 : 1.f;
#if EPI_BATCH
        EPI_HALVES {
            f32x4 t0[8], t1[8];
            if (rope) {
                EPI_CHUNKS { EPI_RC const f32x2* tp = tab64 + (size_t)(row & (SEQ - 1)) * 32 + ((col & 63) >> 1); t0[ci] = *(const f32x4*)tp; t1[ci] = *(const f32x4*)(tp + 2); }
#pragma unroll
                for (int c8 = 0; c8 < 8; ++c8) { asm volatile("" : "+v"(t0[c8])); asm volatile("" : "+v"(t1[c8])); }
            }
            EPI_CHUNKS { EPI_RC f32x4 v0 = acc[ai][bj][m][0], v1 = acc[ai][bj][m][1];
                if (rope) rope8t(v0, v1, t0[ci], t1[ci]);
                v0 = v0 * sc; v1 = v1 * sc;
                *(u32x4*)(out + (size_t)row * 4608 + col) = pack8(v0, v1); }
        }
#else
        EPI_ROWS_BEGIN
            if (rope) rope8(v0, v1, tab64 + (size_t)(row & (SEQ - 1)) * 32 + ((col & 63) >> 1));
            v0 = v0 * sc; v1 = v1 * sc;
            *(u32x4*)(out + (size_t)row * 4608 + col) = pack8(v0, v1);
        EPI_ROWS_END
#endif
    }
};
struct EpiQKV1 {
    static constexpr bool PERM = true, AFTER_DRAIN = false;
    unsigned char* ws; const f32x2* tab128;
    __device__ __forceinline__ void operator()(const f32x4 (&acc)[2][2][4][2], const pg8::Unit& u, int wr, int wc, int fr, int fq) const {
        const int pn = u.pn;
        const bool rope = (pn < 8) || pn == 10 || pn == 12;
#if EPI_BATCH
        EPI_HALVES {
            f32x4 t0[8], t1[8];
            if (rope) {
                EPI_CHUNKS { EPI_RC const f32x2* tp = tab128 + (size_t)(row & (SEQ - 1)) * 64 + ((col & 127) >> 1); t0[ci] = *(const f32x4*)tp; t1[ci] = *(const f32x4*)(tp + 2); }
#pragma unroll
                for (int c8 = 0; c8 < 8; ++c8) { asm volatile("" : "+v"(t0[c8])); asm volatile("" : "+v"(t1[c8])); }
            }
            EPI_CHUNKS { EPI_RC f32x4 v0 = acc[ai][bj][m][0], v1 = acc[ai][bj][m][1];
            if (rope) rope8t(v0, v1, t0[ci], t1[ci]);
            if (pn < 8) { v0 = v0 * QSCALE128; v1 = v1 * QSCALE128; *(u32x4*)((bf16*)(ws + WS_Q1) + (size_t)row * 2048 + col) = pack8(v0, v1); }
            else if (pn < 10) {
                const int c = col & 255, h = c >> 7, d0 = c & 127, b = row >> 13, s = row & (SEQ - 1);
                *(u32x4*)((bf16*)(ws + WS_KCVC) + ((((size_t)(pn - 8) * 2 + b) * 2 + h) * SEQ + s) * 128 + d0) = pack8(v0, v1);
            } else if (pn < 14) {
                const size_t off = (pn == 10) ? WS_KSL : (pn == 11) ? WS_VSL : (pn == 12) ? WS_KW : WS_VW;
                *(u32x4*)((bf16*)(ws + off) + (size_t)row * 256 + (col & 255)) = pack8(v0, v1);
            } else {
                const int c = col - 3584;
                if (c < 48) { float* gp = (float*)(ws + WS_GATES) + (size_t)row * 48 + c;
                    f32x4 a, b2; a.x = sigmoidf_(v0.x); a.y = sigmoidf_(v0.y); a.z = sigmoidf_(v0.z); a.w = sigmoidf_(v0.w);
                    b2.x = sigmoidf_(v1.x); b2.y = sigmoidf_(v1.y); b2.z = sigmoidf_(v1.z); b2.w = sigmoidf_(v1.w);
                    *(f32x4*)gp = a; *(f32x4*)(gp + 4) = b2; }
            }
            }
        }
#else
        EPI_ROWS_BEGIN
            if (rope) rope8(v0, v1, tab128 + (size_t)(row & (SEQ - 1)) * 64 + ((col & 127) >> 1));
            if (pn < 8) { v0 = v0 * QSCALE128; v1 = v1 * QSCALE128; *(u32x4*)((bf16*)(ws + WS_Q1) + (size_t)row * 2048 + col) = pack8(v0, v1); }
            else if (pn < 10) {
                const int c = col & 255, h = c >> 7, d0 = c & 127, b = row >> 13, s = row & (SEQ - 1);
                *(u32x4*)((bf16*)(ws + WS_KCVC) + ((((size_t)(pn - 8) * 2 + b) * 2 + h) * SEQ + s) * 128 + d0) = pack8(v0, v1);
            } else if (pn < 14) {
                const size_t off = (pn == 10) ? WS_KSL : (pn == 11) ? WS_VSL : (pn == 12) ? WS_KW : WS_VW;
                *(u32x4*)((bf16*)(ws + off) + (size_t)row * 256 + (col & 255)) = pack8(v0, v1);
            } else {
                const int c = col - 3584;
                if (c < 48) { float* gp = (float*)(ws + WS_GATES) + (size_t)row * 48 + c;
                    f32x4 a, b2; a.x = sigmoidf_(v0.x); a.y = sigmoidf_(v0.y); a.z = sigmoidf_(v0.z); a.w = sigmoidf_(v0.w);
                    b2.x = sigmoidf_(v1.x); b2.y = sigmoidf_(v1.y); b2.z = sigmoidf_(v1.z); b2.w = sigmoidf_(v1.w);
                    *(f32x4*)gp = a; *(f32x4*)(gp + 4) = b2; }
            }
        EPI_ROWS_END
#endif
    }
};
struct EpiGate {
    static constexpr bool PERM = true, AFTER_DRAIN = false;
    bf16* y; const float* gate;
    __device__ __forceinline__ void operator()(const f32x4 (&acc)[2][2][4][2], const pg8::Unit& u, int wr, int wc, int fr, int fq) const {
        EPI_ROWS_BEGIN
            const float* gp = gate + (size_t)(row >> 13) * 6144 + col;
            const f32x4 g0 = *(const f32x4*)gp, g1 = *(const f32x4*)(gp + 4);
            *(u32x4*)(y + (size_t)row * 2048 + col) = pack8(g0 * v0, g1 * v1);
        EPI_ROWS_END
    }
};
template <bool XOLD_F32>
struct EpiResid {
    static constexpr bool PERM = true, AFTER_DRAIN = false;
    const void* xold; bf16* xnew; const float* gate;
    __device__ __forceinline__ void operator()(const f32x4 (&acc)[2][2][4][2], const pg8::Unit& u, int wr, int wc, int fr, int fq) const {
#if EPI_BATCH
        const float* gp0 = gate + (size_t)((u.pm * 256) >> 13) * 6144 + u.pn * 256 + wc * 32 + 8 * fq;
        f32x4 gg[2][2];
#pragma unroll
        for (int bj = 0; bj < 2; ++bj) { gg[bj][0] = *(const f32x4*)(gp0 + bj * 128); gg[bj][1] = *(const f32x4*)(gp0 + bj * 128 + 4); }
        EPI_HALVES {
            if (XOLD_F32) {
                f32x4 x0[8], x1[8];
                EPI_CHUNKS { EPI_RC const float* xp = (const float*)xold + (size_t)row * 2048 + col; x0[ci] = *(const f32x4*)xp; x1[ci] = *(const f32x4*)(xp + 4); }
#pragma unroll
                for (int c8 = 0; c8 < 8; ++c8) { asm volatile("" : "+v"(x0[c8])); asm volatile("" : "+v"(x1[c8])); }
                EPI_CHUNKS { EPI_RC const f32x4 v0 = acc[ai][bj][m][0], v1 = acc[ai][bj][m][1];
                    *(u32x4*)(xnew + (size_t)row * 2048 + col) = pack8(x0[ci] + gg[bj][0] * v0, x1[ci] + gg[bj][1] * v1); }
            } else {
                u32x4 xw[8];
                EPI_CHUNKS { EPI_RC xw[ci] = *(const u32x4*)((const bf16*)xold + (size_t)row * 2048 + col); }
#pragma unroll
                for (int c8 = 0; c8 < 8; ++c8) asm volatile("" : "+v"(xw[c8]));
                EPI_CHUNKS { EPI_RC const f32x4 v0 = acc[ai][bj][m][0], v1 = acc[ai][bj][m][1]; const u32x4 w = xw[ci];
                    const f32x4 x0 = {bflo(w.x), bfhi(w.x), bflo(w.y), bfhi(w.y)}, x1 = {bflo(w.z), bfhi(w.z), bflo(w.w), bfhi(w.w)};
                    *(u32x4*)(xnew + (size_t)row * 2048 + col) = pack8(x0 + gg[bj][0] * v0, x1 + gg[bj][1] * v1); }
            }
        }
#else
        EPI_ROWS_BEGIN
            const float* gp = gate + (size_t)(row >> 13) * 6144 + col;
            const f32x4 g0 = *(const f32x4*)gp, g1 = *(const f32x4*)(gp + 4);
            f32x4 x0, x1;
            if (XOLD_F32) { const float* xp = (const float*)xold + (size_t)row * 2048 + col; x0 = *(const f32x4*)xp; x1 = *(const f32x4*)(xp + 4); }
            else { const u32x4 w = *(const u32x4*)((const bf16*)xold + (size_t)row * 2048 + col); x0 = (f32x4){bflo(w.x), bfhi(w.x), bflo(w.y), bfhi(w.y)}; x1 = (f32x4){bflo(w.z), bfhi(w.z), bflo(w.w), bfhi(w.w)}; }
            *(u32x4*)(xnew + (size_t)row * 2048 + col) = pack8(x0 + g0 * v0, x1 + g1 * v1);
        EPI_ROWS_END
#endif
    }
};
#ifndef QNT
#define QNT 0
#endif
struct EpiPlain {
    static constexpr bool PERM = true, AFTER_DRAIN = false;
    bf16* out; int ld;
    __device__ __forceinline__ void operator()(const f32x4 (&acc)[2][2][4][2], const pg8::Unit& u, int wr, int wc, int fr, int fq) const {
        EPI_ROWS_BEGIN
#if QNT
            __builtin_nontemporal_store(pack8(v0, v1), (u32x4*)(out + (size_t)row * ld + col));
#else
            *(u32x4*)(out + (size_t)row * ld + col) = pack8(v0, v1);
#endif
        EPI_ROWS_END
    }
};
struct EpiCmp1 {
    static constexpr bool PERM = true, AFTER_DRAIN = false;
    bf16* hid; const float* bias1;
    __device__ __forceinline__ void operator()(const f32x4 (&acc)[2][2][4][2], const pg8::Unit& u, int wr, int wc, int fr, int fq) const {
        EPI_ROWS_BEGIN
            const int c = col & 255; const float* bp = bias1 + u.pn * 256 + c;
            const f32x4 b0 = *(const f32x4*)bp, b1 = *(const f32x4*)(bp + 4);
            v0 = v0 + b0; v1 = v1 + b1;
            v0.x = gelu_tanh(v0.x); v0.y = gelu_tanh(v0.y); v0.z = gelu_tanh(v0.z); v0.w = gelu_tanh(v0.w);
            v1.x = gelu_tanh(v1.x); v1.y = gelu_tanh(v1.y); v1.z = gelu_tanh(v1.z); v1.w = gelu_tanh(v1.w);
            *(u32x4*)(hid + (size_t)row * 256 + c) = pack8(v0, v1);
        EPI_ROWS_END
    }
};
struct EpiCmp2 {
    static constexpr bool PERM = true, AFTER_DRAIN = false;
    bf16* kcmp; bf16* vcmp; const f32x2* tab128;
    __device__ __forceinline__ void operator()(const f32x4 (&acc)[2][2][4][2], const pg8::Unit& u, int wr, int wc, int fr, int fq) const {
        EPI_ROWS_BEGIN
            const int c = col & 255;
            if (c < 128) {
                const int r = row & 2047;
                if (u.pn == 0) { int pos = 16 * (r & 511) + 31; pos = pos > SEQ - 1 ? SEQ - 1 : pos; rope8(v0, v1, tab128 + (size_t)pos * 64 + (c >> 1)); }
                *(u32x4*)((u.pn == 0 ? kcmp : vcmp) + (size_t)r * 128 + c) = pack8(v0, v1);
            }
        EPI_ROWS_END
    }
};
struct CmpOrder {
    int c;
    __device__ __forceinline__ bool next(int i, pg8::Unit& u) const { if (i > 0 || c >= 16) return false; u.pm = c; u.pn = c >> 3; return true; }
    __device__ __forceinline__ void a_ready(const pg8::Unit&) const {}
    __device__ __forceinline__ void done(const pg8::Unit&) const {}
};

__device__ __forceinline__ int crow(int r, int hi) { return (r & 3) + 8 * (r >> 2) + 4 * hi; }
__device__ __forceinline__ float max3f(float a, float b, float c) { float r; asm("v_max3_f32 %0, %1, %2, %3" : "=v"(r) : "v"(a), "v"(b), "v"(c)); return r; }
__device__ __forceinline__ float max2f(float a, float b) { float r; asm("v_max_f32_e32 %0, %1, %2" : "=v"(r) : "v"(a), "v"(b)); return r; }
#ifndef QK_INIT
#define QK_INIT 1
#endif
constexpr float RESCALE_THR = 8.0f;
typedef short v4i16_t __attribute__((ext_vector_type(4)));

template <int DQK, int DV> struct AT {
    static constexpr int KP = DQK + 8, VP = DV + 32;
    static constexpr int KBYTES = 64 * KP * 2, VBYTES = 64 * VP * 2;
    static constexpr int KCH = 64 * DQK / 8 / NTHREADS, VCH = 64 * DV / 8 / NTHREADS;
    static constexpr int KOFF = 0, VOFF = KBYTES;
    static constexpr int BYTES = KBYTES + VBYTES;
};

template <int DX, int NCH>
__device__ __forceinline__ void tile_load(u32x4 (&reg)[NCH], const bf16* g, int pitch, int key0, int kmax, int tid) {
    asm volatile("" : "+v"(tid));
#pragma unroll
    for (int i = 0; i < NCH; ++i) {
        const int id = tid + NTHREADS * i, row = id / (DX / 8), ch = id % (DX / 8);
        int key = key0 + row; key = key < 0 ? 0 : (key > kmax ? kmax : key);
        reg[i] = *(const u32x4*)(g + (size_t)key * pitch + ch * 8);
    }
}
template <int DX, int NCH, int PITCH = DX + 8>
__device__ __forceinline__ void tile_store(const u32x4 (&reg)[NCH], LAS unsigned char* l, int tid) {
    asm volatile("" : "+v"(tid));
#pragma unroll
    for (int i = 0; i < NCH; ++i) {
        const int id = tid + NTHREADS * i, row = id / (DX / 8), ch = id % (DX / 8);
        *(LAS u32x4*)(l + (row * PITCH + ch * 8) * 2) = reg[i];
    }
}
__device__ __forceinline__ void glds16(const void* gsrc, unsigned lds_dst) { unsigned keep;
    asm volatile("s_mov_b32 %0, m0\n\ts_mov_b32 m0, %2\n\ts_nop 0\n\tglobal_load_lds_dwordx4 %1, off\n\ts_mov_b32 m0, %0" : "=&s"(keep) : "v"(gsrc), "s"(lds_dst) : "memory"); }
template <int PITCH> struct DmaN { static constexpr int CPR = PITCH / 8, NI = 64 * CPR / 64, NIW = (NI + 7) / 8; static_assert((64 * PITCH * 2) % 1024 == 0, "tile image must be whole 1 KiB pieces"); };
template <int DX, int PITCH>
__device__ __forceinline__ void tile_dma(const bf16* g, int pitch, int key0, int kmax, unsigned lds_tile, unsigned lds_dump, int wave, int lane) {
    typedef DmaN<PITCH> D;
#pragma unroll
    for (int j = 0; j < D::NIW; ++j) {
        const int idx = j * 8 + wave; const bool ok = idx < D::NI;
        const int gch = (ok ? idx : 0) * 64 + lane, row = gch / D::CPR, ch = gch % D::CPR;
        int key = key0 + row; key = key < 0 ? 0 : (key > kmax ? kmax : key);
        const bf16* src = g + (size_t)key * pitch + (ch < DX / 8 ? ch : 0) * 8;
        glds16(src, (unsigned)__builtin_amdgcn_readfirstlane((int)(ok ? lds_tile + (unsigned)idx * 1024u : lds_dump)));
    }
}
template <int N> __device__ __forceinline__ void wait_bar() { asm volatile("s_waitcnt vmcnt(%0) lgkmcnt(0)\n\ts_barrier" :: "i"(N) : "memory"); }
__device__ __forceinline__ unsigned lds_addr(const LAS unsigned char* p) { return (unsigned)(__UINTPTR_TYPE__)p; }
template <int DQK, bool QL = false>
__device__ __forceinline__ void qk_tile(const LAS unsigned char* kl, const bf16x8 (&qf)[QL ? 1 : DQK / 16], f32x16& s0, f32x16& s1, int lane, const LAS unsigned char* ql = nullptr, float init = 0.f) {
    const int r32 = lane & 31, hi = lane >> 5;
    const LAS unsigned char* p = kl + (r32 * (DQK + 8) + hi * 8) * 2;
#pragma unroll
    for (int i = 0; i < 16; ++i) { s0[i] = init; s1[i] = init; }
#pragma unroll
    for (int sg = 0; sg < DQK / 64; ++sg) {
        bf16x8 a0[4], a1[4];
#pragma unroll
        for (int st = 0; st < 4; ++st) { a0[st] = *(const LAS bf16x8*)(p + (sg * 4 + st) * 32); a1[st] = *(const LAS bf16x8*)(p + 32 * (DQK + 8) * 2 + (sg * 4 + st) * 32); }
        __builtin_amdgcn_s_setprio(1);
#pragma unroll
        for (int st = 0; st < 4; ++st) {
            const bf16x8 qv = QL ? *(const LAS bf16x8*)(ql + (sg * 4 + st) * 32) : qf[QL ? 0 : sg * 4 + st];
            s0 = __builtin_amdgcn_mfma_f32_32x32x16_bf16(a0[st], qv, s0, 0, 0, 0);
            s1 = __builtin_amdgcn_mfma_f32_32x32x16_bf16(a1[st], qv, s1, 0, 0, 0);
        }
        __builtin_amdgcn_s_setprio(0);
        if (DQK > 64) __builtin_amdgcn_sched_barrier(0);
    }
}
__device__ __forceinline__ bf16x8 pfrag(const f32x16& p, int s) {
    u32x4 w; w.x = cvtpk(p[8 * s + 0], p[8 * s + 1]); w.y = cvtpk(p[8 * s + 2], p[8 * s + 3]); w.z = cvtpk(p[8 * s + 4], p[8 * s + 5]); w.w = cvtpk(p[8 * s + 6], p[8 * s + 7]);
    return __builtin_bit_cast(bf16x8, w);
}
template <int DV>
__device__ __forceinline__ void pv_tile(const LAS unsigned char* vl, const f32x16& p0, const f32x16& p1, f32x16 (&O)[DV / 32], int lane) {
    const int hi = lane >> 5, g1 = (lane >> 4) & 1, i = lane & 15, q = i >> 2, pp = i & 3;
    const LAS unsigned char* vb = vl + ((4 * hi + q) * (DV + 32) + 16 * g1 + 4 * pp) * 2;
    v4i16_t lo[2][DV / 32], hh[2][DV / 32];
#pragma unroll
    for (int dt = 0; dt < DV / 32; ++dt) { lo[0][dt] = __builtin_amdgcn_ds_read_tr16_b64_v4i16((LAS v4i16_t*)(vb + dt * 64)); hh[0][dt] = __builtin_amdgcn_ds_read_tr16_b64_v4i16((LAS v4i16_t*)(vb + dt * 64 + 8 * (DV + 32) * 2)); }
#pragma unroll
    for (int ks = 0; ks < 4; ++ks) {
        const bf16x8 pf = pfrag((ks & 2) ? p1 : p0, ks & 1);
        if (ks < 3) {
#pragma unroll
            for (int dt = 0; dt < DV / 32; ++dt) { const LAS unsigned char* a = vb + (16 * (ks + 1)) * (DV + 32) * 2 + dt * 64;
                lo[(ks + 1) & 1][dt] = __builtin_amdgcn_ds_read_tr16_b64_v4i16((LAS v4i16_t*)a); hh[(ks + 1) & 1][dt] = __builtin_amdgcn_ds_read_tr16_b64_v4i16((LAS v4i16_t*)(a + 8 * (DV + 32) * 2)); }
        }
        __builtin_amdgcn_s_setprio(1);
#pragma unroll
        for (int dt = 0; dt < DV / 32; ++dt) {
            const bf16x8 vf = __builtin_shufflevector(lo[ks & 1][dt], hh[ks & 1][dt], 0, 1, 2, 3, 4, 5, 6, 7);
            O[dt] = __builtin_amdgcn_mfma_f32_32x32x16_bf16(vf, pf, O[dt], 0, 0, 0);
        }
        __builtin_amdgcn_s_setprio(0);
        __builtin_amdgcn_sched_barrier(0);
    }
}
struct MaskCausal { int tpos; __device__ __forceinline__ bool full(int k0, bool) const { return k0 + 63 <= tpos; } __device__ __forceinline__ bool prep(int k0) const { return k0 <= tpos; } __device__ __forceinline__ bool valid(int k, bool) const { return k <= tpos; } };
struct MaskWindow { int tpos, w; __device__ __forceinline__ bool full(int k0, bool) const { return k0 + 63 <= tpos && k0 > tpos - w; } __device__ __forceinline__ bool prep(int k0) const { return k0 <= tpos && k0 + 63 > tpos - w; } __device__ __forceinline__ bool valid(int k, bool) const { return k <= tpos && k > tpos - w; } };
struct MaskCmp { int cmax; __device__ __forceinline__ bool full(int k0, bool) const { return k0 + 63 <= cmax; } __device__ __forceinline__ bool prep(int k0) const { return k0 <= cmax; } __device__ __forceinline__ bool valid(int k, bool) const { return k <= cmax; } };
struct MaskSel { int tpos; unsigned long long lo, hi2;
    __device__ __forceinline__ bool prep(int k0) const { const int j = k0 >> 6; return k0 <= tpos && (((j < 64 ? (lo >> j) : (hi2 >> (j - 64))) & 1ull) != 0ull); }
    __device__ __forceinline__ bool full(int k0, bool act) const { return act && k0 + 63 <= tpos; }
    __device__ __forceinline__ bool valid(int k, bool act) const { return act && k <= tpos; } };

template <class M> __device__ __forceinline__ float mask_tile(f32x16& s0, f32x16& s1, int key0, const M& mk, bool act, int lane) {
    const int hi = lane >> 5; float mx = -INFINITY;
    if (__all(mk.full(key0, act))) {
#pragma unroll
        for (int r = 0; r < 16; ++r) mx = max3f(mx, s0[r], s1[r]);
        return mx;
    }
#pragma unroll
    for (int r = 0; r < 16; ++r) {
        const int k = key0 + crow(r, hi);
        s0[r] = mk.valid(k, act) ? s0[r] : -INFINITY; s1[r] = mk.valid(k + 32, act) ? s1[r] : -INFINITY;
        mx = max3f(mx, s0[r], s1[r]);
    }
    return mx;
}
template <int DV> __device__ __forceinline__ void online_update(f32x16& s0, f32x16& s1, float mx, float& m, float& l, f32x16 (&O)[DV / 32], float c = 0.f) {
    mx = max32(mx) - c;
    const float mn = (mx - m > RESCALE_THR) ? mx : m, alpha = __builtin_amdgcn_exp2f(m - mn);
    const float d = mn + c;
    if (__any(d != 0.f)) {
#pragma unroll
        for (int r = 0; r < 16; ++r) { s0[r] -= d; s1[r] -= d; }
    }
    float ps = 0.f;
#pragma unroll
    for (int r = 0; r < 16; ++r) { s0[r] = __builtin_amdgcn_exp2f(s0[r]); s1[r] = __builtin_amdgcn_exp2f(s1[r]); ps += s0[r] + s1[r]; }
    l = l * alpha + ps; m = mn;
    if (__any(alpha != 1.f)) {
#pragma unroll
        for (int dt = 0; dt < DV / 32; ++dt)
#pragma unroll
            for (int r = 0; r < 16; ++r) O[dt][r] *= alpha;
    }
}

template <int DQK, bool QL>
__device__ __forceinline__ void qk_half(const LAS unsigned char* kl, const bf16x8 (&qf)[QL ? 1 : DQK / 16], f32x16& s, int kt, int lane, const LAS unsigned char* ql) {
    const int r32 = lane & 31, hi = lane >> 5;
    const LAS unsigned char* p = kl + ((kt * 32 + r32) * (DQK + 8) + hi * 8) * 2;
#pragma unroll
    for (int i = 0; i < 16; ++i) s[i] = 0.f;
#pragma unroll
    for (int sg = 0; sg < DQK / 64; ++sg) {
        bf16x8 a0[4];
#pragma unroll
        for (int st = 0; st < 4; ++st) a0[st] = *(const LAS bf16x8*)(p + (sg * 4 + st) * 32);
        __builtin_amdgcn_s_setprio(1);
#pragma unroll
        for (int st = 0; st < 4; ++st) { const bf16x8 qv = QL ? *(const LAS bf16x8*)(ql + (sg * 4 + st) * 32) : qf[QL ? 0 : sg * 4 + st]; s = __builtin_amdgcn_mfma_f32_32x32x16_bf16(a0[st], qv, s, 0, 0, 0); }
        __builtin_amdgcn_s_setprio(0);
        if (DQK > 64) __builtin_amdgcn_sched_barrier(0);
    }
}
template <class M> __device__ __forceinline__ float mask_half(f32x16& s, int key0, const M& mk, bool act, int lane, bool allfull) {
    const int hi = lane >> 5; float mx = -INFINITY;
    if (allfull) {
#pragma unroll
        for (int r = 0; r < 16; r += 2) mx = max3f(mx, s[r], s[r + 1]);
        return mx;
    }
#pragma unroll
    for (int r = 0; r < 16; ++r) { const int k = key0 + crow(r, hi); s[r] = mk.valid(k, act) ? s[r] : -INFINITY; mx = fmaxf(mx, s[r]); }
    return mx;
}
template <int DV> __device__ __forceinline__ void online_half(f32x16& s, float mx, float& m, float& l, f32x16 (&O)[DV / 32]) {
    mx = max32(mx);
    const float mn = (mx - m > RESCALE_THR) ? mx : m, alpha = __builtin_amdgcn_exp2f(m - mn);
    float ps = 0.f;
#pragma unroll
    for (int r = 0; r < 16; ++r) { s[r] = __builtin_amdgcn_exp2f(s[r] - mn); ps += s[r]; }
    l = l * alpha + ps; m = mn;
    if (__any(alpha != 1.f)) {
#pragma unroll
        for (int dt = 0; dt < DV / 32; ++dt)
#pragma unroll
            for (int r = 0; r < 16; ++r) O[dt][r] *= alpha;
    }
}
template <int DV>
__device__ __forceinline__ void pv_half(const LAS unsigned char* vl, const f32x16& p, int kt, f32x16 (&O)[DV / 32], int lane) {
    const int hi = lane >> 5, g1 = (lane >> 4) & 1, i = lane & 15, q = i >> 2, pp = i & 3;
    const LAS unsigned char* vb = vl + ((kt * 32 + 4 * hi + q) * (DV + 32) + 16 * g1 + 4 * pp) * 2;
#pragma unroll
    for (int ks = 0; ks < 2; ++ks) {
        const bf16x8 pf = pfrag(p, ks);
        v4i16_t lo[DV / 32], hh[DV / 32];
#pragma unroll
        for (int dt = 0; dt < DV / 32; ++dt) { const LAS unsigned char* a = vb + (16 * ks) * (DV + 32) * 2 + dt * 64;
            lo[dt] = __builtin_amdgcn_ds_read_tr16_b64_v4i16((LAS v4i16_t*)a); hh[dt] = __builtin_amdgcn_ds_read_tr16_b64_v4i16((LAS v4i16_t*)(a + 8 * (DV + 32) * 2)); }
        __builtin_amdgcn_s_setprio(1);
#pragma unroll
        for (int dt = 0; dt < DV / 32; ++dt) { const bf16x8 vf = __builtin_shufflevector(lo[dt], hh[dt], 0, 1, 2, 3, 4, 5, 6, 7); O[dt] = __builtin_amdgcn_mfma_f32_32x32x16_bf16(vf, pf, O[dt], 0, 0, 0); }
        __builtin_amdgcn_s_setprio(0);
        if (DV > 64) __builtin_amdgcn_sched_barrier(0);
    }
}
template <int DQK, int DV, class M, bool SPLIT = false, int TPS = 1, int NSLOT = 3>
__device__ __forceinline__ void attn_run(LAS unsigned char* lds, const bf16* Kg, int kpitch, const bf16* Vg, int vpitch, int kmax, int t_lo, int t_hi,
                                         const bf16x8 (&qf)[DQK / 16], f32x16 (&O)[DV / 32], float& m, float& l, const M& mk) {
    typedef AT<DQK, DV> A;
    constexpr int NT = (DmaN<A::KP>::NIW + DmaN<A::VP>::NIW) * TPS;
    constexpr int SB = A::BYTES * TPS;
    const int tid = threadIdx.x, lane = tid & 63, wave = __builtin_amdgcn_readfirstlane(tid >> 6);
    if (t_lo >= t_hi) return;
    const int ns = (t_hi - t_lo + TPS - 1) / TPS;
    const unsigned ring = lds_addr(lds), dump = ring + (unsigned)(NSLOT * SB);
#define ATT_DMA(st, slot) do { _Pragma("unroll 1") for (int u_ = 0; u_ < TPS; ++u_) { const int tt_ = t_lo + (st) * TPS + u_; \
        tile_dma<DQK, A::KP>(Kg, kpitch, tt_ * 64, kmax, ring + (unsigned)(slot) * SB + u_ * A::BYTES + A::KOFF, dump, wave, lane); \
        tile_dma<DV, A::VP>(Vg, vpitch, tt_ * 64, kmax, ring + (unsigned)(slot) * SB + u_ * A::BYTES + A::VOFF, dump, wave, lane); } } while (0)
    ATT_DMA(0, 0);
    if (NSLOT == 3) { if (1 < ns) { ATT_DMA(1, 1); wait_bar<NT>(); } else wait_bar<0>(); }
    else wait_bar<0>();
    int slot = 0;
#pragma unroll 1
    for (int s = 0; s < ns; ++s) {
        const int sn = (slot == 0) ? NSLOT - 1 : slot - 1;
        if (s + NSLOT - 1 < ns) ATT_DMA(s + NSLOT - 1, sn);
#pragma unroll 1
        for (int u = 0; u < TPS; ++u) {
            const int t = t_lo + s * TPS + u;
            LAS unsigned char* cur = lds + slot * SB + u * A::BYTES;
            const bool act = (t < t_hi) && mk.prep(t * 64);
            if (__any(act)) {
                if (SPLIT) {
                    const bool allfull = __all(mk.full(t * 64, act));
#pragma unroll
                    for (int kt = 0; kt < 2; ++kt) {
                        f32x16 sh;
                        qk_half<DQK, false>(cur + A::KOFF, qf, sh, kt, lane, nullptr);
                        const float mx = mask_half(sh, t * 64 + kt * 32, mk, act, lane, allfull);
                        online_half<DV>(sh, mx, m, l, O);
                        pv_half<DV>(cur + A::VOFF, sh, kt, O, lane);
                    }
                } else {
                    f32x16 s0, s1;
                    const float cinit = QK_INIT ? ((m > 0.5f * NEG_BIG) ? -m : 0.f) : 0.f;
                    qk_tile<DQK, false>(cur + A::KOFF, qf, s0, s1, lane, nullptr, cinit);
                    const float mx = mask_tile(s0, s1, t * 64, mk, act, lane);
                    online_update<DV>(s0, s1, mx, m, l, O, cinit);
                    pv_tile<DV>(cur + A::VOFF, s0, s1, O, lane);
                }
            }
        }
        if (NSLOT == 3 && s + 2 < ns) wait_bar<NT>(); else wait_bar<0>();
        slot = (slot == NSLOT - 1) ? 0 : slot + 1;
    }
#undef ATT_DMA
}
template <int DQK> __device__ __forceinline__ void load_q(bf16x8 (&qf)[DQK / 16], const bf16* qrow, int lane) {
    const int hi = lane >> 5;
#pragma unroll
    for (int st = 0; st < DQK / 16; ++st) qf[st] = *(const bf16x8*)(qrow + st * 16 + hi * 8);
#pragma unroll
    for (int st = 0; st < DQK / 16; ++st) asm volatile("" : "+v"(qf[st]));
}
#ifndef DA_TPS
#define DA_TPS 2
#define DA_NSLOT 2
#endif

__device__ __forceinline__ void da_unit(LAS unsigned char* lds, const bf16* qkv, bf16* att, int b, int h, int qb, float lam, const float* subln, float* slotbase) {
    const int tid = threadIdx.x, lane = tid & 63, wave = __builtin_amdgcn_readfirstlane(tid >> 6), r32 = lane & 31, hi = lane >> 5;
    const int tpos = qb * 256 + wave * 32 + r32; const size_t row = (size_t)b * SEQ + tpos;
    unsigned o0p[32];
    const bf16* base = qkv + (size_t)b * SEQ * 4608;
    f32x16 O[4]; float ss = 0.f;
#pragma unroll 1
    for (int map = 0; map < 2; ++map) {
        bf16x8 qf[4]; load_q<64>(qf, qkv + row * 4608 + map * 512 + h * 64, lane);
#pragma unroll
        for (int dt = 0; dt < 4; ++dt)
#pragma unroll
            for (int r = 0; r < 16; ++r) O[dt][r] = 0.f;
        float m = NEG_BIG, l = 0.f;
        attn_run<64, 128, MaskCausal, false, DA_TPS, DA_NSLOT>(lds, base + 1024 + map * 512 + h * 64, 4608, base + 2048 + h * 128, 4608, SEQ - 1, 0, 4 * (qb + 1), qf, O, m, l, MaskCausal{tpos});
        const float inv = 1.f / sum32(l);
        if (map == 0) {
#pragma unroll
            for (int dt = 0; dt < 4; ++dt)
#pragma unroll
                for (int r = 0; r < 16; r += 2) o0p[dt * 8 + (r >> 1)] = cvtpk(O[dt][r] * inv, O[dt][r + 1] * inv);
        } else {
#pragma unroll
            for (int dt = 0; dt < 4; ++dt)
#pragma unroll
                for (int r = 0; r < 16; r += 2) { const unsigned w = o0p[dt * 8 + (r >> 1)];
                    const float oa = bflo(w) - lam * (O[dt][r] * inv), ob = bfhi(w) - lam * (O[dt][r + 1] * inv); O[dt][r] = oa; O[dt][r + 1] = ob; ss += oa * oa + ob * ob; }
        }
    }
    const float rn = 1.0f / sqrtf(sum32(ss) * (1.f / 128.f) + NORM_EPS) * 0.8f;
    bf16* orow = att + row * 2048 + h * 128;
#pragma unroll
    for (int dt = 0; dt < 4; ++dt)
#pragma unroll
        for (int g4 = 0; g4 < 4; ++g4) {
            const int d = dt * 32 + 8 * g4 + 4 * hi; const f32x4 sg = *(const f32x4*)(subln + d);
            u32x2 w; w.x = cvtpk(O[dt][4 * g4] * rn * sg.x, O[dt][4 * g4 + 1] * rn * sg.y); w.y = cvtpk(O[dt][4 * g4 + 2] * rn * sg.z, O[dt][4 * g4 + 3] * rn * sg.w);
            *(u32x2*)(orow + d) = w;
        }
}
__device__ __forceinline__ void swa_unit(LAS unsigned char* lds, const bf16* qkv, bf16* att, int b, int kvh, int tb, const float* sinks) {
    const int tid = threadIdx.x, lane = tid & 63, wave = __builtin_amdgcn_readfirstlane(tid >> 6), c = lane & 31, hi = lane >> 5;
    const int t0 = tb * 64, tpos = t0 + wave * 8 + (c >> 2), qh = kvh * 4 + (c & 3); const size_t row = (size_t)b * SEQ + tpos;
    const bf16* base = qkv + (size_t)b * SEQ * 4608;
    bf16x8 qf[4]; load_q<64>(qf, qkv + row * 4608 + 3072 + qh * 64, lane);
    f32x16 O[2];
#pragma unroll
    for (int dt = 0; dt < 2; ++dt)
#pragma unroll
        for (int r = 0; r < 16; ++r) O[dt][r] = 0.f;
    float m = sinks[qh] * LOG2E, l = (hi == 0) ? 1.f : 0.f;
    asm volatile("" : "+v"(m));
    const int t_lo = tb >= 2 ? tb - 2 : 0;
    attn_run<64, 64, MaskWindow>(lds, base + 4096 + kvh * 64, 4608, base + 4352 + kvh * 64, 4608, SEQ - 1, t_lo, tb + 1, qf, O, m, l, MaskWindow{tpos, 128});
    const float inv = 1.f / sum32(l);
    bf16* orow = att + row * 2048 + 1024 + qh * 64;
#pragma unroll
    for (int dt = 0; dt < 2; ++dt)
#pragma unroll
        for (int g4 = 0; g4 < 4; ++g4) {
            const int d = dt * 32 + 8 * g4 + 4 * hi;
            u32x2 w; w.x = cvtpk(O[dt][4 * g4] * inv, O[dt][4 * g4 + 1] * inv); w.y = cvtpk(O[dt][4 * g4 + 2] * inv, O[dt][4 * g4 + 3] * inv);
            *(u32x2*)(orow + d) = w;
        }
}

__device__ __forceinline__ void swa_naive(const bf16* qkv, bf16* att, int b, int tpos, int qh, const float* sinks, int lane) {
    const size_t row = (size_t)b * SEQ + tpos; const int kvh = qh >> 2;
    const bf16* q = qkv + row * 4608 + 3072 + qh * 64;
    float sc[2];
#pragma unroll
    for (int j = 0; j < 2; ++j) {
        const int key = tpos - 127 + lane + 64 * j;
        float s = -INFINITY;
        if (key >= 0) { const bf16* k = qkv + ((size_t)b * SEQ + key) * 4608 + 4096 + kvh * 64; float a = 0.f; for (int d = 0; d < 64; ++d) a += bf2f(q[d]) * bf2f(k[d]); s = a; }
        sc[j] = s;
    }
    const float snk = sinks[qh] * LOG2E;
    float mx = fmaxf(fmaxf(sc[0], sc[1]), snk);
#pragma unroll
    for (int o = 1; o < 64; o <<= 1) mx = fmaxf(mx, __shfl_xor(mx, o));
    const float p0 = exp2f(sc[0] - mx), p1 = exp2f(sc[1] - mx);
    const float den = wave_sum(p0 + p1) + exp2f(snk - mx);
    float acc = 0.f;
    for (int kk = 0; kk < 128; ++kk) {
        const int key = tpos - 127 + kk; const float p = __shfl(kk < 64 ? p0 : p1, kk & 63);
        if (key >= 0) acc += p * bf2f(qkv[((size_t)b * SEQ + key) * 4608 + 4352 + kvh * 64 + lane]);
    }
    const float o = acc / den;
    att[row * 2048 + 1024 + qh * 64 + lane] = (bf16)(cvtpk(o, 0.f) & 0xffffu);
}

struct Args { const float* in[20]; float* out; unsigned char* ws; int ph_lo, ph_hi; };
typedef const __attribute__((address_space(4))) Args* KArgs;
__device__ __forceinline__ KArgs kargs() { KArgs p = (KArgs)__builtin_amdgcn_kernarg_segment_ptr(); asm volatile("" : "+s"(p)); return p; }

template <int CTRL> __device__ __forceinline__ float dppf(float v) { return __int_as_float(__builtin_amdgcn_update_dpp(0, __float_as_int(v), CTRL, 0xF, 0xF, false)); }
template <int CTRL> __device__ __forceinline__ unsigned dppu(unsigned v) { return (unsigned)__builtin_amdgcn_update_dpp(0, (int)v, CTRL, 0xF, 0xF, false); }
__device__ __forceinline__ float sum8(float v) { v += dppf<0xB1>(v); v += dppf<0x4E>(v); v += dppf<0x141>(v); return v; }
__device__ __forceinline__ unsigned wave_max_u32(unsigned v) {
    unsigned t;
    t = dppu<0xB1>(v); v = v > t ? v : t;
    t = dppu<0x4E>(v); v = v > t ? v : t;
    t = dppu<0x141>(v); v = v > t ? v : t;
    t = dppu<0x140>(v); v = v > t ? v : t;
    const unsigned a = __builtin_amdgcn_readlane(v, 0), b = __builtin_amdgcn_readlane(v, 16), c = __builtin_amdgcn_readlane(v, 32), d = __builtin_amdgcn_readlane(v, 48);
    const unsigned ab = a > b ? a : b, cd = c > d ? c : d;
    return ab > cd ? ab : cd;
}
__device__ __forceinline__ unsigned ordf(float f) { const unsigned u = __float_as_uint(f); return u ^ ((u >> 31) ? 0xFFFFFFFFu : 0x80000000u); }

#ifndef NSA_SPLIT
#define NSA_SPLIT false
#endif
#ifndef NSA_PROBE
#define NSA_PROBE 0
#endif
constexpr int NSA_TILE = AT<128, 128>::BYTES;
constexpr int NSA_OUT = 2 * NSA_TILE + 1024;
constexpr int NSA_IMPA = NSA_OUT + 65536, NSA_IMPP = 132, NSA_SEL = NSA_IMPA + 32 * NSA_IMPP * 4;
static_assert(NSA_SEL + 512 <= LDS_BYTES && 3 * NSA_TILE + 1024 <= NSA_IMPA, "nsa lds map");

template <int PASS>
__device__ __forceinline__ void nsa_cmp_pass(LAS unsigned char* lds, const bf16* Kg, const bf16* Vg, int t_hi, const bf16x8 (&qf)[8], f32x16 (&O)[4], float& m, float& l, float invl, const MaskCmp& mk, int tl) {
    typedef AT<128, 128> A;
    constexpr int NT = DmaN<A::KP>::NIW + (PASS == 2 ? DmaN<A::VP>::NIW : 0);
    const int tid = threadIdx.x, lane = tid & 63, hi = lane >> 5, wave = __builtin_amdgcn_readfirstlane(tid >> 6);
    LAS float* impA = (LAS float*)(lds + NSA_IMPA);
    const unsigned ring = lds_addr(lds), dump = ring + 3u * A::BYTES;
#define CMP_DMA(t, slot) do { tile_dma<128, A::KP>(Kg, 128, (t) * 64, 511, ring + (unsigned)(slot) * A::BYTES + A::KOFF, dump, wave, lane); \
                              if (PASS == 2) tile_dma<128, A::VP>(Vg, 128, (t) * 64, 511, ring + (unsigned)(slot) * A::BYTES + A::VOFF, dump, wave, lane); } while (0)
    CMP_DMA(0, 0);
    if (1 < t_hi) { CMP_DMA(1, 1); wait_bar<NT>(); } else wait_bar<0>();
    float carry = 0.f;
    int slot = 0;
#pragma unroll 1
    for (int t = 0; t < t_hi; ++t) {
        LAS unsigned char* cur = lds + slot * A::BYTES;
        const int s2 = slot == 0 ? 2 : slot - 1;
        if (t + 2 < t_hi) CMP_DMA(t + 2, s2);
        const bool act = mk.prep(t * 64);
        if (__any(act)) {
            f32x16 s0, s1;
            qk_tile<128, false>(cur + A::KOFF, qf, s0, s1, lane, nullptr);
            float mx = mask_tile(s0, s1, t * 64, mk, act, lane);
            if (PASS == 1) {
                mx = max32(mx);
                const float mn = fmaxf(m, mx), alpha = __builtin_amdgcn_exp2f(m - mn); float ps = 0.f;
#pragma unroll
                for (int r = 0; r < 16; ++r) ps += __builtin_amdgcn_exp2f(s0[r] - mn) + __builtin_amdgcn_exp2f(s1[r] - mn);
                l = l * alpha + ps; m = mn;
            } else {
#pragma unroll
                for (int r = 0; r < 16; ++r) { s0[r] = __builtin_amdgcn_exp2f(s0[r] - m) * invl; s1[r] = __builtin_amdgcn_exp2f(s1[r] - m) * invl; }
#pragma unroll
                for (int kt = 0; kt < 2; ++kt) {
                    const f32x16& p = kt ? s1 : s0;
#pragma unroll
                    for (int g4 = 0; g4 < 4; ++g4) {
                        auto rr = __builtin_amdgcn_permlane32_swap(__float_as_uint(p[4 * g4 + 3]), __float_as_uint(p[4 * g4 + 3]), false, false);
                        const float prev = hi ? __uint_as_float(rr[0]) : carry;
                        carry = __uint_as_float(rr[1]);
                        float a = p[4 * g4] + p[4 * g4 + 1] + p[4 * g4 + 2] + 0.5f * (p[4 * g4 + 3] + prev);
                        a = sum8(a);
                        const int si = 16 * t + 8 * kt + 2 * g4 + hi;
                        if ((lane & 7) == 0) impA[tl * NSA_IMPP + si] = a;
                    }
                }
                pv_tile<128>(cur + A::VOFF, s0, s1, O, lane);
            }
        }
        if (t + 2 < t_hi) wait_bar<NT>(); else wait_bar<0>();
        slot = slot == 2 ? 0 : slot + 1;
    }
#undef CMP_DMA
}
__device__ __forceinline__ void nsa_window_unit(LAS unsigned char* lds, int b, int kvh, int tb) {
#define ws (kargs()->ws)
    const int tid = threadIdx.x, lane = tid & 63, wave = __builtin_amdgcn_readfirstlane(tid >> 6), c = lane & 31, hi = lane >> 5;
    const int t0 = tb * 32, tl = wave * 4 + (c >> 3), tok = t0 + tl, qh = kvh * 8 + (c & 7); const size_t row = (size_t)b * SEQ + tok;
    __syncthreads();
    bf16x8 qf[8]; load_q<128>(qf, (const bf16*)(ws + WS_Q1) + row * 2048 + qh * 128, lane);
    f32x16 O[4];
#pragma unroll
    for (int dt = 0; dt < 4; ++dt)
#pragma unroll
        for (int r = 0; r < 16; ++r) O[dt][r] = 0.f;
    float m = NEG_BIG, l = 0.f;
    const MaskWindow mk{tok, 512};
    const bf16* Kg = (const bf16*)(ws + WS_KW) + (size_t)b * SEQ * 256 + kvh * 128; const bf16* Vg = (const bf16*)(ws + WS_VW) + (size_t)b * SEQ * 256 + kvh * 128;
    const int t_lo = t0 >= 511 ? ((t0 - 511) >> 6) : 0;
    attn_run<128, 128, MaskWindow, NSA_SPLIT, 1, 2>(lds, Kg, 256, Vg, 256, SEQ - 1, t_lo, ((t0 + 31) >> 6) + 1, qf, O, m, l, mk);
    l = sum32(l);
    const float sc = ((const float*)(ws + WS_GATES))[row * 48 + 2 * 16 + qh] / l;
    bf16* orow = (bf16*)(ws + WS_ATT) + row * 2048 + qh * 128;
#pragma unroll
    for (int dt = 0; dt < 4; ++dt)
#pragma unroll
        for (int g4 = 0; g4 < 4; ++g4) {
            u32x2 w; w.x = cvtpk(sc * O[dt][4 * g4], sc * O[dt][4 * g4 + 1]); w.y = cvtpk(sc * O[dt][4 * g4 + 2], sc * O[dt][4 * g4 + 3]);
            *(u32x2*)(orow + dt * 32 + 8 * g4 + 4 * hi) = w;
        }
#undef ws
}
__device__ __forceinline__ void nsa_unit(LAS unsigned char* lds, int b, int kvh, int tb) {
#define ws (kargs()->ws)
    const int tid = threadIdx.x, lane = tid & 63, wave = __builtin_amdgcn_readfirstlane(tid >> 6), c = lane & 31, hi = lane >> 5;
    const int t0 = tb * 32, tl = wave * 4 + (c >> 3), tok = t0 + tl, qh = kvh * 8 + (c & 7); const size_t row = (size_t)b * SEQ + tok;
    LAS float* impA = (LAS float*)(lds + NSA_IMPA);
    LAS unsigned long long* selm = (LAS unsigned long long*)(lds + NSA_SEL);
    LAS unsigned* outl = (LAS unsigned*)(lds + NSA_OUT) + wave * 2048;

#define NSA_SLOT ((float*)(ws + WS_SLOT) + ((size_t)blockIdx.x * NWAVES + wave) * 4096)
#define NSA_GATE(br) (((const float*)(ws + WS_GATES))[((size_t)b * SEQ + t0 + wave * 4 + (c >> 3)) * 48 + (br) * 16 + kvh * 8 + (c & 7)])
    __syncthreads();
    bf16x8 qf[8]; load_q<128>(qf, (const bf16*)(ws + WS_Q1) + row * 2048 + qh * 128, lane);
    for (int i = tid; i < 32 * NSA_IMPP; i += NTHREADS) impA[i] = 0.f;
    f32x16 O[4];
    {
        const bf16* Kc = (const bf16*)(ws + WS_KCMP) + (size_t)(b * 2 + kvh) * 512 * 128; const bf16* Vc = (const bf16*)(ws + WS_VCMP) + (size_t)(b * 2 + kvh) * 512 * 128;
        const MaskCmp mk{(tok - 31) >> 4};
        const int t_hi = ((2 * tb) >> 6) + 1;
        float m = NEG_BIG, l = 0.f;
#if NSA_PROBE == 3
        { nsa_cmp_pass<1>(lds, Kc, Vc, t_hi, qf, O, m, l, 0.f, mk, tl); float l2 = sum32(l); const float iv = l2 > 0.f ? 1.f / l2 : 0.f;
#pragma unroll
          for (int dt = 0; dt < 4; ++dt)
#pragma unroll
            for (int r = 0; r < 16; ++r) O[dt][r] = 0.f;
          nsa_cmp_pass<2>(lds, Kc, Vc, t_hi, qf, O, m, l, iv, mk, tl);
#pragma unroll
          for (int dt = 0; dt < 4; ++dt) asm volatile("" :: "v"(O[dt]));
          m = NEG_BIG; l = 0.f; }
#endif
        nsa_cmp_pass<1>(lds, Kc, Vc, t_hi, qf, O, m, l, 0.f, mk, tl);
        l = sum32(l); const float invl = l > 0.f ? 1.f / l : 0.f;
#pragma unroll
        for (int dt = 0; dt < 4; ++dt)
#pragma unroll
            for (int r = 0; r < 16; ++r) O[dt][r] = 0.f;
        nsa_cmp_pass<2>(lds, Kc, Vc, t_hi, qf, O, m, l, invl, mk, tl);
        const float g0 = NSA_GATE(0);
#pragma unroll
        for (int dt = 0; dt < 4; ++dt)
#pragma unroll
            for (int r = 0; r < 16; r += 2) outl[(dt * 8 + (r >> 1)) * 64 + lane] = cvtpk(g0 * O[dt][r], g0 * O[dt][r + 1]);
    }
    asm volatile("s_waitcnt lgkmcnt(0)" ::: "memory");
    {
        const int rw = lane >> 4, li = lane & 15, tlj = wave * 4 + rw, cur = t0 >> 6;
        unsigned selb = 0u;
        if (cur < 16) {
#pragma unroll
            for (int k = 0; k < 8; ++k) selb |= (li * 8 + k <= cur) ? (1u << k) : 0u;
        } else {
            unsigned kk[8];
            { const f32x4 x0 = *(const LAS f32x4*)(impA + tlj * NSA_IMPP + li * 8), x1 = *(const LAS f32x4*)(impA + tlj * NSA_IMPP + li * 8 + 4);
#pragma unroll
              for (int k = 0; k < 8; ++k) { const int s = li * 8 + k; const float v = k < 4 ? x0[k & 3] : x1[k & 3];
                  const bool forced = (s == 0) || (s == cur) || (s == cur - 1);
                  kk[k] = (s > cur) ? 0u : ((forced ? 0xFFFFFF80u : (ordf(v) & 0xFFFFFF80u)) | (unsigned)(127 - s)); } }
#pragma unroll 1
            for (int r = 0; r < 16; ++r) {
                unsigned mk_ = kk[0];
#pragma unroll
                for (int k = 1; k < 8; ++k) mk_ = mk_ > kk[k] ? mk_ : kk[k];
                unsigned t;
                t = dppu<0xB1>(mk_); mk_ = mk_ > t ? mk_ : t; t = dppu<0x4E>(mk_); mk_ = mk_ > t ? mk_ : t; t = dppu<0x141>(mk_); mk_ = mk_ > t ? mk_ : t; t = dppu<0x140>(mk_); mk_ = mk_ > t ? mk_ : t;
#pragma unroll
                for (int k = 0; k < 8; ++k) { const bool hit = kk[k] == mk_; selb |= hit ? (1u << k) : 0u; kk[k] = hit ? 0u : kk[k]; }
            }
        }
        ((LAS unsigned char*)selm)[tlj * 16 + li] = (unsigned char)selb;
    }
    asm volatile("s_waitcnt lgkmcnt(0)" ::: "memory");
    {
        const MaskSel mk{tok, selm[tl * 2], selm[tl * 2 + 1]};
#pragma unroll
        for (int dt = 0; dt < 4; ++dt)
#pragma unroll
            for (int r = 0; r < 16; ++r) O[dt][r] = 0.f;
        float m = NEG_BIG, l = 0.f;
        const bf16* Kg = (const bf16*)(ws + WS_KSL) + (size_t)b * SEQ * 256 + kvh * 128; const bf16* Vg = (const bf16*)(ws + WS_VSL) + (size_t)b * SEQ * 256 + kvh * 128;
#if NSA_PROBE == 1
        { attn_run<128, 128, MaskSel, NSA_SPLIT, 1, 2>(lds, Kg, 256, Vg, 256, SEQ - 1, 0, ((t0 + 31) >> 6) + 1, qf, O, m, l, mk);
#pragma unroll
          for (int dt = 0; dt < 4; ++dt) { asm volatile("" :: "v"(O[dt]));
#pragma unroll
            for (int r = 0; r < 16; ++r) O[dt][r] = 0.f; }
          m = NEG_BIG; l = 0.f; }
#endif
        attn_run<128, 128, MaskSel, NSA_SPLIT, 1, 2>(lds, Kg, 256, Vg, 256, SEQ - 1, 0, ((t0 + 31) >> 6) + 1, qf, O, m, l, mk);
        l = sum32(l); const float sc = NSA_GATE(1) / l;
        bf16* orow = (bf16*)(ws + WS_ATT) + ((size_t)b * SEQ + t0 + wave * 4 + (c >> 3)) * 2048 + (kvh * 8 + (c & 7)) * 128;
#pragma unroll
        for (int dt = 0; dt < 4; ++dt)
#pragma unroll
            for (int g4 = 0; g4 < 4; ++g4) {
                const unsigned w0 = outl[(dt * 8 + 2 * g4) * 64 + lane], w1 = outl[(dt * 8 + 2 * g4 + 1) * 64 + lane];
                const u32x2 pw = *(const u32x2*)(orow + dt * 32 + 8 * g4 + 4 * hi);
                u32x2 w; w.x = cvtpk(bflo(w0) + bflo(pw.x) + sc * O[dt][4 * g4], bfhi(w0) + bfhi(pw.x) + sc * O[dt][4 * g4 + 1]);
                w.y = cvtpk(bflo(w1) + bflo(pw.y) + sc * O[dt][4 * g4 + 2], bfhi(w1) + bfhi(pw.y) + sc * O[dt][4 * g4 + 3]);
                *(u32x2*)(orow + dt * 32 + 8 * g4 + 4 * hi) = w;
            }
    }
#undef ws
}

#define XB_TMO      128
#define XB_XCNT(j)  (256  + 64 * (j))
#define XB_XSUB(j)  (1280 + 64 * (j))
#define XB_XGEN(j)  (2304 + 64 * (j))
#define XB_TOP      3328
#define XB_TOPGEN   3392
#define XCD_BAR_WORDS 3456
#define XB_SPIN_CAP (1u << 18)

__device__ __forceinline__ unsigned xb_ld(unsigned* p)              { return __hip_atomic_load(p, __ATOMIC_RELAXED, __HIP_MEMORY_SCOPE_AGENT); }
__device__ __forceinline__ unsigned xb_add(unsigned* p, unsigned v) { return __hip_atomic_fetch_add(p, v, __ATOMIC_RELAXED, __HIP_MEMORY_SCOPE_AGENT); }
__device__ __forceinline__ unsigned xb_xcc_id() { return (unsigned)__builtin_amdgcn_s_getreg((3 << 11) | 20) & 0xFu; }
#define XB_SPIN(cond, bar) do { unsigned _sp = 0; while (cond) { __builtin_amdgcn_s_sleep(1); \
    if ((++_sp & 255u) == 0u) { if (xb_ld(&(bar)[XB_TMO])) break; if (_sp > XB_SPIN_CAP) { atomicAdd(&(bar)[XB_TMO], 1u); break; } } } } while (0)

struct XcdBarrier {
    unsigned* bar; unsigned x;
    volatile unsigned* st;
};

__device__ __forceinline__ XcdBarrier xcd_barrier_post(unsigned* bar, volatile unsigned* st) {
    XcdBarrier b; b.bar = bar; b.x = xb_xcc_id(); b.st = st;
    if (threadIdx.x == 0) (void)xb_add(&bar[XB_XCNT(b.x)], 1u);
    return b;
}
__device__ __forceinline__ void xcd_barrier_complete(unsigned* bar, unsigned x, unsigned& nloc, unsigned& nx) {
    const unsigned G = gridDim.x * gridDim.y * gridDim.z;
    unsigned sum, cnt, mine, sp = 0u;
    for (;;) {
        sum = 0u; cnt = 0u; mine = 0u;
#pragma unroll
        for (unsigned j = 0; j < 16; ++j) { const unsigned c = xb_ld(&bar[XB_XCNT(j)]); sum += c; cnt += (c > 0u) ? 1u : 0u; mine = (j == x) ? c : mine; }
        if (sum == G) break;
        __builtin_amdgcn_s_sleep(1);
        if ((++sp & 255u) == 0u) { if (xb_ld(&bar[XB_TMO])) break; if (sp > XB_SPIN_CAP) { atomicAdd(&bar[XB_TMO], 1u); break; } }
    }
    nloc = mine > 0u ? mine : 1u; nx = cnt > 0u ? cnt : 1u;
}

__device__ __forceinline__ void xcd_barrier(const XcdBarrier& b) {
    asm volatile("s_waitcnt vmcnt(0)" ::: "memory");
    __syncthreads();
    if (threadIdx.x == 0) {
        unsigned* bar = b.bar;
        __builtin_amdgcn_s_waitcnt(0);
        unsigned nloc = b.st[0], nx = b.st[1];
        if (nloc == 0u) { xcd_barrier_complete(bar, b.x, nloc, nx); b.st[0] = nloc; b.st[1] = nx; }
        const unsigned old = xb_add(&bar[XB_XSUB(b.x)], 1u);
        const unsigned gen = old / nloc;
        if (old + 1u == (gen + 1u) * nloc) {
            __builtin_amdgcn_fence(__ATOMIC_RELEASE, "agent");
            asm volatile("s_waitcnt vmcnt(0)" ::: "memory");
            const unsigned og = xb_add(&bar[XB_TOP], 1u);
            const unsigned tg = og / nx;
            if (og + 1u == (tg + 1u) * nx) xb_add(&bar[XB_TOPGEN], 1u);
            else XB_SPIN(xb_ld(&bar[XB_TOPGEN]) == tg, bar);
            __builtin_amdgcn_fence(__ATOMIC_ACQUIRE, "agent");
            xb_add(&bar[XB_XGEN(b.x)], 1u);
            asm volatile("s_waitcnt vmcnt(0)" ::: "memory");
        } else {
            XB_SPIN(xb_ld(&bar[XB_XGEN(b.x)]) == gen, bar);
            __builtin_amdgcn_fence(__ATOMIC_ACQUIRE, "agent");
            asm volatile("s_waitcnt vmcnt(0)" ::: "memory");
        }
    }
    __syncthreads();
}

typedef unsigned v6u_t __attribute__((ext_vector_type(6)));
typedef float v32f_t __attribute__((ext_vector_type(32)));
typedef __bf16 v32bf_t __attribute__((ext_vector_type(32)));
__device__ __forceinline__ v32bf_t fp6_to_bf16x32(v6u_t p) { return __builtin_amdgcn_cvt_scalef32_pk32_bf16_fp6(p, 1.0f); }
__device__ __forceinline__ v32f_t fp6_to_f32x32(v6u_t p) { return __builtin_amdgcn_cvt_scalef32_pk32_f32_fp6(p, 1.0f); }
#define PEER_BKT(r) ((((r) >> 15) & 1u) << 8 | (((r) & 0x3FFFu) >> 6))
#ifndef PEER_HCOPY
#define PEER_HCOPY 0
#endif
#ifndef PEER_SELPF
#define PEER_SELPF 1
#endif
#ifndef PEER_TOKPF
#define PEER_TOKPF 0
#endif
#ifndef PEER_DRYMASK
#define PEER_DRYMASK 0
#endif
#ifndef PEER_NT
#define PEER_NT 0
#endif
#ifndef PEER_NTX
#define PEER_NTX 0
#endif
#ifndef PEER_SWEEP_SYNC
#define PEER_SWEEP_SYNC 0
#endif
#ifndef PEER_P
#define PEER_P 8
#endif
constexpr int PEER_SC = 0, PEER_CS = 98304, PEER_REC = 131072, PEER_SRT = 147456;
__device__ __forceinline__ float sum16(float v) { v += dppf<0xB1>(v); v += dppf<0x4E>(v); v += dppf<0x141>(v); v += dppf<0x140>(v); return v; }
__device__ __forceinline__ float dot8(const u32x4& a, const u32x4& b, float acc) {
    acc = fmaf(bflo(a.x), bflo(b.x), acc); acc = fmaf(bfhi(a.x), bfhi(b.x), acc);
    acc = fmaf(bflo(a.y), bflo(b.y), acc); acc = fmaf(bfhi(a.y), bfhi(b.y), acc);
    acc = fmaf(bflo(a.z), bflo(b.z), acc); acc = fmaf(bfhi(a.z), bfhi(b.z), acc);
    acc = fmaf(bflo(a.w), bflo(b.w), acc); acc = fmaf(bfhi(a.w), bfhi(b.w), acc);
    return acc;
}
__device__ __forceinline__ void cand_ij(int c, int& i, int& j) {
    if (c < 16) { i = 0; j = c; } else if (c < 24) { i = 1; j = c - 16; } else if (c < 29) { i = 2; j = c - 24; } else if (c < 33) { i = 3; j = c - 29; }
    else if (c < 36) { i = 4; j = c - 33; } else if (c < 38) { i = 5; j = c - 36; } else if (c < 40) { i = 6; j = c - 38; } else if (c < 42) { i = 7; j = c - 40; }
    else { i = c - 34; j = 0; }
}
template <int MODE, bool DRY = false, bool SELONLY = false>
__device__ __forceinline__ void peer_tile(LAS unsigned char* lds, int tile, int layer, const XcdBarrier& xb) {
#define PWS (kargs()->ws)
#define q ((const bf16*)(PWS + WS_Q1))
#define subk ((const bf16*)(PWS + WS_SUBK) + (size_t)layer * (8 * 2 * 128 * 128))
#define utab ((const unsigned char*)(PWS + WS_TAB + (size_t)layer * 48 * MiB))
#define vtab ((const unsigned char*)(PWS + WS_TAB + (size_t)layer * 48 * MiB + 24 * MiB))
#define tscale ((const float*)(PWS + WS_TSCALE) + (size_t)layer * 2 * 16384)
#define hbuf ((bf16*)(PWS + WS_H))
#define xbuf ((bf16*)(PWS + WS_XB))
#define fout (kargs()->out)
#define gate ((const float*)(PWS + WS_MOD) + (size_t)(layer * 2 + 1) * 2 * 6144 + 4096)
#define g_next (MODE == 0 ? kargs()->in[4] + 2 * 2048 : kargs()->in[19])
#define mod_next ((const float*)(PWS + WS_MOD) + (size_t)2 * 2 * 6144)
    int tid_ = threadIdx.x; asm volatile("" : "+v"(tid_));
    const int tid = tid_, lane = tid & 63, wave = __builtin_amdgcn_readfirstlane(tid >> 6), r32 = lane & 31, hi = lane >> 5;
    LAS float* sc = (LAS float*)(lds + PEER_SC); LAS unsigned* rec = (LAS unsigned*)(lds + PEER_REC);
    const int tok0 = tile * 32;
    const int rw = lane >> 4, li = lane & 15, tlr = wave * 4 + rw;
    LAS float* cscr = (LAS float*)(lds + PEER_CS) + wave * 512;
    bf16x8 fa[8], fb[8];
#if PEER_SELPF
    {   const int p = wave >> 2, kt = wave & 3;
        const bf16* ap = subk + ((size_t)((0 * 2 + p) * 128 + kt * 32 + r32)) * 128 + hi * 8; const bf16* bp = q + (size_t)(tok0 + r32) * 2048 + p * 128 + hi * 8;
#pragma unroll
        for (int st = 0; st < 8; ++st) { fa[st] = *(const bf16x8*)(ap + st * 16); fb[st] = *(const bf16x8*)(bp + st * 16); } }
#endif
#pragma unroll 1
    for (int h = 0; h < 8; ++h) {
        LAS float* scb = sc + (h & 1) * 8192;
        {
            const int p = wave >> 2, kt = wave & 3;
            f32x16 s;
#pragma unroll
            for (int i = 0; i < 16; ++i) s[i] = 0.f;
#if PEER_SELPF
#pragma unroll
            for (int st = 0; st < 8; ++st) s = __builtin_amdgcn_mfma_f32_32x32x16_bf16(fa[st], fb[st], s, 0, 0, 0);
            if (h + 1 < 8) {
                const bf16* ap = subk + ((size_t)(((h + 1) * 2 + p) * 128 + kt * 32 + r32)) * 128 + hi * 8; const bf16* bp = q + (size_t)(tok0 + r32) * 2048 + (h + 1) * 256 + p * 128 + hi * 8;
#pragma unroll
                for (int st = 0; st < 8; ++st) { fa[st] = *(const bf16x8*)(ap + st * 16); fb[st] = *(const bf16x8*)(bp + st * 16); }
            }
#else
            const bf16* ap = subk + ((size_t)((h * 2 + p) * 128 + kt * 32 + r32)) * 128 + hi * 8;
            const bf16* bp = q + (size_t)(tok0 + r32) * 2048 + h * 256 + p * 128 + hi * 8;
#pragma unroll
            for (int st = 0; st < 8; ++st) s = __builtin_amdgcn_mfma_f32_32x32x16_bf16(*(const bf16x8*)(ap + st * 16), *(const bf16x8*)(bp + st * 16), s, 0, 0, 0);
#endif
#pragma unroll
            for (int r = 0; r < 16; ++r) scb[(p * 32 + r32) * 128 + kt * 32 + crow(r, hi)] = s[r];
        }
        __syncthreads();
        {
            const LAS float* s0 = scb + tlr * 128; const LAS float* s1 = scb + (32 + tlr) * 128;
            unsigned ka[8], kb[8];
            { const f32x4 x0 = *(const LAS f32x4*)(s0 + li * 8), x1 = *(const LAS f32x4*)(s0 + li * 8 + 4), y0 = *(const LAS f32x4*)(s1 + li * 8), y1 = *(const LAS f32x4*)(s1 + li * 8 + 4);
#pragma unroll
              for (int k = 0; k < 4; ++k) { ka[k] = (ordf(x0[k]) & 0xFFFFFF80u) | (unsigned)(127 - (li * 8 + k)); ka[4 + k] = (ordf(x1[k]) & 0xFFFFFF80u) | (unsigned)(127 - (li * 8 + 4 + k));
                  kb[k] = (ordf(y0[k]) & 0xFFFFFF80u) | (unsigned)(127 - (li * 8 + k)); kb[4 + k] = (ordf(y1[k]) & 0xFFFFFF80u) | (unsigned)(127 - (li * 8 + 4 + k)); } }
            unsigned ra = 0u, rb = 0u;
#pragma unroll 1
            for (int r = 0; r < 16; ++r) {
                unsigned ma = ka[0], mb = kb[0];
#pragma unroll
                for (int k = 1; k < 8; ++k) { ma = ma > ka[k] ? ma : ka[k]; mb = mb > kb[k] ? mb : kb[k]; }
                unsigned t;
                t = dppu<0xB1>(ma); ma = ma > t ? ma : t; t = dppu<0xB1>(mb); mb = mb > t ? mb : t;
                t = dppu<0x4E>(ma); ma = ma > t ? ma : t; t = dppu<0x4E>(mb); mb = mb > t ? mb : t;
                t = dppu<0x141>(ma); ma = ma > t ? ma : t; t = dppu<0x141>(mb); mb = mb > t ? mb : t;
                t = dppu<0x140>(ma); ma = ma > t ? ma : t; t = dppu<0x140>(mb); mb = mb > t ? mb : t;
#pragma unroll
                for (int k = 0; k < 8; ++k) { ka[k] = ka[k] == ma ? 0u : ka[k]; kb[k] = kb[k] == mb ? 0u : kb[k]; }
                if (li == r) { ra = ma; rb = mb; }
            }
            const int ia = 127 - (int)(ra & 127u), ib = 127 - (int)(rb & 127u);
            const float av = s0[ia], bv = s1[ib];
            unsigned ck[4]; const int rowbase = lane & 48;
#pragma unroll
            for (int u = 0; u < 4; ++u) {
                const int c = li + 16 * u; int ci, cj; cand_ij(c < 50 ? c : 0, ci, cj);
                const float cand = __shfl(av, rowbase + ci) + __shfl(bv, rowbase + cj);
                const int ce = __shfl(ia, rowbase + ci) * 128 + __shfl(ib, rowbase + cj);
                cscr[rw * 64 + c] = cand; ((LAS int*)cscr)[256 + rw * 64 + c] = ce;
                ck[u] = c < 50 ? ((ordf(cand) & 0xFFFFFFC0u) | (unsigned)(63 - c)) : 0u;
            }
            unsigned rc = 0u;
#pragma unroll 1
            for (int r = 0; r < 16; ++r) {
                unsigned mc = ck[0] > ck[1] ? ck[0] : ck[1]; { const unsigned m2 = ck[2] > ck[3] ? ck[2] : ck[3]; mc = mc > m2 ? mc : m2; }
                unsigned t;
                t = dppu<0xB1>(mc); mc = mc > t ? mc : t; t = dppu<0x4E>(mc); mc = mc > t ? mc : t; t = dppu<0x141>(mc); mc = mc > t ? mc : t; t = dppu<0x140>(mc); mc = mc > t ? mc : t;
#pragma unroll
                for (int u = 0; u < 4; ++u) ck[u] = ck[u] == mc ? 0u : ck[u];
                if (li == r) rc = mc;
            }
            const int cw = 63 - (int)(rc & 63u);
            const float best = cscr[rw * 64 + cw]; const int be = ((LAS int*)cscr)[256 + rw * 64 + cw];
            const float mx = __shfl(best, rowbase);
            const float ex = __expf(best - mx);
            const float den = sum16(ex);
            rec[tlr * 128 + h * 16 + li] = (cvtpk(0.f, ex / den) & 0xffff0000u) | ((unsigned)rw << 14) | (unsigned)be;
        }
    }
    __syncthreads();
    if (SELONLY) return;
    {
        LAS unsigned* rec2 = (LAS unsigned*)(lds + PEER_SRT);
#if PEER_TOKPF
        {
            float su[8], sv[8];
#pragma unroll
            for (int k2 = 0; k2 < 8; ++k2) { const unsigned e = rec[wave * 512 + lane + 64 * k2] & 0x3FFFu; su[k2] = tscale[16384 + e]; sv[k2] = tscale[e]; }
#pragma unroll
            for (int k2 = 0; k2 < 8; ++k2) rec2[wave * 512 + lane + 64 * k2] = cvtpk(su[k2], sv[k2]);
        }
        u32x4 hn[4];
#pragma unroll
        for (int c4 = 0; c4 < 4; ++c4) hn[c4] = *(const u32x4*)(hbuf + ((size_t)tok0 + wave * 4) * 2048 + lane * 32 + 8 * c4);
#endif
#pragma unroll 1
        for (int j = 0; j < 4; ++j) {
            const int tl = wave * 4 + j; const size_t row = (size_t)tok0 + tl;
            const LAS unsigned* rcw = rec + tl * 128; LAS unsigned* rc2 = rec2 + tl * 128;
            u32x4 hh[4];
#if PEER_TOKPF
#pragma unroll
            for (int c4 = 0; c4 < 4; ++c4) { hh[c4] = hn[c4]; asm volatile("" : "+v"(hh[c4])); }
            if (j < 3) {
#pragma unroll
                for (int c4 = 0; c4 < 4; ++c4) hn[c4] = *(const u32x4*)(hbuf + (row + 1) * 2048 + lane * 32 + 8 * c4);
            }
#else
#pragma unroll
            for (int k2 = 0; k2 < 2; ++k2) { const unsigned e = rcw[lane + 64 * k2] & 0x3FFFu; rc2[lane + 64 * k2] = cvtpk(tscale[16384 + e], tscale[e]); }
#pragma unroll
            for (int c4 = 0; c4 < 4; ++c4) hh[c4] = *(const u32x4*)(hbuf + row * 2048 + lane * 32 + 8 * c4);
#pragma unroll
            for (int c4 = 0; c4 < 4; ++c4) asm volatile("" : "+v"(hh[c4]));
#endif
            f32x2 acc[16];
#pragma unroll
            for (int i = 0; i < 16; ++i) acc[i] = (f32x2){0.f, 0.f};
#pragma unroll 1
            for (int g0 = 0; g0 < 128; g0 += PEER_P) {
                u32x4 ura[PEER_P], vra[PEER_P]; u32x2 urb[PEER_P], vrb[PEER_P];
#pragma unroll
                for (int p = 0; p < PEER_P; ++p) {
                    const unsigned e = (unsigned)__builtin_amdgcn_readfirstlane((int)rcw[g0 + p]) & ((DRY && PEER_DRYMASK) ? 0x3FFu : 0x3FFFu);
                    const unsigned char* up = utab + (size_t)e * 1536; const unsigned char* vp = vtab + (size_t)e * 1536;
#if PEER_NT
                    ura[p] = __builtin_nontemporal_load((const u32x4*)(up + lane * 16)); urb[p] = __builtin_nontemporal_load((const u32x2*)(up + 1024 + lane * 8));
                    vra[p] = __builtin_nontemporal_load((const u32x4*)(vp + lane * 16)); vrb[p] = __builtin_nontemporal_load((const u32x2*)(vp + 1024 + lane * 8));
#else
                    ura[p] = *(const u32x4*)(up + lane * 16); urb[p] = *(const u32x2*)(up + 1024 + lane * 8);
                    vra[p] = *(const u32x4*)(vp + lane * 16); vrb[p] = *(const u32x2*)(vp + 1024 + lane * 8);
#endif
                }
                float part[PEER_P];
#pragma unroll
                for (int p = 0; p < PEER_P; ++p) {
                    const v6u_t up6 = {ura[p].x, ura[p].y, ura[p].z, ura[p].w, urb[p].x, urb[p].y};
                    const v32bf_t ub = fp6_to_bf16x32(up6);
                    float d = 0.f;
#pragma unroll
                    for (int k = 0; k < 16; ++k) { const bf16x2_t uu = {ub[2 * k], ub[2 * k + 1]}; const unsigned hw = hh[k >> 2][k & 3];     d = __builtin_amdgcn_fdot2_f32_bf16(uu, __builtin_bit_cast(bf16x2_t, hw), d, false); }
                    part[p] = d;
                }
                float v4[4], v2[2], v1;
                { const bool up = (lane & 32) != 0;
#pragma unroll
                  for (int i = 0; i < 4; ++i) { const float keep = up ? part[i + 4] : part[i], snd = up ? part[i] : part[i + 4]; v4[i] = keep + __shfl_xor(snd, 32); } }
                { const bool up = (lane & 16) != 0;
#pragma unroll
                  for (int i = 0; i < 2; ++i) { const float keep = up ? v4[i + 2] : v4[i], snd = up ? v4[i] : v4[i + 2]; v2[i] = keep + __shfl_xor(snd, 16); } }
                { const bool up = (lane & 8) != 0; const float keep = up ? v2[1] : v2[0], snd = up ? v2[0] : v2[1]; v1 = keep + __shfl_xor(snd, 8); }
                v1 += __shfl_xor(v1, 4); v1 += __shfl_xor(v1, 2); v1 += __shfl_xor(v1, 1);
                const int ek = 4 * (lane >> 5) + 2 * ((lane >> 4) & 1) + ((lane >> 3) & 1);
                const unsigned rk = rcw[g0 + ek], sk = rc2[g0 + ek];
                const float cf = __uint_as_float(rk & 0xffff0000u) * gelu_tanh(v1 * __uint_as_float(sk & 0xffff0000u)) * __uint_as_float(sk << 16);
#pragma unroll
                for (int p = 0; p < PEER_P; ++p) {
                    const float ck = __int_as_float(__builtin_amdgcn_readlane(__float_as_int(cf), (((p >> 2) & 1) << 5) | (((p >> 1) & 1) << 4) | ((p & 1) << 3)));
                    const f32x2 ck2 = {ck, ck};
                    const v6u_t vp6 = {vra[p].x, vra[p].y, vra[p].z, vra[p].w, vrb[p].x, vrb[p].y};
                    const v32f_t vf = fp6_to_f32x32(vp6);
#pragma unroll
                    for (int i = 0; i < 16; ++i) acc[i] = __builtin_elementwise_fma((f32x2){vf[2 * i], vf[2 * i + 1]}, ck2, acc[i]);
                }
            }
            if (DRY) {
#pragma unroll
                for (int i = 0; i < 16; ++i) asm volatile("" :: "v"(acc[i]));
                continue;
            }
            bf16* xr = xbuf + row * 2048 + lane * 32; const float* gt = gate + (size_t)(row >> 13) * 6144 + lane * 32;
            float ss = 0.f;
#pragma unroll
            for (int c4 = 0; c4 < 4; ++c4) {
                const u32x4 xw = *(const u32x4*)(xr + 8 * c4); const f32x4 g0 = *(const f32x4*)(gt + 8 * c4), g1 = *(const f32x4*)(gt + 8 * c4 + 4);
                f32x4 xa, xb2;
                xa.x = bflo(xw.x) + g0.x * acc[4 * c4].x; xa.y = bfhi(xw.x) + g0.y * acc[4 * c4].y; xa.z = bflo(xw.y) + g0.z * acc[4 * c4 + 1].x; xa.w = bfhi(xw.y) + g0.w * acc[4 * c4 + 1].y;
                xb2.x = bflo(xw.z) + g1.x * acc[4 * c4 + 2].x; xb2.y = bfhi(xw.z) + g1.y * acc[4 * c4 + 2].y; xb2.z = bflo(xw.w) + g1.z * acc[4 * c4 + 3].x; xb2.w = bfhi(xw.w) + g1.w * acc[4 * c4 + 3].y;
                if (MODE == 0) {
                    const u32x4 pw = pack8(xa, xb2); *(u32x4*)(xr + 8 * c4) = pw;
                    xa = (f32x4){bflo(pw.x), bfhi(pw.x), bflo(pw.y), bfhi(pw.y)}; xb2 = (f32x4){bflo(pw.z), bfhi(pw.z), bflo(pw.w), bfhi(pw.w)};
                }
                acc[4 * c4] = (f32x2){xa.x, xa.y}; acc[4 * c4 + 1] = (f32x2){xa.z, xa.w}; acc[4 * c4 + 2] = (f32x2){xb2.x, xb2.y}; acc[4 * c4 + 3] = (f32x2){xb2.z, xb2.w};
                ss += (xa.x * xa.x + xa.y * xa.y) + (xa.z * xa.z + xa.w * xa.w) + (xb2.x * xb2.x + xb2.y * xb2.y) + (xb2.z * xb2.z + xb2.w * xb2.w);
            }
            const float rn = 1.0f / sqrtf(wave_sum(ss) * (1.f / DM) + NORM_EPS);
            if (MODE == 0) {
                const float* md = mod_next + (size_t)(row >> 13) * 6144 + lane * 32; const float* gn = g_next + lane * 32;
                unsigned ow[16];
#pragma unroll
                for (int q4 = 0; q4 < 8; ++q4) { const f32x4 gg = *(const f32x4*)(gn + 4 * q4), sc4 = *(const f32x4*)(md + 2048 + 4 * q4), sh4 = *(const f32x4*)(md + 4 * q4);
                    ow[2 * q4] = cvtpk(acc[2 * q4].x * rn * gg.x * (1.f + sc4.x) + sh4.x, acc[2 * q4].y * rn * gg.y * (1.f + sc4.y) + sh4.y);
                    ow[2 * q4 + 1] = cvtpk(acc[2 * q4 + 1].x * rn * gg.z * (1.f + sc4.z) + sh4.z, acc[2 * q4 + 1].y * rn * gg.w * (1.f + sc4.w) + sh4.w); }
                bf16* hw = hbuf + row * 2048 + lane * 32;
#pragma unroll
                for (int q4 = 0; q4 < 4; ++q4) *(u32x4*)(hw + 8 * q4) = (u32x4){ow[4 * q4], ow[4 * q4 + 1], ow[4 * q4 + 2], ow[4 * q4 + 3]};
            } else {
                const float* gn = g_next + lane * 32;
#pragma unroll
                for (int q4 = 0; q4 < 8; ++q4) { const f32x4 gg = *(const f32x4*)(gn + 4 * q4); f32x4 o;
                    o.x = acc[2 * q4].x * rn * gg.x; o.y = acc[2 * q4].y * rn * gg.y; o.z = acc[2 * q4 + 1].x * rn * gg.z; o.w = acc[2 * q4 + 1].y * rn * gg.w;
                    *(f32x4*)(fout + row * 2048 + lane * 32 + 4 * q4) = o; }
            }
        }
    }
    __syncthreads();
#undef PWS
#undef q
#undef subk
#undef utab
#undef vtab
#undef tscale
#undef hbuf
#undef xbuf
#undef fout
#undef gate
#undef g_next
#undef mod_next
}
namespace flow {
constexpr size_t WS_FLOW = WS_CTL + 40960;
constexpr int SLOT_LDS = LDS_BYTES - 16;
#define FLOW_RLX __ATOMIC_RELAXED, __HIP_MEMORY_SCOPE_AGENT
#ifndef FLOW_BFS
#define FLOW_BFS 0
#endif
#ifndef FLOW_PCAP
#define FLOW_PCAP 24
#endif
struct R1 {
    static constexpr int NST = 5, BASE = 0, PST = 3;
    static __device__ __forceinline__ int cnt(int st) { return st == 1 ? 4 : st == 4 ? 15 : 8; }
    static __device__ __forceinline__ int dep(int st) { return st - 1; }
    static __device__ __forceinline__ int depn(int st) { return st == 2 ? 4 : 8; }
    static __device__ __forceinline__ int prio(int p) { return p == 4 ? 4 : 3 - p; }
};
struct R2 {
    static constexpr int NST = 4, BASE = 1024, PST = 3;
    static __device__ __forceinline__ int cnt(int st) { return st == 1 ? 4 : 8; }
    static __device__ __forceinline__ int dep(int st) { return st - 1; }
    static __device__ __forceinline__ int depn(int st) { return st == 2 ? 4 : 8; }
    static __device__ __forceinline__ int prio(int p) { return FLOW_BFS ? p : 3 - p; }
};
struct Q { unsigned* base; int home; unsigned par; };
__device__ __forceinline__ unsigned* arrive_ctr(const Q& q, int st, int rt) { return q.base + (rt & 7) * 64 + 16 + st * 8 + (rt >> 3); }
__device__ __forceinline__ unsigned* pact_ctr(const Q& q, int xq) { return q.base + xq * 64 + 8; }
template <class R>
__device__ __forceinline__ int scan_xcd(const Q& q, int xq, int only) {
    const int lane = threadIdx.x & 63; const bool l0 = (lane == 0);
    unsigned* blk = q.base + xq * 64;
    const int v = (int)__hip_atomic_load(blk + lane, FLOW_RLX);
    bool all_ex = true;
    for (int p = 0; p < R::NST; ++p) {
        const int st = only >= 0 ? only : R::prio(p), c = R::cnt(st);
        const int h = __builtin_amdgcn_readlane(v, st);
        if (h < 8 * c) {
            all_ex = false;
            const int kk = h / c, ix = h - kk * c;
            const bool dep_ok = R::dep(st) < 0 || __builtin_amdgcn_readlane(v, 16 + R::dep(st) * 8 + kk) >= R::depn(st);
            const bool cap_ok = st != R::PST || __builtin_amdgcn_readlane(v, 8) < FLOW_PCAP;
            if (dep_ok && cap_ok) {
                unsigned ok = 0u; if (l0) { unsigned ex = (unsigned)h; ok = __hip_atomic_compare_exchange_strong(blk + st, &ex, (unsigned)h + 1u, __ATOMIC_RELAXED, __ATOMIC_RELAXED, __HIP_MEMORY_SCOPE_AGENT) ? 1u : 0u; }
                if (!__builtin_amdgcn_readfirstlane((int)ok)) return -3;
                if (st == R::PST && l0) (void)__hip_atomic_fetch_add(blk + 8, 1u, FLOW_RLX);
                return (xq << 24) | (st << 16) | ((kk * 8 + xq) << 8) | ix;
            }
        }
        if (only >= 0) break;
    }
    return all_ex ? -2 : -1;
}
template <class R, bool IN_GEMM>
__device__ __forceinline__ int pop(LAS unsigned char* lds, Q& q, int only) {
    if (!IN_GEMM) __syncthreads();
    LAS volatile int* slot = (LAS volatile int*)(lds + SLOT_LDS) + (q.par & 1u);
    if (__builtin_amdgcn_readfirstlane((int)(threadIdx.x >> 6)) == 0) {
        int r = -1;
        if (IN_GEMM) { do { r = scan_xcd<R>(q, q.home, only); } while (r == -3); if (r < 0) r = -1; }
        else for (;;) {
            bool all_ex = true;
            for (int xi = 0; xi < 8; ++xi) { const int xq = (q.home + xi) & 7; int c;
                do { c = scan_xcd<R>(q, xq, -1); } while (c == -3);
                if (c >= 0) { r = c; break; } if (c == -1) all_ex = false; }
            if (r >= 0 || all_ex) break;
            r = -1; __builtin_amdgcn_s_sleep(64);
        }
        if (threadIdx.x == 0) *slot = r;
        asm volatile("s_waitcnt lgkmcnt(0)" ::: "memory");
    }
    __builtin_amdgcn_s_barrier();
    const int r = __builtin_amdgcn_readfirstlane(*slot);
    ++q.par;
    return r;
}
__device__ __forceinline__ void acquire() { __builtin_amdgcn_fence(__ATOMIC_ACQUIRE, "agent"); }
template <bool RAW_BAR>
__device__ __forceinline__ void publish(unsigned* c, unsigned* dec) {
    asm volatile("s_waitcnt vmcnt(0)" ::: "memory");
    if (RAW_BAR) __builtin_amdgcn_s_barrier(); else __syncthreads();
    if (threadIdx.x == 0) { __builtin_amdgcn_fence(__ATOMIC_RELEASE, "agent"); asm volatile("s_waitcnt vmcnt(0)" ::: "memory"); (void)__hip_atomic_fetch_add(c, 1u, FLOW_RLX);
        if (dec) (void)__hip_atomic_fetch_sub(dec, 1u, FLOW_RLX); }
}
template <class R, int ST>
struct GOrder {
    LAS unsigned char* lds; Q* q; int first;
    __device__ __forceinline__ bool next(int i, pg8::Unit& u) {
        const int t = (i == 0) ? first : pop<R, true>(lds, *q, ST);
        if (t >= 0) { u.pm = (t >> 8) & 255; u.pn = t & 255; return true; }
        return false;
    }
    __device__ __forceinline__ void a_ready(const pg8::Unit&) const { if (R::dep(ST) >= 0) acquire(); }
    __device__ __forceinline__ void done(const pg8::Unit& u) const { publish<true>(arrive_ctr(*q, ST, u.pm), nullptr); }
};
}
#ifndef CONV_COAL
#define CONV_COAL 0
#endif
#ifndef P9_SKIP5
#define P9_SKIP5 0
#endif
#ifndef PRO_SKIP
#define PRO_SKIP 0
#endif
#ifndef DEFER_PRO
#define DEFER_PRO 0
#endif


constexpr int N_PHASES = 17;
#ifndef STOP_AFTER
#define STOP_AFTER 15
#endif
#ifndef N_LAUNCH_MODE
#define N_LAUNCH_MODE 1
#endif

__device__ __forceinline__ void cvt_rows_bf16(const float* src, bf16* dst, size_t nvec8, size_t gtid, size_t nthr) {
    for (size_t i = gtid; i < nvec8; i += nthr) {
        const f32x4 a = *(const f32x4*)(src + i * 8), b = *(const f32x4*)(src + i * 8 + 4);
        u32x4 w; w.x = cvtpk(a.x, a.y); w.y = cvtpk(a.z, a.w); w.z = cvtpk(b.x, b.y); w.w = cvtpk(b.z, b.w);
        *(u32x4*)(dst + i * 8) = w;
    }
}
typedef float v16f_t __attribute__((ext_vector_type(16)));

#ifndef FP6_INTERLEAVED
#define FP6_INTERLEAVED 1
#endif
__device__ __forceinline__ void row_to_fp6_pre(const float* src, f32x4 (&v)[8], int lane) {
#pragma unroll
    for (int q = 0; q < 8; ++q) v[q] = NT_ONCE ? __builtin_nontemporal_load((const f32x4*)(src + lane * 32 + 4 * q)) : *(const f32x4*)(src + lane * 32 + 4 * q);
}
__device__ __forceinline__ void row_load_coal(const float* src, f32x4 (&raw)[8], int lane) {
#pragma unroll
    for (int q = 0; q < 8; ++q) raw[q] = *(const f32x4*)(src + q * 256 + lane * 4);
}
__device__ __forceinline__ void row_xpose(const f32x4 (&raw)[8], f32x4 (&v)[8], LAS float* scr, int lane) {
#pragma unroll
    for (int q = 0; q < 8; ++q) *(LAS f32x4*)(scr + q * 288 + lane * 4 + 4 * (lane >> 3)) = raw[q];
    asm volatile("s_waitcnt lgkmcnt(0)" ::: "memory");
#pragma unroll
    for (int q = 0; q < 8; ++q) v[q] = *(const LAS f32x4*)(scr + lane * 36 + 4 * q);
    asm volatile("s_waitcnt lgkmcnt(0)" ::: "memory");
}
__device__ __forceinline__ void row_to_fp6(const float* src, unsigned char* dst, float* scale, int lane, const f32x4 (*pre)[8] = nullptr) {
    f32x4 v[8]; float am = 0.f;
#pragma unroll
    for (int q = 0; q < 8; ++q) { v[q] = pre ? (*pre)[q] : (NT_ONCE ? __builtin_nontemporal_load((const f32x4*)(src + lane * 32 + 4 * q)) : *(const f32x4*)(src + lane * 32 + 4 * q)); const f32x4 a = __builtin_elementwise_abs(v[q]); am = fmaxf(am, fmaxf(fmaxf(a.x, a.y), fmaxf(a.z, a.w))); }
#pragma unroll
    for (int o = 1; o < 64; o <<= 1) am = fmaxf(am, __shfl_xor(am, o));
    const float sc = am > 0.f ? am * (1.f / 7.5f) : 1.f, inv = 1.f / sc;
    if (lane == 0) *scale = sc;
    v16f_t x, y;
#pragma unroll
    for (int i = 0; i < 16; ++i) {
        const int ex = FP6_INTERLEAVED ? 2 * i : i, ey = FP6_INTERLEAVED ? 2 * i + 1 : 16 + i;
        x[i] = v[ex >> 2][ex & 3] * inv; y[i] = v[ey >> 2][ey & 3] * inv;
    }
    const v6u_t p = __builtin_amdgcn_cvt_scalef32_2xpk16_fp6_f32(x, y, 1.0f);
    *(u32x4*)(dst + lane * 16) = (u32x4){p[0], p[1], p[2], p[3]}; *(u32x2*)(dst + 1024 + lane * 8) = (u32x2){p[4], p[5]};
}
__device__ __forceinline__ void ada_item(KArgs Ap, LAS unsigned char* lds, int it) {
    LAS float* sv = (LAS float*)lds; LAS float* red = (LAS float*)(lds + 32768); float* mod = (float*)((*Ap).ws + WS_MOD);
    const int li = it / 48, cgp = it % 48;
    for (int k = threadIdx.x; k < 4096; k += NTHREADS) sv[k] = siluf_((*Ap).in[1][k]);
    __syncthreads();
    gemv_item(sv, 2048, (*Ap).in[2] + (size_t)li * 2048 * 6144, 6144, cgp * 128, red, mod + (size_t)(li * 2) * 6144, mod + (size_t)(li * 2 + 1) * 6144, (*Ap).in[3] + (size_t)li * 6144);
}
__device__ __forceinline__ void phase_prologue(KArgs Ap, LAS unsigned char* lds, int vcu, int G, int skip = 0) {
    const int tid = threadIdx.x, lane = tid & 63, wave = __builtin_amdgcn_readfirstlane(tid >> 6), bx = blockIdx.x;
    unsigned char* ws = Ap->ws;
#define A (*Ap)
    {
        LAS float* sv = (LAS float*)lds; LAS float* red = (LAS float*)(lds + 32768);
        float* mod = (float*)(ws + WS_MOD); float* bias1 = (float*)(ws + WS_BIAS1);
        if (!(skip & 1)) for (int it = bx; it < 196; it += G) {
            __syncthreads();
            if (it < 192) {
                if (DEFER_PRO && G == 256 && it >= 48) continue;
                ada_item(Ap, lds, it);
            } else {
                const int kv = (it - 192) >> 1, cgp = (it - 192) & 1;
                for (int k = tid; k < 4096; k += NTHREADS) { const float p = A.in[12][(size_t)kv * 4096 + k]; sv[k] = p; sv[4096 + k] = p; }
                __syncthreads();
                gemv_item(sv, 4096, A.in[13] + (size_t)kv * 4096 * 256, 256, cgp * 128, red, bias1 + kv * 256, bias1 + 512, nullptr);
            }
        }
        __syncthreads();
    }
    {
        LAS float* scr = (LAS float*)(lds + wave * 16384);
        const int gw = vcu * NWAVES + wave, NGW = G * NWAVES;
        constexpr int I0 = 4608, I1 = I0 + 2048, I2 = I1 + 3648, I3 = I2 + 2048, I4 = I3 + 2048, I5 = I4 + 2048, I6 = I5 + 512, I7 = I6 + 512, I8 = I7 + 16, I9 = I8 + 16;
        if (!(skip & 2)) for (int it = gw; it < I9; it += NGW) {
            if (it < I0) transpose_item(A.in[5], 2048, 4608, (bf16*)(ws + WS_WIN0), 1, scr, it, lane);
            else if (it < I1) transpose_item(A.in[6], 2048, 2048, (bf16*)(ws + WS_WOUT0), 0, scr, it - I0, lane);
            else if (it < I2) transpose_item(A.in[10], 2048, 3632, (bf16*)(ws + WS_WIN1), 2, scr, it - I1, lane);
            else if (it < I3) { if (!(DEFER_PRO && G == 256)) transpose_item(A.in[11], 2048, 2048, (bf16*)(ws + WS_WOUT1), 0, scr, it - I2, lane); }
            else if (it < I4) transpose_item(A.in[15], 2048, 2048, (bf16*)(ws + WS_WQ0), 0, scr, it - I3, lane);
            else if (it < I5) { if (!(DEFER_PRO && G == 256)) transpose_item(A.in[15] + (size_t)2048 * 2048, 2048, 2048, (bf16*)(ws + WS_WQ1), 0, scr, it - I4, lane); }
            else if (it < I6) transpose_item(A.in[13], 4096, 256, (bf16*)(ws + WS_W1T), 0, scr, it - I5, lane);
            else if (it < I7) transpose_item(A.in[13] + (size_t)4096 * 256, 4096, 256, (bf16*)(ws + WS_W1T) + (size_t)256 * 4096, 0, scr, it - I6, lane);
            else if (it < I8) transpose_item(A.in[14], 256, 128, (bf16*)(ws + WS_W2T), 3, scr, it - I7, lane);
            else transpose_item(A.in[14] + (size_t)256 * 128, 256, 128, (bf16*)(ws + WS_W2T) + (size_t)256 * 256, 0, scr, it - I8, lane);
        }
    }
    if (CONV_COAL) __syncthreads();
    {
        const size_t gtid = (size_t)vcu * NTHREADS + tid, nthr = (size_t)G * NTHREADS;
        {
            const int gw2 = vcu * NWAVES + wave, NGW2 = G * NWAVES;
            if (!(skip & 4)) for (int r = gw2; r < 2 * 16384; r += 2 * NGW2) {
                const int r2 = r + NGW2;
                const int tb = r >> 14, e = r & 16383; const float* src = (tb & 1 ? A.in[18] : A.in[17]) + ((size_t)(tb >> 1) * 16384 + e) * 2048;
                const int tb2 = r2 >> 14, e2 = r2 & 16383; const float* src2 = (tb2 & 1 ? A.in[18] : A.in[17]) + ((size_t)(tb2 >> 1) * 16384 + e2) * 2048;
                f32x4 pa[8], pb[8];
#if CONV_COAL
                { f32x4 ra[8], rb[8]; row_load_coal(src, ra, lane); row_load_coal(src2, rb, lane); LAS float* xs = (LAS float*)lds + wave * 4608; row_xpose(ra, pa, xs, lane); row_xpose(rb, pb, xs + 2304, lane); }
#else
                row_to_fp6_pre(src, pa, lane); row_to_fp6_pre(src2, pb, lane);
#endif
                row_to_fp6(src, ws + WS_TAB + (size_t)tb * 24 * MiB + (size_t)e * 1536, (float*)(ws + WS_TSCALE) + r, lane, &pa);
                row_to_fp6(src2, ws + WS_TAB + (size_t)tb2 * 24 * MiB + (size_t)e2 * 1536, (float*)(ws + WS_TSCALE) + r2, lane, &pb);
            }
        }
        cvt_rows_bf16(A.in[16], (bf16*)(ws + WS_SUBK), (size_t)2 * 8 * 2 * 128 * 128 / 8, gtid, nthr);
        f32x2* t64 = (f32x2*)(ws + WS_TAB64); f32x2* t128 = (f32x2*)(ws + WS_TAB128);
        if (!(skip & 8)) for (size_t i = gtid; i < (size_t)SEQ * 96; i += nthr) {
            const int pos = (int)(i / 96), r = (int)(i % 96);
            const bool is64 = r < 32; const int fi = is64 ? r : r - 32; const float dim = is64 ? 64.f : 128.f;
            const float inv = exp2f(-(2.f * (float)fi / dim) * 13.287712379549449f);
            const float ang = (float)pos * inv; float sn, cs; sincosf(ang, &sn, &cs);
            if (is64) t64[(size_t)pos * 32 + fi] = (f32x2){cs, sn}; else t128[(size_t)pos * 64 + fi] = (f32x2){cs, sn};
        }
        u32x4 z = {0u, 0u, 0u, 0u};
        for (size_t i = gtid; i < (size_t)208 * 2048 / 8; i += nthr) *(u32x4*)((bf16*)(ws + WS_WIN1) + (size_t)3632 * 2048 + i * 8) = z;
        for (size_t i = gtid; i < (size_t)2 * 128 * 256 / 8; i += nthr) { const size_t half = i / (128 * 256 / 8), r = i % (128 * 256 / 8); *(u32x4*)((bf16*)(ws + WS_W2T) + (half * 256 + 128) * 256 + r * 8) = z; }
    }
}
#undef A
template <bool XF32, bool ADDY = false>
__device__ __forceinline__ void adaln_rows(const void* X, const float* g, const float* mod, bf16* H, int vcu, int G, const bf16* Y = nullptr, bf16* XB = nullptr) {
    int tid_ = threadIdx.x; asm volatile("" : "+v"(tid_));
    const int lane = tid_ & 63, wave = __builtin_amdgcn_readfirstlane(tid_ >> 6);
    const int stride = G * NWAVES;
#pragma unroll 1
    for (int b = 0; b < T / SEQ; ++b) {
        f32x4 cs[8], sh[8];
#pragma unroll
        for (int j = 0; j < 8; ++j) { const int idx = lane * 8 + 512 * (j >> 1) + 4 * (j & 1);
            const f32x4 gg = *(const f32x4*)(g + idx), sc = *(const f32x4*)(mod + (size_t)b * 6144 + 2048 + idx);
            cs[j] = gg * (1.f + sc); sh[j] = *(const f32x4*)(mod + (size_t)b * 6144 + idx); }
        int row = b * SEQ + vcu * NWAVES + wave;
        if (row >= (b + 1) * SEQ) continue;
        f32x4 v[8];
        auto ld = [&](int r, f32x4 (&d)[8]) {
            if (XF32) { const float* xr = (const float*)X + (size_t)r * 2048;
#pragma unroll
                for (int j = 0; j < 8; ++j) d[j] = *(const f32x4*)(xr + lane * 8 + 512 * (j >> 1) + 4 * (j & 1)); }
            else { const bf16* xr = (const bf16*)X + (size_t)r * 2048;
#pragma unroll
                for (int j = 0; j < 4; ++j) { const u32x4 w = *(const u32x4*)(xr + lane * 8 + 512 * j);
                    d[2 * j] = (f32x4){bflo(w.x), bfhi(w.x), bflo(w.y), bfhi(w.y)}; d[2 * j + 1] = (f32x4){bflo(w.z), bfhi(w.z), bflo(w.w), bfhi(w.w)}; } }
            if (ADDY) {
                const bf16* yr = Y + (size_t)r * 2048; bf16* xo = XB + (size_t)r * 2048;
#pragma unroll
                for (int j = 0; j < 4; ++j) { const u32x4 w = *(const u32x4*)(yr + lane * 8 + 512 * j);
                    const f32x4 s0 = d[2 * j] + (f32x4){bflo(w.x), bfhi(w.x), bflo(w.y), bfhi(w.y)}, s1 = d[2 * j + 1] + (f32x4){bflo(w.z), bfhi(w.z), bflo(w.w), bfhi(w.w)};
                    const u32x4 pw = pack8(s0, s1); *(u32x4*)(xo + lane * 8 + 512 * j) = pw;
                    d[2 * j] = (f32x4){bflo(pw.x), bfhi(pw.x), bflo(pw.y), bfhi(pw.y)}; d[2 * j + 1] = (f32x4){bflo(pw.z), bfhi(pw.z), bflo(pw.w), bfhi(pw.w)}; }
            }
        };
        ld(row, v);
#pragma unroll 1
        for (; row < (b + 1) * SEQ; row += stride) {
            f32x4 nx[8]; const int rn = row + stride; const bool more = rn < (b + 1) * SEQ;
            if (!ADDY || more) ld(more ? rn : row, nx);
            float ss = 0.f;
#pragma unroll
            for (int j = 0; j < 8; ++j) ss += v[j].x * v[j].x + v[j].y * v[j].y + v[j].z * v[j].z + v[j].w * v[j].w;
            const float r = 1.0f / sqrtf(wave_sum(ss) * (1.f / DM) + NORM_EPS);
            bf16* hrow = H + (size_t)row * 2048;
#pragma unroll
            for (int j = 0; j < 4; ++j) {
                const f32x4 o0 = v[2 * j] * r * cs[2 * j] + sh[2 * j], o1 = v[2 * j + 1] * r * cs[2 * j + 1] + sh[2 * j + 1];
                u32x4 w; w.x = cvtpk(o0.x, o0.y); w.y = cvtpk(o0.z, o0.w); w.z = cvtpk(o1.x, o1.y); w.w = cvtpk(o1.z, o1.w);
                *(u32x4*)(hrow + lane * 8 + 512 * j) = w;
            }
#pragma unroll
            for (int j = 0; j < 8; ++j) v[j] = nx[j];
        }
    }
}
__device__ __forceinline__ void phase_adaln_bf(KArgs Ap, int li, int vcu, int G) {
    adaln_rows<false>((*Ap).ws + WS_XB, (*Ap).in[4] + (size_t)li * 2048, (const float*)((*Ap).ws + WS_MOD) + (size_t)li * 2 * 6144, (bf16*)((*Ap).ws + WS_H), vcu, G);
}
template <bool XF32>
__device__ __forceinline__ void phase_adaln_add(KArgs Ap, const void* xold, int li, int vcu, int G) {
    adaln_rows<XF32, true>(xold, (*Ap).in[4] + (size_t)li * 2048, (const float*)((*Ap).ws + WS_MOD) + (size_t)li * 2 * 6144, (bf16*)((*Ap).ws + WS_H), vcu, G, (const bf16*)((*Ap).ws + WS_Y), (bf16*)((*Ap).ws + WS_XB));
}
__device__ __forceinline__ void phase_adaln(KArgs Ap, const float* xsrc, int li, int vcu, int G) {
    adaln_rows<true>(xsrc, (*Ap).in[4] + (size_t)li * 2048, (const float*)((*Ap).ws + WS_MOD) + (size_t)li * 2 * 6144, (bf16*)((*Ap).ws + WS_H), vcu, G);
}
__device__ __forceinline__ void phase_final(KArgs Ap, const float* xsrc, int vcu, int G) {
    const int lane = threadIdx.x & 63, wave = __builtin_amdgcn_readfirstlane(threadIdx.x >> 6);
    for (int row = vcu * NWAVES + wave; row < T; row += G * NWAVES) final_row(xsrc + (size_t)row * 2048, (*Ap).in[19], (*Ap).out + (size_t)row * 2048, lane);
}

#undef A
__global__ void __launch_bounds__(NTHREADS, 2) fwd_kernel(Args Aunused) {
    extern __shared__ __attribute__((aligned(16))) unsigned char lds_raw[];
    LAS unsigned char* lds = (LAS unsigned char*)lds_raw;
    const int G = gridDim.x, bx = blockIdx.x;
    const int vcu = (G % 8 == 0) ? (bx % 8) * (G / 8) + bx / 8 : bx;
    cg::grid_group grid = cg::this_grid();
    const XcdBarrier xbar = xcd_barrier_post((unsigned*)(kargs()->ws + WS_CTL), (volatile unsigned*)(kargs()->ws + WS_CTL + 16384) + 16 * bx);
#define A (*kargs())
#define ws (kargs()->ws)
#define mod ((const float*)(ws + WS_MOD))
#define tab64 ((const f32x2*)(ws + WS_TAB64))
#define tab128 ((const f32x2*)(ws + WS_TAB128))
#define H ((bf16*)(ws + WS_H))
#define ATT ((bf16*)(ws + WS_ATT))
#define xbuf (kargs()->out)
#ifndef PHASE_MASK
#define PHASE_MASK 0x1FFFF
#endif
#define PH(k) ((((PHASE_MASK) >> (k)) & 1) && A.ph_lo <= (k) && (k) < A.ph_hi)
#define SEAM(k) do { if (PH(k) && PH((k) + 1)) { if ((k) == 0) grid.sync(); else xcd_barrier(xbar); } } while (0)
#ifndef PEER_SELONLY
#define PEER_SELONLY 0
#endif
#ifndef FLOW1
#define FLOW1 0
#endif
#ifndef P9_ALT
#define P9_ALT 1
#endif
#ifndef RESID_IN_NORM
#define RESID_IN_NORM 0
#endif
#ifndef FLOW2
#define FLOW2 0
#endif
#ifndef PEER_HALF_PROBE
#define PEER_HALF_PROBE 0
#endif
#ifndef REPEAT_PHASE
#define REPEAT_PHASE -1
#endif
#define REP(k) for (int rep_ = 0; rep_ < ((REPEAT_PHASE) == (k) ? 2 : 1); ++rep_, (((REPEAT_PHASE) == (k) && rep_ == 1) ? xcd_barrier(xbar) : (void)0))
    if (PH(0)) REP(0) { phase_prologue(kargs(), lds, vcu, G, rep_ ? (PRO_SKIP) : 0); }
    SEAM(0);
    if (PH(1)) REP(1) { phase_adaln(kargs(), A.in[0], 0, vcu, G); }
    SEAM(1);
    if (PH(2)) REP(2) { pg8::Gemm g{H, (const bf16*)(ws + WS_WIN0), T, 4608, 2048, 2048}; pg8::StaticOrder S; S.init(T, 4608, G, bx);
        EpiQKV0 E{(bf16*)(ws + WS_QKV), tab64}; pg8::gemm_phase<EpiQKV0, pg8::StaticOrder, true, true>(lds, g, S, E); }
    if (DEFER_PRO && PH(2) && bx >= 128 && G == 256) {
        for (int it = 48 + (bx - 128); it < 192; it += 128) { __syncthreads(); ada_item(kargs(), lds, it); }
        __syncthreads();
    }
    SEAM(2);
    if (PH(3)) REP(3) {
        const bf16* qkv = (const bf16*)(ws + WS_QKV);
        float lam;
        { const float* lv = A.in[7]; const int lane = threadIdx.x & 63; const float d1 = wave_sum(lv[lane] * lv[64 + lane]), d2 = wave_sum(lv[128 + lane] * lv[192 + lane]); lam = __expf(d1) - __expf(d2) + 0.2f; }
#ifndef SKIP_DA
#define SKIP_DA 0
#endif
        if (SKIP_DA) { for (size_t i = (size_t)vcu * NTHREADS + threadIdx.x; i < (size_t)T * 128; i += (size_t)G * NTHREADS) { const size_t r = i >> 7, cc = i & 127; *(u32x4*)(ATT + r * 2048 + cc * 8) = (u32x4){0u, 0u, 0u, 0u}; } }
        else for (int n = vcu; n < 256; n += G)
            for (int i = 0; i < 2; ++i) { const int bh = n >> 4, s = n & 15, qb = i == 0 ? s : 31 - s; __syncthreads(); da_unit(lds, qkv, ATT, bh >> 3, bh & 7, qb, lam, A.in[8], (float*)(ws + WS_SLOT)); }
#ifndef NAIVE_SWA
#define NAIVE_SWA 0
#endif
#ifndef SKIP_SWA
#define SKIP_SWA 0
#endif
        if (SKIP_SWA) { for (size_t i = (size_t)vcu * NTHREADS + threadIdx.x; i < (size_t)T * 128; i += (size_t)G * NTHREADS) { const size_t r = i >> 7, cc = i & 127; *(u32x4*)(ATT + r * 2048 + 1024 + cc * 8) = (u32x4){0u, 0u, 0u, 0u}; } }
        else if (NAIVE_SWA) { const int wv = __builtin_amdgcn_readfirstlane(threadIdx.x >> 6);
            for (int it = vcu * NWAVES + wv; it < T * 16; it += G * NWAVES) swa_naive(qkv, ATT, (it >> 4) >> 13, (it >> 4) & (SEQ - 1), it & 15, A.in[9], threadIdx.x & 63); }
        else
        for (int n = vcu; n < 1024; n += G) { __syncthreads(); swa_unit(lds, qkv, ATT, n >> 9, (n >> 7) & 3, n & 127, A.in[9]); }
    }
    SEAM(3);
#if FLOW1
    if (PH(4)) {
        using R = flow::R1;
        flow::Q fq{(unsigned*)(ws + flow::WS_FLOW) + R::BASE, (int)(xbar.x & 7u), 0u};
        for (int t = flow::pop<R, false>(lds, fq, -1); t >= 0; t = flow::pop<R, false>(lds, fq, -1)) {
            const int xq = (t >> 24) & 7, st = (t >> 16) & 255, rt = (t >> 8) & 255, ix = t & 255;
            if (st == 0) { pg8::Gemm g{ATT, (const bf16*)(ws + WS_WOUT0), T, 2048, 2048, 2048}; EpiResid<true> E{A.in[0], (bf16*)(ws + WS_XB), mod + 4096};
                flow::GOrder<R, 0> S{lds, &fq, t}; pg8::gemm_phase<EpiResid<true>, flow::GOrder<R, 0>, true, true>(lds, g, S, E); }
            else if (st == 2) { pg8::Gemm g{H, (const bf16*)(ws + WS_WQ0), T, 2048, 2048, 2048}; EpiPlain E{(bf16*)(ws + WS_Q1), 2048};
                flow::GOrder<R, 2> S{lds, &fq, t}; pg8::gemm_phase<EpiPlain, flow::GOrder<R, 2>, true, true>(lds, g, S, E); }
            else if (st == 4) { pg8::Gemm g{H, (const bf16*)(ws + WS_WIN1), T, 3840, 2048, 2048}; EpiQKV1 E{ws, tab128};
                flow::GOrder<R, 4> S{lds, &fq, t}; pg8::gemm_phase<EpiQKV1, flow::GOrder<R, 4>, true, true>(lds, g, S, E); }
            else if (st == 1) {
                flow::acquire();
                int tid_ = threadIdx.x; asm volatile("" : "+v"(tid_));
                const int lane = tid_ & 63, wave = __builtin_amdgcn_readfirstlane(tid_ >> 6);
                const float* md = mod + (size_t)1 * 2 * 6144; const float* gg = A.in[4] + (size_t)1 * 2048;
                for (int i = 0; i < 8; ++i) { const int row = rt * 256 + ix * 64 + wave * 8 + i; adaln_row_bf((const bf16*)(ws + WS_XB) + (size_t)row * 2048, gg, md + (size_t)(row >> 13) * 6144, H + (size_t)row * 2048, lane); }
                flow::publish<false>(flow::arrive_ctr(fq, 1, rt), nullptr);
            } else {
                flow::acquire();
                peer_tile<0>(lds, rt * 8 + ix, 0, xbar);
                flow::publish<false>(flow::arrive_ctr(fq, 3, rt), flow::pact_ctr(fq, xq));
            }
        }
    }
#else
#if RESID_IN_NORM
    if (PH(4)) REP(4) { pg8::Gemm g{ATT, (const bf16*)(ws + WS_WOUT0), T, 2048, 2048, 2048}; pg8::StaticOrder S; S.init(T, 2048, G, bx);
        EpiGate E{(bf16*)(ws + WS_Y), mod + 4096}; pg8::gemm_phase<EpiGate, pg8::StaticOrder, true, true>(lds, g, S, E); }
    SEAM(4);
    if (PH(5)) { phase_adaln_add<true>(kargs(), A.in[0], 1, vcu, G); }
#else
    if (PH(4)) REP(4) { pg8::Gemm g{ATT, (const bf16*)(ws + WS_WOUT0), T, 2048, 2048, 2048}; pg8::StaticOrder S; S.init(T, 2048, G, bx);
        EpiResid<true> E{A.in[0], (bf16*)(ws + WS_XB), mod + 4096}; pg8::gemm_phase<EpiResid<true>, pg8::StaticOrder, true, true>(lds, g, S, E); }
    SEAM(4);
    if (PH(5)) REP(5) { phase_adaln_bf(kargs(), 1, vcu, G); }
#endif
    SEAM(5);
    if (PH(6)) REP(6) { pg8::Gemm g{H, (const bf16*)(ws + WS_WQ0), T, 2048, 2048, 2048}; pg8::StaticOrder S; S.init(T, 2048, G, bx);
        EpiPlain E{(bf16*)(ws + WS_Q1), 2048}; pg8::gemm_phase<EpiPlain, pg8::StaticOrder, true, true>(lds, g, S, E); }
    SEAM(6);
    if (PH(7)) REP(7) {
        if (REPEAT_PHASE == 7 && rep_ == 0 && PEER_HALF_PROBE >= 2) {
            if (((bx >> 3) & 1) == 0) { if (PEER_HALF_PROBE == 2) for (int tile = vcu; tile < 512; tile += G) peer_tile<0, true, false>(lds, tile, 0, xbar); }
            else { const int c = (bx >> 4) * 8 + (bx & 7);
                for (int r2 = 0; r2 < 2; ++r2) { pg8::Gemm g{H, (const bf16*)(ws + WS_WQ0), T, 2048, 2048, 2048}; pg8::StaticOrder S; S.init(T, 2048, 128, c);
                    EpiPlain E{ATT, 2048}; pg8::gemm_phase<EpiPlain, pg8::StaticOrder, true, true>(lds, g, S, E); } }
        } else
        for (int tile = vcu; tile < 512; tile += G)
            if (REPEAT_PHASE == 7 && rep_ == 0) { if (!(PEER_HALF_PROBE) || ((bx >> 3) & 1) == 0) peer_tile<0, true, (PEER_SELONLY != 0)>(lds, tile, 0, xbar); }
            else peer_tile<0>(lds, tile, 0, xbar);
    }
    SEAM(7);
    if (PH(8)) REP(8) { pg8::Gemm g{H, (const bf16*)(ws + WS_WIN1), T, 3840, 2048, 2048}; pg8::StaticOrder S; S.init(T, 3840, G, bx);
        EpiQKV1 E{ws, tab128}; pg8::gemm_phase<EpiQKV1, pg8::StaticOrder, true, true>(lds, g, S, E); }
#endif
    if (DEFER_PRO && PH(8) && bx >= 192 && G == 256) {
        __syncthreads();
        const int lane = threadIdx.x & 63, wv = __builtin_amdgcn_readfirstlane(threadIdx.x >> 6);
        LAS float* scr = (LAS float*)(lds + wv * 16384);
        for (int it = (bx - 192) * NWAVES + wv; it < 4096; it += 64 * NWAVES) {
            if (it < 2048) transpose_item(A.in[11], 2048, 2048, (bf16*)(ws + WS_WOUT1), 0, scr, it, lane);
            else transpose_item(A.in[15] + (size_t)2048 * 2048, 2048, 2048, (bf16*)(ws + WS_WQ1), 0, scr, it - 2048, lane);
        }
        __syncthreads();
    }
    SEAM(8);
    if (PH(9) && bx >= 16) {
        const int lane = threadIdx.x & 63, wv = __builtin_amdgcn_readfirstlane(threadIdx.x >> 6);
#pragma unroll 1
        for (int half = 0; half < 2; ++half) {
            if ((half == 0) == (((bx >> 3) & 1) == 0 || !P9_ALT)) {
                for (int un = bx - 16; un < 1024; un += G - 16) nsa_window_unit(lds, un >> 9, (un >> 8) & 1, un & 255);
                __syncthreads();
            } else {
                const int cvi = (P9_SKIP5 && G == 256) ? bx - 80 : bx - 16, cvn = (P9_SKIP5 && G == 256) ? 176 : G - 16;
                if (cvi >= 0)
                for (int r = 2 * 16384 + cvi * NWAVES + wv; r < 4 * 16384; r += 2 * cvn * NWAVES) {
                    const int r2 = r + cvn * NWAVES; const bool two = r2 < 4 * 16384;
                    const int tb = r >> 14, e = r & 16383; const float* src = (tb & 1 ? A.in[18] : A.in[17]) + ((size_t)(tb >> 1) * 16384 + e) * 2048;
                    const int rr = two ? r2 : r, tb2 = rr >> 14, e2 = rr & 16383; const float* src2 = (tb2 & 1 ? A.in[18] : A.in[17]) + ((size_t)(tb2 >> 1) * 16384 + e2) * 2048;
                    f32x4 pa[8], pb[8];
#if CONV_COAL
                    { f32x4 ra[8], rb[8]; row_load_coal(src, ra, lane); row_load_coal(src2, rb, lane); LAS float* xs = (LAS float*)lds + wv * 4608; row_xpose(ra, pa, xs, lane); row_xpose(rb, pb, xs + 2304, lane); }
#else
                    row_to_fp6_pre(src, pa, lane); row_to_fp6_pre(src2, pb, lane);
#endif
                    row_to_fp6(src, ws + WS_TAB + (size_t)tb * 24 * MiB + (size_t)e * 1536, (float*)(ws + WS_TSCALE) + r, lane, &pa);
                    if (two) row_to_fp6(src2, ws + WS_TAB + (size_t)tb2 * 24 * MiB + (size_t)e2 * 1536, (float*)(ws + WS_TSCALE) + rr, lane, &pb);
                }
            }
        }
    }
    if (PH(9)) REP(9) { pg8::Gemm g{(const bf16*)(ws + WS_KCVC), (const bf16*)(ws + WS_W1T), 4096, 512, 4096, 2048}; CmpOrder S{bx};
        EpiCmp1 E{(bf16*)(ws + WS_HID), (const float*)(ws + WS_BIAS1)}; pg8::gemm_phase<EpiCmp1, CmpOrder, false, true>(lds, g, S, E); }
    SEAM(9);
    if (PH(10)) { pg8::Gemm g{(const bf16*)(ws + WS_HID), (const bf16*)(ws + WS_W2T), 4096, 512, 256, 256}; CmpOrder S{bx};
        EpiCmp2 E{(bf16*)(ws + WS_KCMP), (bf16*)(ws + WS_VCMP), tab128}; pg8::gemm_phase<EpiCmp2, CmpOrder, false, true>(lds, g, S, E); }
    SEAM(10);
    if (PH(11)) REP(11) {
        if (vcu < 256) {
#pragma unroll 1
            for (int i = 0; i < 4; ++i) nsa_unit(lds, i >> 1, i & 1, (i & 1) ? 255 - vcu : vcu);
        }
    }
    SEAM(11);
#if FLOW2
    if (PH(12)) {
        using R = flow::R2;
        flow::Q fq{(unsigned*)(ws + flow::WS_FLOW) + R::BASE, (int)(xbar.x & 7u), 0u};
        for (int t = flow::pop<R, false>(lds, fq, -1); t >= 0; t = flow::pop<R, false>(lds, fq, -1)) {
            const int xq = (t >> 24) & 7, st = (t >> 16) & 255, rt = (t >> 8) & 255, ix = t & 255;
            if (st == 0) { pg8::Gemm g{ATT, (const bf16*)(ws + WS_WOUT1), T, 2048, 2048, 2048}; EpiResid<false> E{(const bf16*)(ws + WS_XB), (bf16*)(ws + WS_XB), mod + (size_t)2 * 2 * 6144 + 4096};
                flow::GOrder<R, 0> S{lds, &fq, t}; pg8::gemm_phase<EpiResid<false>, flow::GOrder<R, 0>, true, true>(lds, g, S, E); }
            else if (st == 2) { pg8::Gemm g{H, (const bf16*)(ws + WS_WQ1), T, 2048, 2048, 2048}; EpiPlain E{(bf16*)(ws + WS_Q1), 2048};
                flow::GOrder<R, 2> S{lds, &fq, t}; pg8::gemm_phase<EpiPlain, flow::GOrder<R, 2>, true, true>(lds, g, S, E); }
            else if (st == 1) {
                flow::acquire();
                int tid_ = threadIdx.x; asm volatile("" : "+v"(tid_));
                const int lane = tid_ & 63, wave = __builtin_amdgcn_readfirstlane(tid_ >> 6);
                const float* md = mod + (size_t)3 * 2 * 6144; const float* gg = A.in[4] + (size_t)3 * 2048;
                for (int i = 0; i < 8; ++i) { const int row = rt * 256 + ix * 64 + wave * 8 + i; adaln_row_bf((const bf16*)(ws + WS_XB) + (size_t)row * 2048, gg, md + (size_t)(row >> 13) * 6144, H + (size_t)row * 2048, lane); }
                flow::publish<false>(flow::arrive_ctr(fq, 1, rt), nullptr);
            } else {
                flow::acquire();
                peer_tile<1>(lds, rt * 8 + ix, 1, xbar);
                flow::publish<false>(flow::arrive_ctr(fq, 3, rt), flow::pact_ctr(fq, xq));
            }
        }
    }
#else
#if RESID_IN_NORM
    if (PH(12)) REP(12) { pg8::Gemm g{ATT, (const bf16*)(ws + WS_WOUT1), T, 2048, 2048, 2048}; pg8::StaticOrder S; S.init(T, 2048, G, bx);
        EpiGate E{(bf16*)(ws + WS_Y), mod + (size_t)2 * 2 * 6144 + 4096}; pg8::gemm_phase<EpiGate, pg8::StaticOrder, true, true>(lds, g, S, E); }
    SEAM(12);
    if (PH(13)) phase_adaln_add<false>(kargs(), ws + WS_XB, 3, vcu, G);
#else
    if (PH(12)) REP(12) { pg8::Gemm g{ATT, (const bf16*)(ws + WS_WOUT1), T, 2048, 2048, 2048}; pg8::StaticOrder S; S.init(T, 2048, G, bx);
        EpiResid<false> E{(const bf16*)(ws + WS_XB), (bf16*)(ws + WS_XB), mod + (size_t)2 * 2 * 6144 + 4096}; pg8::gemm_phase<EpiResid<false>, pg8::StaticOrder, true, true>(lds, g, S, E); }
    SEAM(12);
    if (PH(13)) phase_adaln_bf(kargs(), 3, vcu, G);
#endif
    SEAM(13);
    if (PH(14)) REP(14) { pg8::Gemm g{H, (const bf16*)(ws + WS_WQ1), T, 2048, 2048, 2048}; pg8::StaticOrder S; S.init(T, 2048, G, bx);
        EpiPlain E{(bf16*)(ws + WS_Q1), 2048}; pg8::gemm_phase<EpiPlain, pg8::StaticOrder, true, true>(lds, g, S, E); }
    SEAM(14);
    if (PH(15)) REP(15) {
        for (int tile = vcu; tile < 512; tile += G)
            peer_tile<1>(lds, tile, 1, xbar);
    }
#endif
    SEAM(15);
    if (PH(16)) phase_final(kargs(), (STOP_AFTER < 4) ? A.in[0] : (const float*)xbuf, vcu, G);
#undef PH
#undef SEAM
#undef A
#undef ws
#undef mod
#undef tab64
#undef tab128
#undef H
#undef ATT
#undef xbuf
}

extern "C" void kernel_launch(void* const* d_in, const int* in_sizes, int n_in, void* d_out, int out_size, void* d_ws, size_t ws_size, hipStream_t stream) {
    static int grid = 0;
    if (grid == 0) {
        if (n_in != 20 || out_size != T * DM || ws_size < WS_END) { fprintf(stderr, "kernel_launch: unexpected problem (n_in %d out %d ws %zu)\n", n_in, out_size, ws_size); grid = -1; return; }
        int dev = 0, cus = 0, per_cu = 0;
        hipGetDevice(&dev); hipDeviceGetAttribute(&cus, hipDeviceAttributeMultiprocessorCount, dev);
        hipFuncSetAttribute((const void*)fwd_kernel, hipFuncAttributeMaxDynamicSharedMemorySize, LDS_BYTES);
        hipOccupancyMaxActiveBlocksPerMultiprocessor(&per_cu, (const void*)fwd_kernel, NTHREADS, LDS_BYTES);
        (void)hipGetLastError();
        if (per_cu < 1) { fprintf(stderr, "kernel_launch: occupancy query says %d blocks per CU\n", per_cu); per_cu = 1; }
        grid = cus;
        if (grid > 256) grid = 256;
    }
    if (grid < 0) return;
    (void)hipMemsetAsync((char*)d_ws + WS_CTL, 0, 65536, stream);
    Args a{};
    for (int i = 0; i < 20; ++i) a.in[i] = (const float*)d_in[i];
    a.out = (float*)d_out; a.ws = (unsigned char*)d_ws;
#if N_LAUNCH_MODE == 1
    a.ph_lo = 0; a.ph_hi = (STOP_AFTER < 15) ? N_PHASES : 16;
    if (STOP_AFTER < 15) {
        a.ph_hi = STOP_AFTER + 1; void* args1[] = {&a};
        hipLaunchCooperativeKernel((const void*)fwd_kernel, dim3(grid), dim3(NTHREADS), args1, LDS_BYTES, stream);
        Args b = a; b.ph_lo = 16; b.ph_hi = 17; void* args2[] = {&b};
        hipLaunchCooperativeKernel((const void*)fwd_kernel, dim3(grid), dim3(NTHREADS), args2, LDS_BYTES, stream);
    } else {
        void* args[] = {&a};
        hipError_t e = hipLaunchCooperativeKernel((const void*)fwd_kernel, dim3(grid), dim3(NTHREADS), args, LDS_BYTES, stream);
        if (e != hipSuccess) fprintf(stderr, "cooperative launch failed: %s (grid %d)\n", hipGetErrorString(e), grid);
    }
#else
    for (int p = 0; p < N_PHASES; ++p) {
        if (p > STOP_AFTER && p != 16) continue;
        if (p == 16 && STOP_AFTER >= 15) continue;
        Args b = a; b.ph_lo = p; b.ph_hi = p + 1;
        hipLaunchKernelGGL(fwd_kernel, dim3(grid), dim3(NTHREADS), LDS_BYTES, stream, b);
    }
#endif
}
```

```cpp
#include <hip/hip_runtime.h>
#include <hip/hip_cooperative_groups.h>
#include <cstdio>
#include <cstdint>
namespace pg8 {
#define PG8_LAS __attribute__((address_space(3)))
typedef unsigned short bf16_t;
typedef short bf16x8 __attribute__((ext_vector_type(8)));
typedef float f32x4 __attribute__((ext_vector_type(4)));
typedef unsigned u32x4 __attribute__((ext_vector_type(4)));
constexpr int BM = 256, BK = 64, HALF = 128, HTB = HALF * BK * 2  , STAGE_BYTES = 8 * HTB, NXCD = 8, WGM = 8;

__host__ __device__ __forceinline__ int lds_byte(int r, int c) { const int st = (r >> 4) * 2 + (c >> 5), rr = r & 15, cc = c & 31, ob = rr * 64 + cc * 2; return st * 1024 + (ob ^ (((ob >> 9) & 1) << 5)); }
__host__ __device__ __forceinline__ void stage_rc(int b, int& R, int& C) { const int st = b / 1024, sb = b % 1024, swz = sb ^ (((sb >> 9) & 1) << 5); R = (st >> 1) * 16 + swz / 64; C = (st & 1) * 32 + (swz % 64) / 2; }
__host__ __device__ __forceinline__ int perm32(int rho) { const int n = rho >> 4, i = rho & 15; return 8 * (i >> 2) + 4 * n + (i & 3); }

struct Unit { int pm, pn; };
struct Gemm { const bf16_t* A; const bf16_t* Bt; int M, N, K, lda; };

struct StaticOrder {
    int nM, nN, nwg, G, c;
    __host__ __device__ void init(int M, int N, int G_, int c_) { nM = M / BM; nN = N / BM; nwg = nM * nN; G = G_; c = c_; }
    __host__ __device__ bool next(int i, Unit& u) const {
        const long L = (long)i * G + c; if (L >= nwg) return false;
        int wgid = (int)L; { const int q = nwg / NXCD, r = nwg % NXCD, xcd = wgid % NXCD, off = wgid / NXCD; wgid = (xcd < r ? xcd * (q + 1) : r * (q + 1) + (xcd - r) * q) + off; }
        const int nig = WGM * nN, gid = wgid / nig, fm = gid * WGM, gsz = (nM - fm) < WGM ? (nM - fm) : WGM;
        u.pm = fm + ((wgid % nig) % gsz); u.pn = (wgid % nig) / gsz; return true;
    }
    __device__ __forceinline__ void a_ready(const Unit&) const {}
    __device__ __forceinline__ void done(const Unit&) const {}
};

__device__ __forceinline__ unsigned cvt_pk_bf16(float lo, float hi) { unsigned r; asm volatile("v_cvt_pk_bf16_f32 %0, %1, %2" : "=v"(r) : "v"(lo), "v"(hi)); return r; }
typedef float f32x2 __attribute__((ext_vector_type(2)));
template <class Epi, class Sched, bool ALIGN_EPI = false, bool SP2 = false>
__device__ __forceinline__ void gemm_phase(PG8_LAS unsigned char* lds, const Gemm g, Sched& S, const Epi& E) {
    int tid_ = threadIdx.x; asm volatile("" : "+v"(tid_));
    const int tid = tid_, wid = __builtin_amdgcn_readfirstlane(tid >> 6), lane = tid & 63, wr = wid >> 2, wc = wid & 3, fr = lane & 15, fq = lane >> 4;
    const int K = g.K, nt = K / BK, LDA = g.lda;
    unsigned voffA[2], voffB[2];
#pragma unroll
    for (int i = 0; i < 2; ++i) { int R, C; stage_rc(tid * 16 + i * 8192, R, C); const int Rb = Epi::PERM ? ((R & ~31) + perm32(R & 31)) : R;
        voffA[i] = (unsigned)(R * LDA + C) * 2u; voffB[i] = (unsigned)(Rb * K + C) * 2u; }
    const size_t kstep = (size_t)(BK * 2);
    const size_t hstepB = (size_t)HALF * K * 2, hstepA = (size_t)HALF * LDA * 2;
    const size_t tstepA = 2 * hstepA, tstepB = 2 * hstepB;
    const unsigned ldsw = (unsigned)wid * 1024u;
    const int aoff = lds_byte(wr * 64 + fr, fq * 8), boff = lds_byte(wc * 32 + fr, fq * 8);
#define PG8_SA(b, h) (((b) * 2 + (h)) * HTB)
#define PG8_SB(b, h) ((4 + (b) * 2 + (h)) * HTB)
#define PG8_STAGE(bufoff, gbase, voff) do { _Pragma("unroll") for (int _i = 0; _i < 2; ++_i) \
        __builtin_amdgcn_global_load_lds((const unsigned*)((const char*)(gbase) + (voff)[_i]), (PG8_LAS unsigned*)(lds + (bufoff) + ldsw + _i * 8192), 16, 0, 0); } while (0)
#define PG8_LDA(dst, b, h) do { _Pragma("unroll") for (int m = 0; m < 4; ++m) _Pragma("unroll") for (int k = 0; k < 2; ++k) dst[m][k] = *(const PG8_LAS bf16x8*)(lds + PG8_SA(b, h) + aoff + m * 2048 + k * 1024); } while (0)
#define PG8_LDB(dst, b, h) do { _Pragma("unroll") for (int n = 0; n < 2; ++n) _Pragma("unroll") for (int k = 0; k < 2; ++k) dst[n][k] = *(const PG8_LAS bf16x8*)(lds + PG8_SB(b, h) + boff + n * 2048 + k * 1024); } while (0)
#define PG8_MMA(ai, bj, At, Bt) do { __builtin_amdgcn_s_setprio(1); _Pragma("unroll") for (int m = 0; m < 4; ++m) _Pragma("unroll") for (int n = 0; n < 2; ++n) _Pragma("unroll") for (int k = 0; k < 2; ++k) \
        acc[ai][bj][m][n] = __builtin_amdgcn_mfma_f32_16x16x32_bf16(Bt[n][k], At[m][k], acc[ai][bj][m][n], 0, 0, 0); __builtin_amdgcn_s_setprio(0); } while (0)
#define PG8_WAIT_V(n) asm volatile("s_waitcnt vmcnt(" #n ")" ::: "memory")
#define PG8_WAIT_L(n) asm volatile("s_waitcnt lgkmcnt(" #n ")" ::: "memory")
#define PG8_BAR __builtin_amdgcn_s_barrier()
#define PG8_SCHED __builtin_amdgcn_sched_barrier(0)
    Unit cur, nxt; int ui = 0;
    if (!S.next(0, cur)) return;
    f32x4 acc[2][2][4][2];
#pragma unroll
    for (int a = 0; a < 2; ++a)
#pragma unroll
        for (int b = 0; b < 2; ++b)
#pragma unroll
            for (int m = 0; m < 4; ++m)
#pragma unroll
                for (int n = 0; n < 2; ++n) acc[a][b][m][n] = (f32x4){0.f, 0.f, 0.f, 0.f};
    bf16x8 At[4][2], B0[2][2], B1[2][2];
    const char* cA = (const char*)g.A + (size_t)cur.pm * tstepA; const char* cB = (const char*)g.Bt + (size_t)cur.pn * tstepB;
    S.a_ready(cur);
    if constexpr (SP2) {
        PG8_STAGE(PG8_SB(0, 0), cB, voffB); PG8_STAGE(PG8_SB(0, 1), cB + hstepB, voffB); PG8_STAGE(PG8_SA(0, 0), cA, voffA); PG8_STAGE(PG8_SA(0, 1), cA + hstepA, voffA);
        if (wr == 1) PG8_BAR;
        PG8_WAIT_V(2); PG8_BAR;
        PG8_STAGE(PG8_SB(1, 0), cB + kstep, voffB); PG8_STAGE(PG8_SA(1, 0), cA + kstep, voffA); PG8_STAGE(PG8_SB(1, 1), cB + hstepB + kstep, voffB);
        PG8_WAIT_V(6); PG8_BAR;
    } else {
        PG8_STAGE(PG8_SB(0, 0), cB, voffB); PG8_STAGE(PG8_SA(0, 0), cA, voffA); PG8_STAGE(PG8_SB(0, 1), cB + hstepB, voffB); PG8_STAGE(PG8_SA(0, 1), cA + hstepA, voffA);
        if (wr == 1) PG8_BAR;
        PG8_WAIT_V(4); PG8_BAR;
        PG8_STAGE(PG8_SB(1, 0), cB + kstep, voffB); PG8_STAGE(PG8_SA(1, 0), cA + kstep, voffA); PG8_STAGE(PG8_SB(1, 1), cB + hstepB + kstep, voffB);
        PG8_WAIT_V(6); PG8_BAR;
    }
    for (;;) {
        const bool has_next = S.next(ui + 1, nxt);
        const char* nA = has_next ? (const char*)g.A + (size_t)nxt.pm * tstepA : cA; const char* nB = has_next ? (const char*)g.Bt + (size_t)nxt.pn * tstepB : cB;
        for (int t = 0; t < nt; t += 2) {
            const bool last = (t == nt - 2);
            const char* a1 = cA + (size_t)(t + 1) * kstep;
            const char* a2 = last ? nA : cA + (size_t)(t + 2) * kstep; const char* b2 = last ? nB : cB + (size_t)(t + 2) * kstep;
            const char* a3 = a2 + kstep; const char* b3 = b2 + kstep;
            if (last && has_next) S.a_ready(nxt);
            if constexpr (SP2) {
            PG8_LDB(B0, 0, 0); PG8_LDB(B1, 0, 1); PG8_SCHED; PG8_LDA(At, 0, 0); PG8_STAGE(PG8_SA(1, 1), a1 + hstepA, voffA);
            PG8_WAIT_V(8); PG8_WAIT_L(0); PG8_BAR; PG8_MMA(0, 0, At, B0); PG8_MMA(0, 1, At, B1); PG8_BAR; PG8_SCHED;
            PG8_LDA(At, 0, 1); PG8_STAGE(PG8_SB(0, 0), b2, voffB); PG8_STAGE(PG8_SB(0, 1), b2 + hstepB, voffB); PG8_STAGE(PG8_SA(0, 0), a2, voffA);
            PG8_WAIT_V(8); PG8_WAIT_L(0); PG8_BAR; PG8_MMA(1, 0, At, B0); PG8_MMA(1, 1, At, B1); PG8_BAR; PG8_SCHED;
            PG8_LDB(B0, 1, 0); PG8_LDB(B1, 1, 1); PG8_SCHED; PG8_LDA(At, 1, 0); PG8_STAGE(PG8_SA(0, 1), a2 + hstepA, voffA);
            PG8_WAIT_V(8); PG8_WAIT_L(0); PG8_BAR; PG8_MMA(0, 0, At, B0); PG8_MMA(0, 1, At, B1); PG8_BAR; PG8_SCHED;
            PG8_LDA(At, 1, 1); PG8_STAGE(PG8_SB(1, 0), b3, voffB); PG8_STAGE(PG8_SB(1, 1), b3 + hstepB, voffB); PG8_STAGE(PG8_SA(1, 0), a3, voffA);
            PG8_WAIT_V(8); PG8_WAIT_L(0); PG8_BAR; PG8_MMA(1, 0, At, B0); PG8_MMA(1, 1, At, B1); PG8_BAR; PG8_SCHED;
            } else {
            PG8_LDB(B0, 0, 0); PG8_SCHED; PG8_LDA(At, 0, 0); PG8_STAGE(PG8_SA(1, 1), a1 + hstepA, voffA);
            PG8_WAIT_L(8); PG8_BAR; PG8_WAIT_L(0); PG8_MMA(0, 0, At, B0); PG8_BAR; PG8_SCHED;
            PG8_LDB(B1, 0, 1); PG8_STAGE(PG8_SB(0, 0), b2, voffB);
            PG8_BAR; PG8_WAIT_L(0); PG8_MMA(0, 1, At, B1); PG8_BAR;
            PG8_LDA(At, 0, 1); PG8_STAGE(PG8_SA(0, 0), a2, voffA);
            PG8_BAR; PG8_WAIT_L(0); PG8_MMA(1, 0, At, B0); PG8_BAR; PG8_SCHED;
            PG8_STAGE(PG8_SB(0, 1), b2 + hstepB, voffB);
            PG8_WAIT_V(6); PG8_BAR; PG8_MMA(1, 1, At, B1); PG8_BAR;
            PG8_LDB(B0, 1, 0); PG8_SCHED; PG8_LDA(At, 1, 0); PG8_STAGE(PG8_SA(0, 1), a2 + hstepA, voffA);
            PG8_WAIT_L(8); PG8_BAR; PG8_WAIT_L(0); PG8_MMA(0, 0, At, B0); PG8_BAR; PG8_SCHED;
            PG8_LDB(B1, 1, 1); PG8_STAGE(PG8_SB(1, 0), b3, voffB);
            PG8_BAR; PG8_WAIT_L(0); PG8_MMA(0, 1, At, B1); PG8_BAR;
            PG8_LDA(At, 1, 1); PG8_STAGE(PG8_SA(1, 0), a3, voffA);
            PG8_BAR; PG8_WAIT_L(0); PG8_MMA(1, 0, At, B0); PG8_BAR; PG8_SCHED;
            PG8_STAGE(PG8_SB(1, 1), b3 + hstepB, voffB);
            PG8_WAIT_V(6); PG8_BAR; PG8_MMA(1, 1, At, B1); PG8_BAR;
            }
        }
        if constexpr (ALIGN_EPI) { if (wr == 0) PG8_BAR; }
        if constexpr (!Epi::AFTER_DRAIN) { E(acc, cur, wr, wc, fr, fq); S.done(cur); }
        if (!has_next) break;
#pragma unroll
        for (int a = 0; a < 2; ++a)
#pragma unroll
            for (int b = 0; b < 2; ++b)
#pragma unroll
                for (int m = 0; m < 4; ++m)
#pragma unroll
                    for (int n = 0; n < 2; ++n) acc[a][b][m][n] = (f32x4){0.f, 0.f, 0.f, 0.f};
        cur = nxt; cA = nA; cB = nB; ++ui;
        if constexpr (ALIGN_EPI) { if (wr == 1) PG8_BAR; }
    }
    PG8_WAIT_V(0);
    if constexpr (!ALIGN_EPI) { if (wr == 0) PG8_BAR; }
    PG8_BAR;
    if constexpr (Epi::AFTER_DRAIN) { E.fused(acc, cur, wr, wc, fr, fq, lds, wid, lane); S.done(cur); }
#undef PG8_SA
#undef PG8_SB
#undef PG8_STAGE
#undef PG8_LDA
#undef PG8_LDB
#undef PG8_MMA
#undef PG8_WAIT_V
#undef PG8_WAIT_L
#undef PG8_BAR
#undef PG8_SCHED
}
}

namespace cg = cooperative_groups;
#define LAS __attribute__((address_space(3)))
typedef unsigned short bf16;
typedef short bf16x8 __attribute__((ext_vector_type(8)));
typedef short s16x4 __attribute__((ext_vector_type(4)));
typedef float f32x2 __attribute__((ext_vector_type(2)));
typedef float f32x4 __attribute__((ext_vector_type(4)));
typedef float f32x16 __attribute__((ext_vector_type(16)));
typedef unsigned u32x2 __attribute__((ext_vector_type(2)));
typedef unsigned u32x4 __attribute__((ext_vector_type(4)));
typedef __bf16 bf16x2_t __attribute__((ext_vector_type(2)));

constexpr int NB = 2, SEQ = 8192, T = NB * SEQ, DM = 2048;
constexpr float LOG2E = 1.4426950408889634f;
constexpr float NORM_EPS = 1e-6f;
constexpr int NTHREADS = 512, NWAVES = 8;
constexpr int LDS_BYTES = 160 * 1024;
constexpr float NEG_BIG = -1e30f;

constexpr size_t MiB = 1u << 20;
constexpr size_t WS_CTL = 0;
constexpr size_t WS_ROWSQ = 656 * MiB;
constexpr size_t WS_SW = 1 * MiB + 512 * 1024;
constexpr size_t WS_MOD = 1 * MiB;
constexpr size_t WS_TAB64 = 2 * MiB;
constexpr size_t WS_TAB128 = 4 * MiB;
constexpr size_t WS_BIAS1 = 8 * MiB;
constexpr size_t WS_SUBK = 9 * MiB;
constexpr size_t WS_W2T = 10 * MiB;
constexpr size_t WS_W1T = 11 * MiB;
constexpr size_t WS_WIN0 = 16 * MiB;
constexpr size_t WS_WOUT0 = 34 * MiB;
constexpr size_t WS_WIN1 = 42 * MiB;
constexpr size_t WS_WOUT1 = 57 * MiB;
constexpr size_t WS_WQ0 = 65 * MiB;
constexpr size_t WS_WQ1 = 73 * MiB;
constexpr size_t WS_SLOT = 81 * MiB;
constexpr size_t WS_U0 = 128 * MiB;
constexpr size_t WS_TAB = WS_U0;
constexpr size_t WS_TSCALE = WS_U0 + 128 * MiB;
constexpr size_t WS_H = 384 * MiB;
constexpr size_t WS_ATT = 448 * MiB;
constexpr size_t WS_QKV = 512 * MiB;
constexpr size_t WS_Q1 = 512 * MiB;
constexpr size_t WS_KSL = 576 * MiB;
constexpr size_t WS_VSL = 584 * MiB;
constexpr size_t WS_KW = 592 * MiB;
constexpr size_t WS_VW = 600 * MiB;
constexpr size_t WS_KCVC = 608 * MiB;
constexpr size_t WS_GATES = 626 * MiB;
constexpr size_t WS_HID = 630 * MiB;
constexpr size_t WS_KCMP = 633 * MiB;
constexpr size_t WS_VCMP = 634 * MiB;
constexpr size_t WS_Y = 576 * MiB;
constexpr size_t WS_XB = 656 * MiB;
constexpr size_t WS_END = 720 * MiB;

__device__ __forceinline__ unsigned cvtpk(float lo, float hi) { f32x2 v = {lo, hi}; bf16x2_t b = __builtin_convertvector(v, bf16x2_t); return __builtin_bit_cast(unsigned, b); }
__device__ __forceinline__ float bf2f(unsigned short b) { return __uint_as_float((unsigned)b << 16); }
__device__ __forceinline__ float bflo(unsigned w) { return __uint_as_float(w << 16); }
__device__ __forceinline__ float bfhi(unsigned w) { return __uint_as_float(w & 0xffff0000u); }
__device__ __forceinline__ float wave_sum(float v) {
#pragma unroll
    for (int o = 1; o < 64; o <<= 1) v += __shfl_xor(v, o);
    return v;
}
__device__ __forceinline__ float sum32(float v) {
    auto rr = __builtin_amdgcn_permlane32_swap(__float_as_uint(v), __float_as_uint(v), false, false);
    return __uint_as_float(rr[0]) + __uint_as_float(rr[1]);
}
__device__ __forceinline__ float max32(float v) {
    auto rr = __builtin_amdgcn_permlane32_swap(__float_as_uint(v), __float_as_uint(v), false, false);
    return fmaxf(__uint_as_float(rr[0]), __uint_as_float(rr[1]));
}
__device__ __forceinline__ float gelu_tanh(float x) {
    const float u = 0.7978845608028654f * (x + 0.044715f * x * x * x);
    const float e = __expf(2.f * u);
    const float th = 1.f - 2.f * __builtin_amdgcn_rcpf(e + 1.f);
    return 0.5f * x * (1.f + th);
}
__device__ __forceinline__ float sigmoidf_(float x) { return 1.f / (1.f + __expf(-x)); }
__device__ __forceinline__ float siluf_(float x) { return x / (1.f + __expf(-x)); }

#ifndef NT_ONCE
#define NT_ONCE 0
#endif
__device__ __forceinline__ void gemv_item(const LAS float* sv, int K, const float* W, int ldw, int col0, LAS float* red, float* out0, float* out1, const float* bias) {
    const int tid = threadIdx.x, lane = tid & 63, w = __builtin_amdgcn_readfirstlane(tid >> 6);
    const int kw = K / 8, kb = w * kw;
    float a00 = 0.f, a01 = 0.f, a10 = 0.f, a11 = 0.f;
    const float* wp = W + (size_t)kb * ldw + col0 + 2 * lane;
#pragma unroll 32
    for (int k = 0; k < kw; ++k) {
        const f32x2 wv = NT_ONCE ? __builtin_nontemporal_load((const f32x2*)(wp + (size_t)k * ldw)) : *(const f32x2*)(wp + (size_t)k * ldw);
        const float s0 = sv[kb + k], s1 = sv[K + kb + k];
        a00 += s0 * wv.x; a01 += s0 * wv.y; a10 += s1 * wv.x; a11 += s1 * wv.y;
    }
    red[(w * 2 + 0) * 128 + 2 * lane] = a00; red[(w * 2 + 0) * 128 + 2 * lane + 1] = a01;
    red[(w * 2 + 1) * 128 + 2 * lane] = a10; red[(w * 2 + 1) * 128 + 2 * lane + 1] = a11;
    __syncthreads();
    if (tid < 256) {
        const int v = tid >> 7, c = tid & 127; float s = 0.f;
#pragma unroll
        for (int ww = 0; ww < 8; ++ww) s += red[(ww * 2 + v) * 128 + c];
        if (bias) s += bias[col0 + c];
        (v == 0 ? out0 : out1)[col0 + c] = s;
    }
    __syncthreads();
}
__device__ __forceinline__ int rope64_pos(int n) { const int d = n & 63; return (n & ~63) | ((d < 32) ? 2 * d : 2 * (d - 32) + 1); }
__device__ __forceinline__ int rope128_pos(int n) { const int d = n & 127; return (n & ~127) | ((d < 64) ? 2 * d : 2 * (d - 64) + 1); }
__device__ __forceinline__ int dst_row(int mode, int n) {
    if (mode == 1) {
        if (n < 2048) return rope64_pos(n);
        if (n < 3072) return n;
        if (n < 4352) return rope64_pos(n);
        return n;
    }
    if (mode == 2) {
        if (n < 2048) return rope128_pos(n);
        if (n < 2560) return n;
        if (n < 2816) return rope128_pos(n);
        if (n < 3072) return n;
        if (n < 3328) return rope128_pos(n);
        return n;
    }
    if (mode == 3) return rope128_pos(n);
    return n;
}
__device__ __forceinline__ void transpose_item(const float* W, int K, int N, bf16* WT, int mode, LAS float* scr, int item, int lane) {
    const int nblk = (N + 31) / 32, kb = item / nblk, nb = item % nblk, k0 = 64 * kb, n0 = 32 * nb;
    const int nn = n0 + (lane & 31); const bool okn = nn < N;
    float tv[32];
#pragma unroll
    for (int i = 0; i < 32; ++i) { const int kk = 2 * i + (lane >> 5); tv[i] = okn ? (NT_ONCE ? __builtin_nontemporal_load(W + (size_t)(k0 + kk) * N + nn) : W[(size_t)(k0 + kk) * N + nn]) : 0.f; }
#pragma unroll
    for (int i = 0; i < 32; ++i) { const int kk = 2 * i + (lane >> 5); scr[kk * 33 + (lane & 31)] = tv[i]; }
    asm volatile("s_waitcnt lgkmcnt(0)" ::: "memory");
    const int c = lane & 7;
#pragma unroll
    for (int j = 0; j < 4; ++j) {
        const int nl = (lane >> 3) + 8 * j, n = n0 + nl; const LAS float* s = scr + (8 * c) * 33 + nl;
        u32x4 o; o.x = cvtpk(s[0 * 33], s[1 * 33]); o.y = cvtpk(s[2 * 33], s[3 * 33]); o.z = cvtpk(s[4 * 33], s[5 * 33]); o.w = cvtpk(s[6 * 33], s[7 * 33]);
        if (n < N) *(u32x4*)(WT + (size_t)dst_row(mode, n) * K + k0 + 8 * c) = o;
    }
    asm volatile("s_waitcnt lgkmcnt(0)" ::: "memory");
}

__device__ __forceinline__ void adaln_row(const float* xrow, const float* g, const float* mod, bf16* hrow, int lane) {
    f32x4 v[8]; float ss = 0.f;
#pragma unroll
    for (int j = 0; j < 4; ++j) {
        v[2 * j] = *(const f32x4*)(xrow + lane * 8 + 512 * j); v[2 * j + 1] = *(const f32x4*)(xrow + lane * 8 + 512 * j + 4);
        ss += v[2 * j].x * v[2 * j].x + v[2 * j].y * v[2 * j].y + v[2 * j].z * v[2 * j].z + v[2 * j].w * v[2 * j].w;
        ss += v[2 * j + 1].x * v[2 * j + 1].x + v[2 * j + 1].y * v[2 * j + 1].y + v[2 * j + 1].z * v[2 * j + 1].z + v[2 * j + 1].w * v[2 * j + 1].w;
    }
    const float r = 1.0f / sqrtf(wave_sum(ss) * (1.f / DM) + NORM_EPS);
#pragma unroll
    for (int j = 0; j < 4; ++j) {
        const int idx = lane * 8 + 512 * j;
        f32x4 o[2];
#pragma unroll
        for (int q = 0; q < 2; ++q) {
            const f32x4 gg = *(const f32x4*)(g + idx + 4 * q), sh = *(const f32x4*)(mod + idx + 4 * q), sc = *(const f32x4*)(mod + 2048 + idx + 4 * q);
            o[q] = v[2 * j + q] * r * gg * (1.f + sc) + sh;
        }
        u32x4 w; w.x = cvtpk(o[0].x, o[0].y); w.y = cvtpk(o[0].z, o[0].w); w.z = cvtpk(o[1].x, o[1].y); w.w = cvtpk(o[1].z, o[1].w);
        *(u32x4*)(hrow + idx) = w;
    }
}
__device__ __forceinline__ void adaln_row2(const float* xa, const float* xb, const float* g, const float* moda, const float* modb, bf16* ha, bf16* hb, int lane) {
    f32x4 va[8], vb[8]; float sa = 0.f, sb = 0.f;
#pragma unroll
    for (int j = 0; j < 8; ++j) { va[j] = *(const f32x4*)(xa + lane * 8 + 512 * (j >> 1) + 4 * (j & 1)); vb[j] = *(const f32x4*)(xb + lane * 8 + 512 * (j >> 1) + 4 * (j & 1)); }
#pragma unroll
    for (int j = 0; j < 8; ++j) { sa += va[j].x * va[j].x + va[j].y * va[j].y + va[j].z * va[j].z + va[j].w * va[j].w; sb += vb[j].x * vb[j].x + vb[j].y * vb[j].y + vb[j].z * vb[j].z + vb[j].w * vb[j].w; }
    const float ra = 1.0f / sqrtf(wave_sum(sa) * (1.f / DM) + NORM_EPS), rb = 1.0f / sqrtf(wave_sum(sb) * (1.f / DM) + NORM_EPS);
#pragma unroll
    for (int j = 0; j < 4; ++j) {
        const int idx = lane * 8 + 512 * j;
        f32x4 oa[2], ob[2];
#pragma unroll
        for (int q = 0; q < 2; ++q) {
            const f32x4 gg = *(const f32x4*)(g + idx + 4 * q);
            oa[q] = va[2 * j + q] * ra * gg * (1.f + *(const f32x4*)(moda + 2048 + idx + 4 * q)) + *(const f32x4*)(moda + idx + 4 * q);
            ob[q] = vb[2 * j + q] * rb * gg * (1.f + *(const f32x4*)(modb + 2048 + idx + 4 * q)) + *(const f32x4*)(modb + idx + 4 * q);
        }
        u32x4 w; w.x = cvtpk(oa[0].x, oa[0].y); w.y = cvtpk(oa[0].z, oa[0].w); w.z = cvtpk(oa[1].x, oa[1].y); w.w = cvtpk(oa[1].z, oa[1].w);
        *(u32x4*)(ha + idx) = w;
        w.x = cvtpk(ob[0].x, ob[0].y); w.y = cvtpk(ob[0].z, ob[0].w); w.z = cvtpk(ob[1].x, ob[1].y); w.w = cvtpk(ob[1].z, ob[1].w);
        *(u32x4*)(hb + idx) = w;
    }
}
__device__ __forceinline__ void adaln_row_bf(const bf16* xrow, const float* g, const float* mod, bf16* hrow, int lane) {
    f32x4 v[8]; float ss = 0.f;
#pragma unroll
    for (int j = 0; j < 4; ++j) {
        const u32x4 w = *(const u32x4*)(xrow + lane * 8 + 512 * j);
        v[2 * j] = (f32x4){bflo(w.x), bfhi(w.x), bflo(w.y), bfhi(w.y)}; v[2 * j + 1] = (f32x4){bflo(w.z), bfhi(w.z), bflo(w.w), bfhi(w.w)};
        ss += v[2 * j].x * v[2 * j].x + v[2 * j].y * v[2 * j].y + v[2 * j].z * v[2 * j].z + v[2 * j].w * v[2 * j].w;
        ss += v[2 * j + 1].x * v[2 * j + 1].x + v[2 * j + 1].y * v[2 * j + 1].y + v[2 * j + 1].z * v[2 * j + 1].z + v[2 * j + 1].w * v[2 * j + 1].w;
    }
    const float r = 1.0f / sqrtf(wave_sum(ss) * (1.f / DM) + NORM_EPS);
#pragma unroll
    for (int j = 0; j < 4; ++j) {
        const int idx = lane * 8 + 512 * j;
        f32x4 o[2];
#pragma unroll
        for (int q = 0; q < 2; ++q) {
            const f32x4 gg = *(const f32x4*)(g + idx + 4 * q), sh = *(const f32x4*)(mod + idx + 4 * q), sc = *(const f32x4*)(mod + 2048 + idx + 4 * q);
            o[q] = v[2 * j + q] * r * gg * (1.f + sc) + sh;
        }
        u32x4 w; w.x = cvtpk(o[0].x, o[0].y); w.y = cvtpk(o[0].z, o[0].w); w.z = cvtpk(o[1].x, o[1].y); w.w = cvtpk(o[1].z, o[1].w);
        *(u32x4*)(hrow + idx) = w;
    }
}
__device__ __forceinline__ void final_row(const float* xrow, const float* g, float* orow, int lane) {
    f32x4 v[8]; float ss = 0.f;
#pragma unroll
    for (int j = 0; j < 8; ++j) { v[j] = *(const f32x4*)(xrow + lane * 8 + 512 * (j >> 1) + 4 * (j & 1)); ss += v[j].x * v[j].x + v[j].y * v[j].y + v[j].z * v[j].z + v[j].w * v[j].w; }
    const float r = 1.0f / sqrtf(wave_sum(ss) * (1.f / DM) + NORM_EPS);
#pragma unroll
    for (int j = 0; j < 8; ++j) { const int idx = lane * 8 + 512 * (j >> 1) + 4 * (j & 1); const f32x4 gg = *(const f32x4*)(g + idx); *(f32x4*)(orow + idx) = v[j] * r * gg; }
}

#define EPI_ROWS_BEGIN _Pragma("unroll") for (int ai = 0; ai < 2; ++ai) { _Pragma("unroll") for (int m = 0; m < 4; ++m) { const int row = u.pm * 256 + wr * 64 + fr + ai * 128 + m * 16; _Pragma("unroll") for (int bj = 0; bj < 2; ++bj) { \
        const int col = u.pn * 256 + bj * 128 + wc * 32 + 8 * fq; f32x4 v0 = acc[ai][bj][m][0], v1 = acc[ai][bj][m][1];
#define EPI_ROWS_END } } }
#define EPI_HALVES _Pragma("unroll") for (int ai = 0; ai < 2; ++ai)
#define EPI_CHUNKS _Pragma("unroll") for (int m = 0; m < 4; ++m) _Pragma("unroll") for (int bj = 0; bj < 2; ++bj)
#define EPI_RC const int ci = m * 2 + bj, row = u.pm * 256 + wr * 64 + fr + ai * 128 + m * 16, col = u.pn * 256 + bj * 128 + wc * 32 + 8 * fq; (void)ci;
#ifndef EPI_BATCH
#define EPI_BATCH 0
#endif
__device__ __forceinline__ void rope8t(f32x4& v0, f32x4& v1, const f32x4& t0, const f32x4& t1) {
    f32x4 a, b;
    a.x = v0.x * t0.x - v0.y * t0.y; a.y = v0.y * t0.x + v0.x * t0.y;
    a.z = v0.z * t0.z - v0.w * t0.w; a.w = v0.w * t0.z + v0.z * t0.w;
    b.x = v1.x * t1.x - v1.y * t1.y; b.y = v1.y * t1.x + v1.x * t1.y;
    b.z = v1.z * t1.z - v1.w * t1.w; b.w = v1.w * t1.z + v1.z * t1.w;
    v0 = a; v1 = b;
}
__device__ __forceinline__ void rope8(f32x4& v0, f32x4& v1, const f32x2* tab) {
    const f32x4 t0 = *(const f32x4*)tab, t1 = *(const f32x4*)(tab + 2);
    f32x4 a, b;
    a.x = v0.x * t0.x - v0.y * t0.y; a.y = v0.y * t0.x + v0.x * t0.y;
    a.z = v0.z * t0.z - v0.w * t0.w; a.w = v0.w * t0.z + v0.z * t0.w;
    b.x = v1.x * t1.x - v1.y * t1.y; b.y = v1.y * t1.x + v1.x * t1.y;
    b.z = v1.z * t1.z - v1.w * t1.w; b.w = v1.w * t1.z + v1.z * t1.w;
    v0 = a; v1 = b;
}
__device__ __forceinline__ u32x4 pack8(const f32x4& v0, const f32x4& v1) { u32x4 w; w.x = cvtpk(v0.x, v0.y); w.y = cvtpk(v0.z, v0.w); w.z = cvtpk(v1.x, v1.y); w.w = cvtpk(v1.z, v1.w); return w; }

constexpr float QSCALE64 = 0.125f * LOG2E;
constexpr float QSCALE128 = 0.08838834764831845f * LOG2E;

struct EpiQKV0 {
    static constexpr bool PERM = true, AFTER_DRAIN = false;
    bf16* out; const f32x2* tab64;
    __device__ __forceinline__ void operator()(const f32x4 (&acc)[2][2][4][2], const pg8::Unit& u, int wr, int wc, int fr, int fq) const {
        const int pn = u.pn;
        const bool rope = (pn < 8) || (pn >= 12 && pn < 17);
        const float sc = (pn < 4 || (pn >= 12 && pn < 16)) ? QSCALE64 : 1.f;
#if EPI_BATCH
        EPI_HALVES {
            f32x4 t0[8], t1[8];
            if (rope) {
                EPI_CHUNKS { EPI_RC const f32x2* tp = tab64 + (size_t)(row & (SEQ - 1)) * 32 + ((col & 63) >> 1); t0[ci] = *(const f32x4*)tp; t1[ci] = *(const f32x4*)(tp + 2); }
#pragma unroll
                for (int c8 = 0; c8 < 8; ++c8) { asm volatile("" : "+v"(t0[c8])); asm volatile("" : "+v"(t1[c8])); }
            }
            EPI_CHUNKS { EPI_RC f32x4 v0 = acc[ai][bj][m][0], v1 = acc[ai][bj][m][1];
                if (rope) rope8t(v0, v1, t0[ci], t1[ci]);
                v0 = v0 * sc; v1 = v1 * sc;
                *(u32x4*)(out + (size_t)row * 4608 + col) = pack8(v0, v1); }
        }
#else
        EPI_ROWS_BEGIN
            if (rope) rope8(v0, v1, tab64 + (size_t)(row & (SEQ - 1)) * 32 + ((col & 63) >> 1));
            v0 = v0 * sc; v1 = v1 * sc;
            *(u32x4*)(out + (size_t)row * 4608 + col) = pack8(v0, v1);
        EPI_ROWS_END
#endif
    }
};
struct EpiQKV1 {
    static constexpr bool PERM = true, AFTER_DRAIN = false;
    unsigned char* ws; const f32x2* tab128;
    __device__ __forceinline__ void operator()(const f32x4 (&acc)[2][2][4][2], const pg8::Unit& u, int wr, int wc, int fr, int fq) const {
        const int pn = u.pn;
        const bool rope = (pn < 8) || pn == 10 || pn == 12;
#if EPI_BATCH
        EPI_HALVES {
            f32x4 t0[8], t1[8];
            if (rope) {
                EPI_CHUNKS { EPI_RC const f32x2* tp = tab128 + (size_t)(row & (SEQ - 1)) * 64 + ((col & 127) >> 1); t0[ci] = *(const f32x4*)tp; t1[ci] = *(const f32x4*)(tp + 2); }
#pragma unroll
                for (int c8 = 0; c8 < 8; ++c8) { asm volatile("" : "+v"(t0[c8])); asm volatile("" : "+v"(t1[c8])); }
            }
            EPI_CHUNKS { EPI_RC f32x4 v0 = acc[ai][bj][m][0], v1 = acc[ai][bj][m][1];
            if (rope) rope8t(v0, v1, t0[ci], t1[ci]);
            if (pn < 8) { v0 = v0 * QSCALE128; v1 = v1 * QSCALE128; *(u32x4*)((bf16*)(ws + WS_Q1) + (size_t)row * 2048 + col) = pack8(v0, v1); }
            else if (pn < 10) {
                const int c = col & 255, h = c >> 7, d0 = c & 127, b = row >> 13, s = row & (SEQ - 1);
                *(u32x4*)((bf16*)(ws + WS_KCVC) + ((((size_t)(pn - 8) * 2 + b) * 2 + h) * SEQ + s) * 128 + d0) = pack8(v0, v1);
            } else if (pn < 14) {
                const size_t off = (pn == 10) ? WS_KSL : (pn == 11) ? WS_VSL : (pn == 12) ? WS_KW : WS_VW;
                *(u32x4*)((bf16*)(ws + off) + (size_t)row * 256 + (col & 255)) = pack8(v0, v1);
            } else {
                const int c = col - 3584;
                if (c < 48) { float* gp = (float*)(ws + WS_GATES) + (size_t)row * 48 + c;
                    f32x4 a, b2; a.x = sigmoidf_(v0.x); a.y = sigmoidf_(v0.y); a.z = sigmoidf_(v0.z); a.w = sigmoidf_(v0.w);
                    b2.x = sigmoidf_(v1.x); b2.y = sigmoidf_(v1.y); b2.z = sigmoidf_(v1.z); b2.w = sigmoidf_(v1.w);
                    *(f32x4*)gp = a; *(f32x4*)(gp + 4) = b2; }
            }
            }
        }
#else
        EPI_ROWS_BEGIN
            if (rope) rope8(v0, v1, tab128 + (size_t)(row & (SEQ - 1)) * 64 + ((col & 127) >> 1));
            if (pn < 8) { v0 = v0 * QSCALE128; v1 = v1 * QSCALE128; *(u32x4*)((bf16*)(ws + WS_Q1) + (size_t)row * 2048 + col) = pack8(v0, v1); }
            else if (pn < 10) {
                const int c = col & 255, h = c >> 7, d0 = c & 127, b = row >> 13, s = row & (SEQ - 1);
                *(u32x4*)((bf16*)(ws + WS_KCVC) + ((((size_t)(pn - 8) * 2 + b) * 2 + h) * SEQ + s) * 128 + d0) = pack8(v0, v1);
            } else if (pn < 14) {
                const size_t off = (pn == 10) ? WS_KSL : (pn == 11) ? WS_VSL : (pn == 12) ? WS_KW : WS_VW;
                *(u32x4*)((bf16*)(ws + off) + (size_t)row * 256 + (col & 255)) = pack8(v0, v1);
            } else {
                const int c = col - 3584;
                if (c < 48) { float* gp = (float*)(ws + WS_GATES) + (size_t)row * 48 + c;
                    f32x4 a, b2; a.x = sigmoidf_(v0.x); a.y = sigmoidf_(v0.y); a.z = sigmoidf_(v0.z); a.w = sigmoidf_(v0.w);
                    b2.x = sigmoidf_(v1.x); b2.y = sigmoidf_(v1.y); b2.z = sigmoidf_(v1.z); b2.w = sigmoidf_(v1.w);
                    *(f32x4*)gp = a; *(f32x4*)(gp + 4) = b2; }
            }
        EPI_ROWS_END
#endif
    }
};
struct EpiGate {
    static constexpr bool PERM = true, AFTER_DRAIN = false;
    bf16* y; const float* gate;
    __device__ __forceinline__ void operator()(const f32x4 (&acc)[2][2][4][2], const pg8::Unit& u, int wr, int wc, int fr, int fq) const {
        EPI_ROWS_BEGIN
            const float* gp = gate + (size_t)(row >> 13) * 6144 + col;
            const f32x4 g0 = *(const f32x4*)gp, g1 = *(const f32x4*)(gp + 4);
            *(u32x4*)(y + (size_t)row * 2048 + col) = pack8(g0 * v0, g1 * v1);
        EPI_ROWS_END
    }
};
template <bool XOLD_F32>
struct EpiResid {
    static constexpr bool PERM = true, AFTER_DRAIN = false;
    const void* xold; bf16* xnew; const float* gate;
    __device__ __forceinline__ void operator()(const f32x4 (&acc)[2][2][4][2], const pg8::Unit& u, int wr, int wc, int fr, int fq) const {
#if EPI_BATCH
        const float* gp0 = gate + (size_t)((u.pm * 256) >> 13) * 6144 + u.pn * 256 + wc * 32 + 8 * fq;
        f32x4 gg[2][2];
#pragma unroll
        for (int bj = 0; bj < 2; ++bj) { gg[bj][0] = *(const f32x4*)(gp0 + bj * 128); gg[bj][1] = *(const f32x4*)(gp0 + bj * 128 + 4); }
        EPI_HALVES {
            if (XOLD_F32) {
                f32x4 x0[8], x1[8];
                EPI_CHUNKS { EPI_RC const float* xp = (const float*)xold + (size_t)row * 2048 + col; x0[ci] = *(const f32x4*)xp; x1[ci] = *(const f32x4*)(xp + 4); }
#pragma unroll
                for (int c8 = 0; c8 < 8; ++c8) { asm volatile("" : "+v"(x0[c8])); asm volatile("" : "+v"(x1[c8])); }
                EPI_CHUNKS { EPI_RC const f32x4 v0 = acc[ai][bj][m][0], v1 = acc[ai][bj][m][1];
                    *(u32x4*)(xnew + (size_t)row * 2048 + col) = pack8(x0[ci] + gg[bj][0] * v0, x1[ci] + gg[bj][1] * v1); }
            } else {
                u32x4 xw[8];
                EPI_CHUNKS { EPI_RC xw[ci] = *(const u32x4*)((const bf16*)xold + (size_t)row * 2048 + col); }
#pragma unroll
                for (int c8 = 0; c8 < 8; ++c8) asm volatile("" : "+v"(xw[c8]));
                EPI_CHUNKS { EPI_RC const f32x4 v0 = acc[ai][bj][m][0], v1 = acc[ai][bj][m][1]; const u32x4 w = xw[ci];
                    const f32x4 x0 = {bflo(w.x), bfhi(w.x), bflo(w.y), bfhi(w.y)}, x1 = {bflo(w.z), bfhi(w.z), bflo(w.w), bfhi(w.w)};
                    *(u32x4*)(xnew + (size_t)row * 2048 + col) = pack8(x0 + gg[bj][0] * v0, x1 + gg[bj][1] * v1); }
            }
        }
#else
        EPI_ROWS_BEGIN
            const float* gp = gate + (size_t)(row >> 13) * 6144 + col;
            const f32x4 g0 = *(const f32x4*)gp, g1 = *(const f32x4*)(gp + 4);
            f32x4 x0, x1;
            if (XOLD_F32) { const float* xp = (const float*)xold + (size_t)row * 2048 + col; x0 = *(const f32x4*)xp; x1 = *(const f32x4*)(xp + 4); }
            else { const u32x4 w = *(const u32x4*)((const bf16*)xold + (size_t)row * 2048 + col); x0 = (f32x4){bflo(w.x), bfhi(w.x), bflo(w.y), bfhi(w.y)}; x1 = (f32x4){bflo(w.z), bfhi(w.z), bflo(w.w), bfhi(w.w)}; }
            *(u32x4*)(xnew + (size_t)row * 2048 + col) = pack8(x0 + g0 * v0, x1 + g1 * v1);
        EPI_ROWS_END
#endif
    }
};
#ifndef QNT
#define QNT 0
#endif
struct EpiPlain {
    static constexpr bool PERM = true, AFTER_DRAIN = false;
    bf16* out; int ld;
    __device__ __forceinline__ void operator()(const f32x4 (&acc)[2][2][4][2], const pg8::Unit& u, int wr, int wc, int fr, int fq) const {
        EPI_ROWS_BEGIN
#if QNT
            __builtin_nontemporal_store(pack8(v0, v1), (u32x4*)(out + (size_t)row * ld + col));
#else
            *(u32x4*)(out + (size_t)row * ld + col) = pack8(v0, v1);
#endif
        EPI_ROWS_END
    }
};
struct EpiCmp1 {
    static constexpr bool PERM = true, AFTER_DRAIN = false;
    bf16* hid; const float* bias1;
    __device__ __forceinline__ void operator()(const f32x4 (&acc)[2][2][4][2], const pg8::Unit& u, int wr, int wc, int fr, int fq) const {
        EPI_ROWS_BEGIN
            const int c = col & 255; const float* bp = bias1 + u.pn * 256 + c;
            const f32x4 b0 = *(const f32x4*)bp, b1 = *(const f32x4*)(bp + 4);
            v0 = v0 + b0; v1 = v1 + b1;
            v0.x = gelu_tanh(v0.x); v0.y = gelu_tanh(v0.y); v0.z = gelu_tanh(v0.z); v0.w = gelu_tanh(v0.w);
            v1.x = gelu_tanh(v1.x); v1.y = gelu_tanh(v1.y); v1.z = gelu_tanh(v1.z); v1.w = gelu_tanh(v1.w);
            *(u32x4*)(hid + (size_t)row * 256 + c) = pack8(v0, v1);
        EPI_ROWS_END
    }
};
struct EpiCmp2 {
    static constexpr bool PERM = true, AFTER_DRAIN = false;
    bf16* kcmp; bf16* vcmp; const f32x2* tab128;
    __device__ __forceinline__ void operator()(const f32x4 (&acc)[2][2][4][2], const pg8::Unit& u, int wr, int wc, int fr, int fq) const {
        EPI_ROWS_BEGIN
            const int c = col & 255;
            if (c < 128) {
                const int r = row & 2047;
                if (u.pn == 0) { int pos = 16 * (r & 511) + 31; pos = pos > SEQ - 1 ? SEQ - 1 : pos; rope8(v0, v1, tab128 + (size_t)pos * 64 + (c >> 1)); }
                *(u32x4*)((u.pn == 0 ? kcmp : vcmp) + (size_t)r * 128 + c) = pack8(v0, v1);
            }
        EPI_ROWS_END
    }
};
struct CmpOrder {
    int c;
    __device__ __forceinline__ bool next(int i, pg8::Unit& u) const { if (i > 0 || c >= 16) return false; u.pm = c; u.pn = c >> 3; return true; }
    __device__ __forceinline__ void a_ready(const pg8::Unit&) const {}
    __device__ __forceinline__ void done(const pg8::Unit&) const {}
};

__device__ __forceinline__ int crow(int r, int hi) { return (r & 3) + 8 * (r >> 2) + 4 * hi; }
__device__ __forceinline__ float max3f(float a, float b, float c) { float r; asm("v_max3_f32 %0, %1, %2, %3" : "=v"(r) : "v"(a), "v"(b), "v"(c)); return r; }
__device__ __forceinline__ float max2f(float a, float b) { float r; asm("v_max_f32_e32 %0, %1, %2" : "=v"(r) : "v"(a), "v"(b)); return r; }
#ifndef QK_INIT
#define QK_INIT 1
#endif
constexpr float RESCALE_THR = 8.0f;
typedef short v4i16_t __attribute__((ext_vector_type(4)));

template <int DQK, int DV> struct AT {
    static constexpr int KP = DQK + 8, VP = DV + 32;
    static constexpr int KBYTES = 64 * KP * 2, VBYTES = 64 * VP * 2;
    static constexpr int KCH = 64 * DQK / 8 / NTHREADS, VCH = 64 * DV / 8 / NTHREADS;
    static constexpr int KOFF = 0, VOFF = KBYTES;
    static constexpr int BYTES = KBYTES + VBYTES;
};

template <int DX, int NCH>
__device__ __forceinline__ void tile_load(u32x4 (&reg)[NCH], const bf16* g, int pitch, int key0, int kmax, int tid) {
    asm volatile("" : "+v"(tid));
#pragma unroll
    for (int i = 0; i < NCH; ++i) {
        const int id = tid + NTHREADS * i, row = id / (DX / 8), ch = id % (DX / 8);
        int key = key0 + row; key = key < 0 ? 0 : (key > kmax ? kmax : key);
        reg[i] = *(const u32x4*)(g + (size_t)key * pitch + ch * 8);
    }
}
template <int DX, int NCH, int PITCH = DX + 8>
__device__ __forceinline__ void tile_store(const u32x4 (&reg)[NCH], LAS unsigned char* l, int tid) {
    asm volatile("" : "+v"(tid));
#pragma unroll
    for (int i = 0; i < NCH; ++i) {
        const int id = tid + NTHREADS * i, row = id / (DX / 8), ch = id % (DX / 8);
        *(LAS u32x4*)(l + (row * PITCH + ch * 8) * 2) = reg[i];
    }
}
__device__ __forceinline__ void glds16(const void* gsrc, unsigned lds_dst) { unsigned keep;
    asm volatile("s_mov_b32 %0, m0\n\ts_mov_b32 m0, %2\n\ts_nop 0\n\tglobal_load_lds_dwordx4 %1, off\n\ts_mov_b32 m0, %0" : "=&s"(keep) : "v"(gsrc), "s"(lds_dst) : "memory"); }
template <int PITCH> struct DmaN { static constexpr int CPR = PITCH / 8, NI = 64 * CPR / 64, NIW = (NI + 7) / 8; static_assert((64 * PITCH * 2) % 1024 == 0, "tile image must be whole 1 KiB pieces"); };
template <int DX, int PITCH>
__device__ __forceinline__ void tile_dma(const bf16* g, int pitch, int key0, int kmax, unsigned lds_tile, unsigned lds_dump, int wave, int lane) {
    typedef DmaN<PITCH> D;
#pragma unroll
    for (int j = 0; j < D::NIW; ++j) {
        const int idx = j * 8 + wave; const bool ok = idx < D::NI;
        const int gch = (ok ? idx : 0) * 64 + lane, row = gch / D::CPR, ch = gch % D::CPR;
        int key = key0 + row; key = key < 0 ? 0 : (key > kmax ? kmax : key);
        const bf16* src = g + (size_t)key * pitch + (ch < DX / 8 ? ch : 0) * 8;
        glds16(src, (unsigned)__builtin_amdgcn_readfirstlane((int)(ok ? lds_tile + (unsigned)idx * 1024u : lds_dump)));
    }
}
template <int N> __device__ __forceinline__ void wait_bar() { asm volatile("s_waitcnt vmcnt(%0) lgkmcnt(0)\n\ts_barrier" :: "i"(N) : "memory"); }
__device__ __forceinline__ unsigned lds_addr(const LAS unsigned char* p) { return (unsigned)(__UINTPTR_TYPE__)p; }
template <int DQK, bool QL = false>
__device__ __forceinline__ void qk_tile(const LAS unsigned char* kl, const bf16x8 (&qf)[QL ? 1 : DQK / 16], f32x16& s0, f32x16& s1, int lane, const LAS unsigned char* ql = nullptr, float init = 0.f) {
    const int r32 = lane & 31, hi = lane >> 5;
    const LAS unsigned char* p = kl + (r32 * (DQK + 8) + hi * 8) * 2;
#pragma unroll
    for (int i = 0; i < 16; ++i) { s0[i] = init; s1[i] = init; }
#pragma unroll
    for (int sg = 0; sg < DQK / 64; ++sg) {
        bf16x8 a0[4], a1[4];
#pragma unroll
        for (int st = 0; st < 4; ++st) { a0[st] = *(const LAS bf16x8*)(p + (sg * 4 + st) * 32); a1[st] = *(const LAS bf16x8*)(p + 32 * (DQK + 8) * 2 + (sg * 4 + st) * 32); }
        __builtin_amdgcn_s_setprio(1);
#pragma unroll
        for (int st = 0; st < 4; ++st) {
            const bf16x8 qv = QL ? *(const LAS bf16x8*)(ql + (sg * 4 + st) * 32) : qf[QL ? 0 : sg * 4 + st];
            s0 = __builtin_amdgcn_mfma_f32_32x32x16_bf16(a0[st], qv, s0, 0, 0, 0);
            s1 = __builtin_amdgcn_mfma_f32_32x32x16_bf16(a1[st], qv, s1, 0, 0, 0);
        }
        __builtin_amdgcn_s_setprio(0);
        if (DQK > 64) __builtin_amdgcn_sched_barrier(0);
    }
}
__device__ __forceinline__ bf16x8 pfrag(const f32x16& p, int s) {
    u32x4 w; w.x = cvtpk(p[8 * s + 0], p[8 * s + 1]); w.y = cvtpk(p[8 * s + 2], p[8 * s + 3]); w.z = cvtpk(p[8 * s + 4], p[8 * s + 5]); w.w = cvtpk(p[8 * s + 6], p[8 * s + 7]);
    return __builtin_bit_cast(bf16x8, w);
}
template <int DV>
__device__ __forceinline__ void pv_tile(const LAS unsigned char* vl, const f32x16& p0, const f32x16& p1, f32x16 (&O)[DV / 32], int lane) {
    const int hi = lane >> 5, g1 = (lane >> 4) & 1, i = lane & 15, q = i >> 2, pp = i & 3;
    const LAS unsigned char* vb = vl + ((4 * hi + q) * (DV + 32) + 16 * g1 + 4 * pp) * 2;
    v4i16_t lo[2][DV / 32], hh[2][DV / 32];
#pragma unroll
    for (int dt = 0; dt < DV / 32; ++dt) { lo[0][dt] = __builtin_amdgcn_ds_read_tr16_b64_v4i16((LAS v4i16_t*)(vb + dt * 64)); hh[0][dt] = __builtin_amdgcn_ds_read_tr16_b64_v4i16((LAS v4i16_t*)(vb + dt * 64 + 8 * (DV + 32) * 2)); }
#pragma unroll
    for (int ks = 0; ks < 4; ++ks) {
        const bf16x8 pf = pfrag((ks & 2) ? p1 : p0, ks & 1);
        if (ks < 3) {
#pragma unroll
            for (int dt = 0; dt < DV / 32; ++dt) { const LAS unsigned char* a = vb + (16 * (ks + 1)) * (DV + 32) * 2 + dt * 64;
                lo[(ks + 1) & 1][dt] = __builtin_amdgcn_ds_read_tr16_b64_v4i16((LAS v4i16_t*)a); hh[(ks + 1) & 1][dt] = __builtin_amdgcn_ds_read_tr16_b64_v4i16((LAS v4i16_t*)(a + 8 * (DV + 32) * 2)); }
        }
        __builtin_amdgcn_s_setprio(1);
#pragma unroll
        for (int dt = 0; dt < DV / 32; ++dt) {
            const bf16x8 vf = __builtin_shufflevector(lo[ks & 1][dt], hh[ks & 1][dt], 0, 1, 2, 3, 4, 5, 6, 7);
            O[dt] = __builtin_amdgcn_mfma_f32_32x32x16_bf16(vf, pf, O[dt], 0, 0, 0);
        }
        __builtin_amdgcn_s_setprio(0);
        __builtin_amdgcn_sched_barrier(0);
    }
}
struct MaskCausal { int tpos; __device__ __forceinline__ bool full(int k0, bool) const { return k0 + 63 <= tpos; } __device__ __forceinline__ bool prep(int k0) const { return k0 <= tpos; } __device__ __forceinline__ bool valid(int k, bool) const { return k <= tpos; } };
struct MaskWindow { int tpos, w; __device__ __forceinline__ bool full(int k0, bool) const { return k0 + 63 <= tpos && k0 > tpos - w; } __device__ __forceinline__ bool prep(int k0) const { return k0 <= tpos && k0 + 63 > tpos - w; } __device__ __forceinline__ bool valid(int k, bool) const { return k <= tpos && k > tpos - w; } };
struct MaskCmp { int cmax; __device__ __forceinline__ bool full(int k0, bool) const { return k0 + 63 <= cmax; } __device__ __forceinline__ bool prep(int k0) const { return k0 <= cmax; } __device__ __forceinline__ bool valid(int k, bool) const { return k <= cmax; } };
struct MaskSel { int tpos; unsigned long long lo, hi2;
    __device__ __forceinline__ bool prep(int k0) const { const int j = k0 >> 6; return k0 <= tpos && (((j < 64 ? (lo >> j) : (hi2 >> (j - 64))) & 1ull) != 0ull); }
    __device__ __forceinline__ bool full(int k0, bool act) const { return act && k0 + 63 <= tpos; }
    __device__ __forceinline__ bool valid(int k, bool act) const { return act && k <= tpos; } };

template <class M> __device__ __forceinline__ float mask_tile(f32x16& s0, f32x16& s1, int key0, const M& mk, bool act, int lane) {
    const int hi = lane >> 5; float mx = -INFINITY;
    if (__all(mk.full(key0, act))) {
#pragma unroll
        for (int r = 0; r < 16; ++r) mx = max3f(mx, s0[r], s1[r]);
        return mx;
    }
#pragma unroll
    for (int r = 0; r < 16; ++r) {
        const int k = key0 + crow(r, hi);
        s0[r] = mk.valid(k, act) ? s0[r] : -INFINITY; s1[r] = mk.valid(k + 32, act) ? s1[r] : -INFINITY;
        mx = max3f(mx, s0[r], s1[r]);
    }
    return mx;
}
template <int DV> __device__ __forceinline__ void online_update(f32x16& s0, f32x16& s1, float mx, float& m, float& l, f32x16 (&O)[DV / 32], float c = 0.f) {
    mx = max32(mx) - c;
    const float mn = (mx - m > RESCALE_THR) ? mx : m, alpha = __builtin_amdgcn_exp2f(m - mn);
    const float d = mn + c;
    if (__any(d != 0.f)) {
#pragma unroll
        for (int r = 0; r < 16; ++r) { s0[r] -= d; s1[r] -= d; }
    }
    float ps = 0.f;
#pragma unroll
    for (int r = 0; r < 16; ++r) { s0[r] = __builtin_amdgcn_exp2f(s0[r]); s1[r] = __builtin_amdgcn_exp2f(s1[r]); ps += s0[r] + s1[r]; }
    l = l * alpha + ps; m = mn;
    if (__any(alpha != 1.f)) {
#pragma unroll
        for (int dt = 0; dt < DV / 32; ++dt)
#pragma unroll
            for (int r = 0; r < 16; ++r) O[dt][r] *= alpha;
    }
}

template <int DQK, bool QL>
__device__ __forceinline__ void qk_half(const LAS unsigned char* kl, const bf16x8 (&qf)[QL ? 1 : DQK / 16], f32x16& s, int kt, int lane, const LAS unsigned char* ql) {
    const int r32 = lane & 31, hi = lane >> 5;
    const LAS unsigned char* p = kl + ((kt * 32 + r32) * (DQK + 8) + hi * 8) * 2;
#pragma unroll
    for (int i = 0; i < 16; ++i) s[i] = 0.f;
#pragma unroll
    for (int sg = 0; sg < DQK / 64; ++sg) {
        bf16x8 a0[4];
#pragma unroll
        for (int st = 0; st < 4; ++st) a0[st] = *(const LAS bf16x8*)(p + (sg * 4 + st) * 32);
        __builtin_amdgcn_s_setprio(1);
#pragma unroll
        for (int st = 0; st < 4; ++st) { const bf16x8 qv = QL ? *(const LAS bf16x8*)(ql + (sg * 4 + st) * 32) : qf[QL ? 0 : sg * 4 + st]; s = __builtin_amdgcn_mfma_f32_32x32x16_bf16(a0[st], qv, s, 0, 0, 0); }
        __builtin_amdgcn_s_setprio(0);
        if (DQK > 64) __builtin_amdgcn_sched_barrier(0);
    }
}
template <class M> __device__ __forceinline__ float mask_half(f32x16& s, int key0, const M& mk, bool act, int lane, bool allfull) {
    const int hi = lane >> 5; float mx = -INFINITY;
    if (allfull) {
#pragma unroll
        for (int r = 0; r < 16; r += 2) mx = max3f(mx, s[r], s[r + 1]);
        return mx;
    }
#pragma unroll
    for (int r = 0; r < 16; ++r) { const int k = key0 + crow(r, hi); s[r] = mk.valid(k, act) ? s[r] : -INFINITY; mx = fmaxf(mx, s[r]); }
    return mx;
}
template <int DV> __device__ __forceinline__ void online_half(f32x16& s, float mx, float& m, float& l, f32x16 (&O)[DV / 32]) {
    mx = max32(mx);
    const float mn = (mx - m > RESCALE_THR) ? mx : m, alpha = __builtin_amdgcn_exp2f(m - mn);
    float ps = 0.f;
#pragma unroll
    for (int r = 0; r < 16; ++r) { s[r] = __builtin_amdgcn_exp2f(s[r] - mn); ps += s[r]; }
    l = l * alpha + ps; m = mn;
    if (__any(alpha != 1.f)) {
#pragma unroll
        for (int dt = 0; dt < DV / 32; ++dt)
#pragma unroll
            for (int r = 0; r < 16; ++r) O[dt][r] *= alpha;
    }
}
template <int DV>
__device__ __forceinline__ void pv_half(const LAS unsigned char* vl, const f32x16& p, int kt, f32x16 (&O)[DV / 32], int lane) {
    const int hi = lane >> 5, g1 = (lane >> 4) & 1, i = lane & 15, q = i >> 2, pp = i & 3;
    const LAS unsigned char* vb = vl + ((kt * 32 + 4 * hi + q) * (DV + 32) + 16 * g1 + 4 * pp) * 2;
#pragma unroll
    for (int ks = 0; ks < 2; ++ks) {
        const bf16x8 pf = pfrag(p, ks);
        v4i16_t lo[DV / 32], hh[DV / 32];
#pragma unroll
        for (int dt = 0; dt < DV / 32; ++dt) { const LAS unsigned char* a = vb + (16 * ks) * (DV + 32) * 2 + dt * 64;
            lo[dt] = __builtin_amdgcn_ds_read_tr16_b64_v4i16((LAS v4i16_t*)a); hh[dt] = __builtin_amdgcn_ds_read_tr16_b64_v4i16((LAS v4i16_t*)(a + 8 * (DV + 32) * 2)); }
        __builtin_amdgcn_s_setprio(1);
#pragma unroll
        for (int dt = 0; dt < DV / 32; ++dt) { const bf16x8 vf = __builtin_shufflevector(lo[dt], hh[dt], 0, 1, 2, 3, 4, 5, 6, 7); O[dt] = __builtin_amdgcn_mfma_f32_32x32x16_bf16(vf, pf, O[dt], 0, 0, 0); }
        __builtin_amdgcn_s_setprio(0);
        if (DV > 64) __builtin_amdgcn_sched_barrier(0);
    }
}
template <int DQK, int DV, class M, bool SPLIT = false, int TPS = 1, int NSLOT = 3>
__device__ __forceinline__ void attn_run(LAS unsigned char* lds, const bf16* Kg, int kpitch, const bf16* Vg, int vpitch, int kmax, int t_lo, int t_hi,
                                         const bf16x8 (&qf)[DQK / 16], f32x16 (&O)[DV / 32], float& m, float& l, const M& mk) {
    typedef AT<DQK, DV> A;
    constexpr int NT = (DmaN<A::KP>::NIW + DmaN<A::VP>::NIW) * TPS;
    constexpr int SB = A::BYTES * TPS;
    const int tid = threadIdx.x, lane = tid & 63, wave = __builtin_amdgcn_readfirstlane(tid >> 6);
    if (t_lo >= t_hi) return;
    const int ns = (t_hi - t_lo + TPS - 1) / TPS;
    const unsigned ring = lds_addr(lds), dump = ring + (unsigned)(NSLOT * SB);
#define ATT_DMA(st, slot) do { _Pragma("unroll 1") for (int u_ = 0; u_ < TPS; ++u_) { const int tt_ = t_lo + (st) * TPS + u_; \
        tile_dma<DQK, A::KP>(Kg, kpitch, tt_ * 64, kmax, ring + (unsigned)(slot) * SB + u_ * A::BYTES + A::KOFF, dump, wave, lane); \
        tile_dma<DV, A::VP>(Vg, vpitch, tt_ * 64, kmax, ring + (unsigned)(slot) * SB + u_ * A::BYTES + A::VOFF, dump, wave, lane); } } while (0)
    ATT_DMA(0, 0);
    if (NSLOT == 3) { if (1 < ns) { ATT_DMA(1, 1); wait_bar<NT>(); } else wait_bar<0>(); }
    else wait_bar<0>();
    int slot = 0;
#pragma unroll 1
    for (int s = 0; s < ns; ++s) {
        const int sn = (slot == 0) ? NSLOT - 1 : slot - 1;
        if (s + NSLOT - 1 < ns) ATT_DMA(s + NSLOT - 1, sn);
#pragma unroll 1
        for (int u = 0; u < TPS; ++u) {
            const int t = t_lo + s * TPS + u;
            LAS unsigned char* cur = lds + slot * SB + u * A::BYTES;
            const bool act = (t < t_hi) && mk.prep(t * 64);
            if (__any(act)) {
                if (SPLIT) {
                    const bool allfull = __all(mk.full(t * 64, act));
#pragma unroll
                    for (int kt = 0; kt < 2; ++kt) {
                        f32x16 sh;
                        qk_half<DQK, false>(cur + A::KOFF, qf, sh, kt, lane, nullptr);
                        const float mx = mask_half(sh, t * 64 + kt * 32, mk, act, lane, allfull);
                        online_half<DV>(sh, mx, m, l, O);
                        pv_half<DV>(cur + A::VOFF, sh, kt, O, lane);
                    }
                } else {
                    f32x16 s0, s1;
                    const float cinit = QK_INIT ? ((m > 0.5f * NEG_BIG) ? -m : 0.f) : 0.f;
                    qk_tile<DQK, false>(cur + A::KOFF, qf, s0, s1, lane, nullptr, cinit);
                    const float mx = mask_tile(s0, s1, t * 64, mk, act, lane);
                    online_update<DV>(s0, s1, mx, m, l, O, cinit);
                    pv_tile<DV>(cur + A::VOFF, s0, s1, O, lane);
                }
            }
        }
        if (NSLOT == 3 && s + 2 < ns) wait_bar<NT>(); else wait_bar<0>();
        slot = (slot == NSLOT - 1) ? 0 : slot + 1;
    }
#undef ATT_DMA
}
template <int DQK> __device__ __forceinline__ void load_q(bf16x8 (&qf)[DQK / 16], const bf16* qrow, int lane) {
    const int hi = lane >> 5;
#pragma unroll
    for (int st = 0; st < DQK / 16; ++st) qf[st] = *(const bf16x8*)(qrow + st * 16 + hi * 8);
#pragma unroll
    for (int st = 0; st < DQK / 16; ++st) asm volatile("" : "+v"(qf[st]));
}
#ifndef DA_TPS
#define DA_TPS 2
#define DA_NSLOT 2
#endif

__device__ __forceinline__ void da_unit(LAS unsigned char* lds, const bf16* qkv, bf16* att, int b, int h, int qb, float lam, const float* subln, float* slotbase) {
    const int tid = threadIdx.x, lane = tid & 63, wave = __builtin_amdgcn_readfirstlane(tid >> 6), r32 = lane & 31, hi = lane >> 5;
    const int tpos = qb * 256 + wave * 32 + r32; const size_t row = (size_t)b * SEQ + tpos;
    unsigned o0p[32];
    const bf16* base = qkv + (size_t)b * SEQ * 4608;
    f32x16 O[4]; float ss = 0.f;
#pragma unroll 1
    for (int map = 0; map < 2; ++map) {
        bf16x8 qf[4]; load_q<64>(qf, qkv + row * 4608 + map * 512 + h * 64, lane);
#pragma unroll
        for (int dt = 0; dt < 4; ++dt)
#pragma unroll
            for (int r = 0; r < 16; ++r) O[dt][r] = 0.f;
        float m = NEG_BIG, l = 0.f;
        attn_run<64, 128, MaskCausal, false, DA_TPS, DA_NSLOT>(lds, base + 1024 + map * 512 + h * 64, 4608, base + 2048 + h * 128, 4608, SEQ - 1, 0, 4 * (qb + 1), qf, O, m, l, MaskCausal{tpos});
        const float inv = 1.f / sum32(l);
        if (map == 0) {
#pragma unroll
            for (int dt = 0; dt < 4; ++dt)
#pragma unroll
                for (int r = 0; r < 16; r += 2) o0p[dt * 8 + (r >> 1)] = cvtpk(O[dt][r] * inv, O[dt][r + 1] * inv);
        } else {
#pragma unroll
            for (int dt = 0; dt < 4; ++dt)
#pragma unroll
                for (int r = 0; r < 16; r += 2) { const unsigned w = o0p[dt * 8 + (r >> 1)];
                    const float oa = bflo(w) - lam * (O[dt][r] * inv), ob = bfhi(w) - lam * (O[dt][r + 1] * inv); O[dt][r] = oa; O[dt][r + 1] = ob; ss += oa * oa + ob * ob; }
        }
    }
    const float rn = 1.0f / sqrtf(sum32(ss) * (1.f / 128.f) + NORM_EPS) * 0.8f;
    bf16* orow = att + row * 2048 + h * 128;
#pragma unroll
    for (int dt = 0; dt < 4; ++dt)
#pragma unroll
        for (int g4 = 0; g4 < 4; ++g4) {
            const int d = dt * 32 + 8 * g4 + 4 * hi; const f32x4 sg = *(const f32x4*)(subln + d);
            u32x2 w; w.x = cvtpk(O[dt][4 * g4] * rn * sg.x, O[dt][4 * g4 + 1] * rn * sg.y); w.y = cvtpk(O[dt][4 * g4 + 2] * rn * sg.z, O[dt][4 * g4 + 3] * rn * sg.w);
            *(u32x2*)(orow + d) = w;
        }
}
__device__ __forceinline__ void swa_unit(LAS unsigned char* lds, const bf16* qkv, bf16* att, int b, int kvh, int tb, const float* sinks) {
    const int tid = threadIdx.x, lane = tid & 63, wave = __builtin_amdgcn_readfirstlane(tid >> 6), c = lane & 31, hi = lane >> 5;
    const int t0 = tb * 64, tpos = t0 + wave * 8 + (c >> 2), qh = kvh * 4 + (c & 3); const size_t row = (size_t)b * SEQ + tpos;
    const bf16* base = qkv + (size_t)b * SEQ * 4608;
    bf16x8 qf[4]; load_q<64>(qf, qkv + row * 4608 + 3072 + qh * 64, lane);
    f32x16 O[2];
#pragma unroll
    for (int dt = 0; dt < 2; ++dt)
#pragma unroll
        for (int r = 0; r < 16; ++r) O[dt][r] = 0.f;
    float m = sinks[qh] * LOG2E, l = (hi == 0) ? 1.f : 0.f;
    asm volatile("" : "+v"(m));
    const int t_lo = tb >= 2 ? tb - 2 : 0;
    attn_run<64, 64, MaskWindow>(lds, base + 4096 + kvh * 64, 4608, base + 4352 + kvh * 64, 4608, SEQ - 1, t_lo, tb + 1, qf, O, m, l, MaskWindow{tpos, 128});
    const float inv = 1.f / sum32(l);
    bf16* orow = att + row * 2048 + 1024 + qh * 64;
#pragma unroll
    for (int dt = 0; dt < 2; ++dt)
#pragma unroll
        for (int g4 = 0; g4 < 4; ++g4) {
            const int d = dt * 32 + 8 * g4 + 4 * hi;
            u32x2 w; w.x = cvtpk(O[dt][4 * g4] * inv, O[dt][4 * g4 + 1] * inv); w.y = cvtpk(O[dt][4 * g4 + 2] * inv, O[dt][4 * g4 + 3] * inv);
            *(u32x2*)(orow + d) = w;
        }
}

__device__ __forceinline__ void swa_naive(const bf16* qkv, bf16* att, int b, int tpos, int qh, const float* sinks, int lane) {
    const size_t row = (size_t)b * SEQ + tpos; const int kvh = qh >> 2;
    const bf16* q = qkv + row * 4608 + 3072 + qh * 64;
    float sc[2];
#pragma unroll
    for (int j = 0; j < 2; ++j) {
        const int key = tpos - 127 + lane + 64 * j;
        float s = -INFINITY;
        if (key >= 0) { const bf16* k = qkv + ((size_t)b * SEQ + key) * 4608 + 4096 + kvh * 64; float a = 0.f; for (int d = 0; d < 64; ++d) a += bf2f(q[d]) * bf2f(k[d]); s = a; }
        sc[j] = s;
    }
    const float snk = sinks[qh] * LOG2E;
    float mx = fmaxf(fmaxf(sc[0], sc[1]), snk);
#pragma unroll
    for (int o = 1; o < 64; o <<= 1) mx = fmaxf(mx, __shfl_xor(mx, o));
    const float p0 = exp2f(sc[0] - mx), p1 = exp2f(sc[1] - mx);
    const float den = wave_sum(p0 + p1) + exp2f(snk - mx);
    float acc = 0.f;
    for (int kk = 0; kk < 128; ++kk) {
        const int key = tpos - 127 + kk; const float p = __shfl(kk < 64 ? p0 : p1, kk & 63);
        if (key >= 0) acc += p * bf2f(qkv[((size_t)b * SEQ + key) * 4608 + 4352 + kvh * 64 + lane]);
    }
    const float o = acc / den;
    att[row * 2048 + 1024 + qh * 64 + lane] = (bf16)(cvtpk(o, 0.f) & 0xffffu);
}

struct Args { const float* in[20]; float* out; unsigned char* ws; int ph_lo, ph_hi; };
typedef const __attribute__((address_space(4))) Args* KArgs;
__device__ __forceinline__ KArgs kargs() { KArgs p = (KArgs)__builtin_amdgcn_kernarg_segment_ptr(); asm volatile("" : "+s"(p)); return p; }

template <int CTRL> __device__ __forceinline__ float dppf(float v) { return __int_as_float(__builtin_amdgcn_update_dpp(0, __float_as_int(v), CTRL, 0xF, 0xF, false)); }
template <int CTRL> __device__ __forceinline__ unsigned dppu(unsigned v) { return (unsigned)__builtin_amdgcn_update_dpp(0, (int)v, CTRL, 0xF, 0xF, false); }
__device__ __forceinline__ float sum8(float v) { v += dppf<0xB1>(v); v += dppf<0x4E>(v); v += dppf<0x141>(v); return v; }
__device__ __forceinline__ unsigned wave_max_u32(unsigned v) {
    unsigned t;
    t = dppu<0xB1>(v); v = v > t ? v : t;
    t = dppu<0x4E>(v); v = v > t ? v : t;
    t = dppu<0x141>(v); v = v > t ? v : t;
    t = dppu<0x140>(v); v = v > t ? v : t;
    const unsigned a = __builtin_amdgcn_readlane(v, 0), b = __builtin_amdgcn_readlane(v, 16), c = __builtin_amdgcn_readlane(v, 32), d = __builtin_amdgcn_readlane(v, 48);
    const unsigned ab = a > b ? a : b, cd = c > d ? c : d;
    return ab > cd ? ab : cd;
}
__device__ __forceinline__ unsigned ordf(float f) { const unsigned u = __float_as_uint(f); return u ^ ((u >> 31) ? 0xFFFFFFFFu : 0x80000000u); }

#ifndef NSA_SPLIT
#define NSA_SPLIT false
#endif
#ifndef NSA_PROBE
#define NSA_PROBE 0
#endif
#ifndef CMP_INIT
#define CMP_INIT 1
#endif
constexpr int NSA_TILE = AT<128, 128>::BYTES;
constexpr int NSA_OUT = 2 * NSA_TILE + 1024;
constexpr int NSA_IMPA = NSA_OUT + 65536, NSA_IMPP = 132, NSA_SEL = NSA_IMPA + 32 * NSA_IMPP * 4;
static_assert(NSA_SEL + 512 <= LDS_BYTES && 3 * NSA_TILE + 1024 <= NSA_IMPA, "nsa lds map");

template <int PASS>
__device__ __forceinline__ void nsa_cmp_pass(LAS unsigned char* lds, const bf16* Kg, const bf16* Vg, int t_hi, const bf16x8 (&qf)[8], f32x16 (&O)[4], float& m, float& l, float invl, const MaskCmp& mk, int tl) {
    typedef AT<128, 128> A;
    constexpr int NT = DmaN<A::KP>::NIW + (PASS == 2 ? DmaN<A::VP>::NIW : 0);
    const int tid = threadIdx.x, lane = tid & 63, hi = lane >> 5, wave = __builtin_amdgcn_readfirstlane(tid >> 6);
    LAS float* impA = (LAS float*)(lds + NSA_IMPA);
    const unsigned ring = lds_addr(lds), dump = ring + 3u * A::BYTES;
#define CMP_DMA(t, slot) do { tile_dma<128, A::KP>(Kg, 128, (t) * 64, 511, ring + (unsigned)(slot) * A::BYTES + A::KOFF, dump, wave, lane); \
                              if (PASS == 2) tile_dma<128, A::VP>(Vg, 128, (t) * 64, 511, ring + (unsigned)(slot) * A::BYTES + A::VOFF, dump, wave, lane); } while (0)
    CMP_DMA(0, 0);
    if (1 < t_hi) { CMP_DMA(1, 1); wait_bar<NT>(); } else wait_bar<0>();
    float carry = 0.f;
    int slot = 0;
#pragma unroll 1
    for (int t = 0; t < t_hi; ++t) {
        LAS unsigned char* cur = lds + slot * A::BYTES;
        const int s2 = slot == 0 ? 2 : slot - 1;
        if (t + 2 < t_hi) CMP_DMA(t + 2, s2);
        const bool act = mk.prep(t * 64);
        if (__any(act)) {
            f32x16 s0, s1;
            const float cinit = (CMP_INIT && PASS == 2) ? ((invl > 0.f) ? __builtin_amdgcn_logf(invl) - m : -INFINITY) : 0.f;
            qk_tile<128, false>(cur + A::KOFF, qf, s0, s1, lane, nullptr, cinit);
            float mx = mask_tile(s0, s1, t * 64, mk, act, lane);
            if (PASS == 1) {
                mx = max32(mx);
                const float mn = fmaxf(m, mx), alpha = __builtin_amdgcn_exp2f(m - mn); float ps = 0.f;
#pragma unroll
                for (int r = 0; r < 16; ++r) ps += __builtin_amdgcn_exp2f(s0[r] - mn) + __builtin_amdgcn_exp2f(s1[r] - mn);
                l = l * alpha + ps; m = mn;
            } else {
#pragma unroll
                for (int r = 0; r < 16; ++r) {
                    if (CMP_INIT) { s0[r] = __builtin_amdgcn_exp2f(s0[r]); s1[r] = __builtin_amdgcn_exp2f(s1[r]); }
                    else { s0[r] = __builtin_amdgcn_exp2f(s0[r] - m) * invl; s1[r] = __builtin_amdgcn_exp2f(s1[r] - m) * invl; } }
#pragma unroll
                for (int kt = 0; kt < 2; ++kt) {
                    const f32x16& p = kt ? s1 : s0;
#pragma unroll
                    for (int g4 = 0; g4 < 4; ++g4) {
                        auto rr = __builtin_amdgcn_permlane32_swap(__float_as_uint(p[4 * g4 + 3]), __float_as_uint(p[4 * g4 + 3]), false, false);
                        const float prev = hi ? __uint_as_float(rr[0]) : carry;
                        carry = __uint_as_float(rr[1]);
                        float a = p[4 * g4] + p[4 * g4 + 1] + p[4 * g4 + 2] + 0.5f * (p[4 * g4 + 3] + prev);
                        a = sum8(a);
                        const int si = 16 * t + 8 * kt + 2 * g4 + hi;
                        if ((lane & 7) == 0) impA[tl * NSA_IMPP + si] = a;
                    }
                }
                pv_tile<128>(cur + A::VOFF, s0, s1, O, lane);
            }
        }
        if (t + 2 < t_hi) wait_bar<NT>(); else wait_bar<0>();
        slot = slot == 2 ? 0 : slot + 1;
    }
#undef CMP_DMA
}
__device__ __forceinline__ void nsa_window_unit(LAS unsigned char* lds, int b, int kvh, int tb) {
#define ws (kargs()->ws)
    const int tid = threadIdx.x, lane = tid & 63, wave = __builtin_amdgcn_readfirstlane(tid >> 6), c = lane & 31, hi = lane >> 5;
    const int t0 = tb * 32, tl = wave * 4 + (c >> 3), tok = t0 + tl, qh = kvh * 8 + (c & 7); const size_t row = (size_t)b * SEQ + tok;
    __syncthreads();
    bf16x8 qf[8]; load_q<128>(qf, (const bf16*)(ws + WS_Q1) + row * 2048 + qh * 128, lane);
    f32x16 O[4];
#pragma unroll
    for (int dt = 0; dt < 4; ++dt)
#pragma unroll
        for (int r = 0; r < 16; ++r) O[dt][r] = 0.f;
    float m = NEG_BIG, l = 0.f;
    const MaskWindow mk{tok, 512};
    const bf16* Kg = (const bf16*)(ws + WS_KW) + (size_t)b * SEQ * 256 + kvh * 128; const bf16* Vg = (const bf16*)(ws + WS_VW) + (size_t)b * SEQ * 256 + kvh * 128;
    const int t_lo = t0 >= 511 ? ((t0 - 511) >> 6) : 0;
    attn_run<128, 128, MaskWindow, NSA_SPLIT, 1, 2>(lds, Kg, 256, Vg, 256, SEQ - 1, t_lo, ((t0 + 31) >> 6) + 1, qf, O, m, l, mk);
    l = sum32(l);
    const float sc = ((const float*)(ws + WS_GATES))[row * 48 + 2 * 16 + qh] / l;
    bf16* orow = (bf16*)(ws + WS_ATT) + row * 2048 + qh * 128;
#pragma unroll
    for (int dt = 0; dt < 4; ++dt)
#pragma unroll
        for (int g4 = 0; g4 < 4; ++g4) {
            u32x2 w; w.x = cvtpk(sc * O[dt][4 * g4], sc * O[dt][4 * g4 + 1]); w.y = cvtpk(sc * O[dt][4 * g4 + 2], sc * O[dt][4 * g4 + 3]);
            *(u32x2*)(orow + dt * 32 + 8 * g4 + 4 * hi) = w;
        }
#undef ws
}
__device__ __forceinline__ void nsa_unit(LAS unsigned char* lds, int b, int kvh, int tb) {
#define ws (kargs()->ws)
    const int tid = threadIdx.x, lane = tid & 63, wave = __builtin_amdgcn_readfirstlane(tid >> 6), c = lane & 31, hi = lane >> 5;
    const int t0 = tb * 32, tl = wave * 4 + (c >> 3), tok = t0 + tl, qh = kvh * 8 + (c & 7); const size_t row = (size_t)b * SEQ + tok;
    LAS float* impA = (LAS float*)(lds + NSA_IMPA);
    LAS unsigned long long* selm = (LAS unsigned long long*)(lds + NSA_SEL);
    LAS unsigned* outl = (LAS unsigned*)(lds + NSA_OUT) + wave * 2048;

#define NSA_SLOT ((float*)(ws + WS_SLOT) + ((size_t)blockIdx.x * NWAVES + wave) * 4096)
#define NSA_GATE(br) (((const float*)(ws + WS_GATES))[((size_t)b * SEQ + t0 + wave * 4 + (c >> 3)) * 48 + (br) * 16 + kvh * 8 + (c & 7)])
    __syncthreads();
    bf16x8 qf[8]; load_q<128>(qf, (const bf16*)(ws + WS_Q1) + row * 2048 + qh * 128, lane);
    for (int i = tid; i < 32 * NSA_IMPP; i += NTHREADS) impA[i] = 0.f;
    f32x16 O[4];
    {
        const bf16* Kc = (const bf16*)(ws + WS_KCMP) + (size_t)(b * 2 + kvh) * 512 * 128; const bf16* Vc = (const bf16*)(ws + WS_VCMP) + (size_t)(b * 2 + kvh) * 512 * 128;
        const MaskCmp mk{(tok - 31) >> 4};
        const int t_hi = ((2 * tb) >> 6) + 1;
        float m = NEG_BIG, l = 0.f;
#if NSA_PROBE == 3
        { nsa_cmp_pass<1>(lds, Kc, Vc, t_hi, qf, O, m, l, 0.f, mk, tl); float l2 = sum32(l); const float iv = l2 > 0.f ? 1.f / l2 : 0.f;
#pragma unroll
          for (int dt = 0; dt < 4; ++dt)
#pragma unroll
            for (int r = 0; r < 16; ++r) O[dt][r] = 0.f;
          nsa_cmp_pass<2>(lds, Kc, Vc, t_hi, qf, O, m, l, iv, mk, tl);
#pragma unroll
          for (int dt = 0; dt < 4; ++dt) asm volatile("" :: "v"(O[dt]));
          m = NEG_BIG; l = 0.f; }
#endif
        nsa_cmp_pass<1>(lds, Kc, Vc, t_hi, qf, O, m, l, 0.f, mk, tl);
        l = sum32(l); const float invl = l > 0.f ? 1.f / l : 0.f;
#pragma unroll
        for (int dt = 0; dt < 4; ++dt)
#pragma unroll
            for (int r = 0; r < 16; ++r) O[dt][r] = 0.f;
        nsa_cmp_pass<2>(lds, Kc, Vc, t_hi, qf, O, m, l, invl, mk, tl);
        const float g0 = NSA_GATE(0);
#pragma unroll
        for (int dt = 0; dt < 4; ++dt)
#pragma unroll
            for (int r = 0; r < 16; r += 2) outl[(dt * 8 + (r >> 1)) * 64 + lane] = cvtpk(g0 * O[dt][r], g0 * O[dt][r + 1]);
    }
    asm volatile("s_waitcnt lgkmcnt(0)" ::: "memory");
    {
        const int rw = lane >> 4, li = lane & 15, tlj = wave * 4 + rw, cur = t0 >> 6;
        unsigned selb = 0u;
        if (cur < 16) {
#pragma unroll
            for (int k = 0; k < 8; ++k) selb |= (li * 8 + k <= cur) ? (1u << k) : 0u;
        } else {
            unsigned kk[8];
            { const f32x4 x0 = *(const LAS f32x4*)(impA + tlj * NSA_IMPP + li * 8), x1 = *(const LAS f32x4*)(impA + tlj * NSA_IMPP + li * 8 + 4);
#pragma unroll
              for (int k = 0; k < 8; ++k) { const int s = li * 8 + k; const float v = k < 4 ? x0[k & 3] : x1[k & 3];
                  const bool forced = (s == 0) || (s == cur) || (s == cur - 1);
                  kk[k] = (s > cur) ? 0u : ((forced ? 0xFFFFFF80u : (ordf(v) & 0xFFFFFF80u)) | (unsigned)(127 - s)); } }
#pragma unroll 1
            for (int r = 0; r < 16; ++r) {
                unsigned mk_ = kk[0];
#pragma unroll
                for (int k = 1; k < 8; ++k) mk_ = mk_ > kk[k] ? mk_ : kk[k];
                unsigned t;
                t = dppu<0xB1>(mk_); mk_ = mk_ > t ? mk_ : t; t = dppu<0x4E>(mk_); mk_ = mk_ > t ? mk_ : t; t = dppu<0x141>(mk_); mk_ = mk_ > t ? mk_ : t; t = dppu<0x140>(mk_); mk_ = mk_ > t ? mk_ : t;
#pragma unroll
                for (int k = 0; k < 8; ++k) { const bool hit = kk[k] == mk_; selb |= hit ? (1u << k) : 0u; kk[k] = hit ? 0u : kk[k]; }
            }
        }
        ((LAS unsigned char*)selm)[tlj * 16 + li] = (unsigned char)selb;
    }
    asm volatile("s_waitcnt lgkmcnt(0)" ::: "memory");
    {
        const MaskSel mk{tok, selm[tl * 2], selm[tl * 2 + 1]};
#pragma unroll
        for (int dt = 0; dt < 4; ++dt)
#pragma unroll
            for (int r = 0; r < 16; ++r) O[dt][r] = 0.f;
        float m = NEG_BIG, l = 0.f;
        const bf16* Kg = (const bf16*)(ws + WS_KSL) + (size_t)b * SEQ * 256 + kvh * 128; const bf16* Vg = (const bf16*)(ws + WS_VSL) + (size_t)b * SEQ * 256 + kvh * 128;
#if NSA_PROBE == 1
        { attn_run<128, 128, MaskSel, NSA_SPLIT, 1, 2>(lds, Kg, 256, Vg, 256, SEQ - 1, 0, ((t0 + 31) >> 6) + 1, qf, O, m, l, mk);
#pragma unroll
          for (int dt = 0; dt < 4; ++dt) { asm volatile("" :: "v"(O[dt]));
#pragma unroll
            for (int r = 0; r < 16; ++r) O[dt][r] = 0.f; }
          m = NEG_BIG; l = 0.f; }
#endif
        attn_run<128, 128, MaskSel, NSA_SPLIT, 1, 2>(lds, Kg, 256, Vg, 256, SEQ - 1, 0, ((t0 + 31) >> 6) + 1, qf, O, m, l, mk);
        l = sum32(l); const float sc = NSA_GATE(1) / l;
        bf16* orow = (bf16*)(ws + WS_ATT) + ((size_t)b * SEQ + t0 + wave * 4 + (c >> 3)) * 2048 + (kvh * 8 + (c & 7)) * 128;
#pragma unroll
        for (int dt = 0; dt < 4; ++dt)
#pragma unroll
            for (int g4 = 0; g4 < 4; ++g4) {
                const unsigned w0 = outl[(dt * 8 + 2 * g4) * 64 + lane], w1 = outl[(dt * 8 + 2 * g4 + 1) * 64 + lane];
                const u32x2 pw = *(const u32x2*)(orow + dt * 32 + 8 * g4 + 4 * hi);
                u32x2 w; w.x = cvtpk(bflo(w0) + bflo(pw.x) + sc * O[dt][4 * g4], bfhi(w0) + bfhi(pw.x) + sc * O[dt][4 * g4 + 1]);
                w.y = cvtpk(bflo(w1) + bflo(pw.y) + sc * O[dt][4 * g4 + 2], bfhi(w1) + bfhi(pw.y) + sc * O[dt][4 * g4 + 3]);
                *(u32x2*)(orow + dt * 32 + 8 * g4 + 4 * hi) = w;
            }
    }
#undef ws
}

#define XB_TMO      128
#define XB_XCNT(j)  (256  + 64 * (j))
#define XB_XSUB(j)  (1280 + 64 * (j))
#define XB_XGEN(j)  (2304 + 64 * (j))
#define XB_TOP      3328
#define XB_TOPGEN   3392
#define XCD_BAR_WORDS 3456
#define XB_SPIN_CAP (1u << 18)

__device__ __forceinline__ unsigned xb_ld(unsigned* p)              { return __hip_atomic_load(p, __ATOMIC_RELAXED, __HIP_MEMORY_SCOPE_AGENT); }
__device__ __forceinline__ unsigned xb_add(unsigned* p, unsigned v) { return __hip_atomic_fetch_add(p, v, __ATOMIC_RELAXED, __HIP_MEMORY_SCOPE_AGENT); }
__device__ __forceinline__ unsigned xb_xcc_id() { return (unsigned)__builtin_amdgcn_s_getreg((3 << 11) | 20) & 0xFu; }
#define XB_SPIN(cond, bar) do { unsigned _sp = 0; while (cond) { __builtin_amdgcn_s_sleep(1); \
    if ((++_sp & 255u) == 0u) { if (xb_ld(&(bar)[XB_TMO])) break; if (_sp > XB_SPIN_CAP) { atomicAdd(&(bar)[XB_TMO], 1u); break; } } } } while (0)

struct XcdBarrier {
    unsigned* bar; unsigned x;
    volatile unsigned* st;
};

__device__ __forceinline__ XcdBarrier xcd_barrier_post(unsigned* bar, volatile unsigned* st) {
    XcdBarrier b; b.bar = bar; b.x = xb_xcc_id(); b.st = st;
    if (threadIdx.x == 0) (void)xb_add(&bar[XB_XCNT(b.x)], 1u);
    return b;
}
__device__ __forceinline__ void xcd_barrier_complete(unsigned* bar, unsigned x, unsigned& nloc, unsigned& nx) {
    const unsigned G = gridDim.x * gridDim.y * gridDim.z;
    unsigned sum, cnt, mine, sp = 0u;
    for (;;) {
        sum = 0u; cnt = 0u; mine = 0u;
#pragma unroll
        for (unsigned j = 0; j < 16; ++j) { const unsigned c = xb_ld(&bar[XB_XCNT(j)]); sum += c; cnt += (c > 0u) ? 1u : 0u; mine = (j == x) ? c : mine; }
        if (sum == G) break;
        __builtin_amdgcn_s_sleep(1);
        if ((++sp & 255u) == 0u) { if (xb_ld(&bar[XB_TMO])) break; if (sp > XB_SPIN_CAP) { atomicAdd(&bar[XB_TMO], 1u); break; } }
    }
    nloc = mine > 0u ? mine : 1u; nx = cnt > 0u ? cnt : 1u;
}

__device__ __forceinline__ void xcd_barrier(const XcdBarrier& b) {
    asm volatile("s_waitcnt vmcnt(0)" ::: "memory");
    __syncthreads();
    if (threadIdx.x == 0) {
        unsigned* bar = b.bar;
        __builtin_amdgcn_s_waitcnt(0);
        unsigned nloc = b.st[0], nx = b.st[1];
        if (nloc == 0u) { xcd_barrier_complete(bar, b.x, nloc, nx); b.st[0] = nloc; b.st[1] = nx; }
        const unsigned old = xb_add(&bar[XB_XSUB(b.x)], 1u);
        const unsigned gen = old / nloc;
        if (old + 1u == (gen + 1u) * nloc) {
            __builtin_amdgcn_fence(__ATOMIC_RELEASE, "agent");
            asm volatile("s_waitcnt vmcnt(0)" ::: "memory");
            const unsigned og = xb_add(&bar[XB_TOP], 1u);
            const unsigned tg = og / nx;
            if (og + 1u == (tg + 1u) * nx) xb_add(&bar[XB_TOPGEN], 1u);
            else XB_SPIN(xb_ld(&bar[XB_TOPGEN]) == tg, bar);
            __builtin_amdgcn_fence(__ATOMIC_ACQUIRE, "agent");
            xb_add(&bar[XB_XGEN(b.x)], 1u);
            asm volatile("s_waitcnt vmcnt(0)" ::: "memory");
        } else {
            XB_SPIN(xb_ld(&bar[XB_XGEN(b.x)]) == gen, bar);
            __builtin_amdgcn_fence(__ATOMIC_ACQUIRE, "agent");
            asm volatile("s_waitcnt vmcnt(0)" ::: "memory");
        }
    }
    __syncthreads();
}

typedef unsigned v6u_t __attribute__((ext_vector_type(6)));
typedef float v32f_t __attribute__((ext_vector_type(32)));
typedef __bf16 v32bf_t __attribute__((ext_vector_type(32)));
__device__ __forceinline__ v32bf_t fp6_to_bf16x32(v6u_t p) { return __builtin_amdgcn_cvt_scalef32_pk32_bf16_fp6(p, 1.0f); }
__device__ __forceinline__ v32f_t fp6_to_f32x32(v6u_t p) { return __builtin_amdgcn_cvt_scalef32_pk32_f32_fp6(p, 1.0f); }
#define PEER_BKT(r) ((((r) >> 15) & 1u) << 8 | (((r) & 0x3FFFu) >> 6))
#ifndef PEER_HCOPY
#define PEER_HCOPY 0
#endif
#ifndef PEER_SELPF
#define PEER_SELPF 1
#endif
#ifndef PEER_TOKPF
#define PEER_TOKPF 0
#endif
#ifndef PEER_DRYMASK
#define PEER_DRYMASK 0
#endif
#ifndef PEER_NT
#define PEER_NT 0
#endif
#ifndef PEER_NTX
#define PEER_NTX 0
#endif
#ifndef PEER_SWEEP_SYNC
#define PEER_SWEEP_SYNC 0
#endif
#ifndef PEER_P
#define PEER_P 8
#endif
constexpr int PEER_SC = 0, PEER_CS = 98304, PEER_REC = 131072, PEER_SRT = 147456;
__device__ __forceinline__ float sum16(float v) { v += dppf<0xB1>(v); v += dppf<0x4E>(v); v += dppf<0x141>(v); v += dppf<0x140>(v); return v; }
__device__ __forceinline__ float dot8(const u32x4& a, const u32x4& b, float acc) {
    acc = fmaf(bflo(a.x), bflo(b.x), acc); acc = fmaf(bfhi(a.x), bfhi(b.x), acc);
    acc = fmaf(bflo(a.y), bflo(b.y), acc); acc = fmaf(bfhi(a.y), bfhi(b.y), acc);
    acc = fmaf(bflo(a.z), bflo(b.z), acc); acc = fmaf(bfhi(a.z), bfhi(b.z), acc);
    acc = fmaf(bflo(a.w), bflo(b.w), acc); acc = fmaf(bfhi(a.w), bfhi(b.w), acc);
    return acc;
}
__device__ __forceinline__ void cand_ij(int c, int& i, int& j) {
    if (c < 16) { i = 0; j = c; } else if (c < 24) { i = 1; j = c - 16; } else if (c < 29) { i = 2; j = c - 24; } else if (c < 33) { i = 3; j = c - 29; }
    else if (c < 36) { i = 4; j = c - 33; } else if (c < 38) { i = 5; j = c - 36; } else if (c < 40) { i = 6; j = c - 38; } else if (c < 42) { i = 7; j = c - 40; }
    else { i = c - 34; j = 0; }
}
template <int MODE, bool DRY = false, bool SELONLY = false>
__device__ __forceinline__ void peer_tile(LAS unsigned char* lds, int tile, int layer, const XcdBarrier& xb) {
#define PWS (kargs()->ws)
#define q ((const bf16*)(PWS + WS_Q1))
#define subk ((const bf16*)(PWS + WS_SUBK) + (size_t)layer * (8 * 2 * 128 * 128))
#define utab ((const unsigned char*)(PWS + WS_TAB + (size_t)layer * 48 * MiB))
#define vtab ((const unsigned char*)(PWS + WS_TAB + (size_t)layer * 48 * MiB + 24 * MiB))
#define tscale ((const float*)(PWS + WS_TSCALE) + (size_t)layer * 2 * 16384)
#define hbuf ((bf16*)(PWS + WS_H))
#define xbuf ((bf16*)(PWS + WS_XB))
#define fout (kargs()->out)
#define gate ((const float*)(PWS + WS_MOD) + (size_t)(layer * 2 + 1) * 2 * 6144 + 4096)
#define g_next (MODE == 0 ? kargs()->in[4] + 2 * 2048 : kargs()->in[19])
#define mod_next ((const float*)(PWS + WS_MOD) + (size_t)2 * 2 * 6144)
    int tid_ = threadIdx.x; asm volatile("" : "+v"(tid_));
    const int tid = tid_, lane = tid & 63, wave = __builtin_amdgcn_readfirstlane(tid >> 6), r32 = lane & 31, hi = lane >> 5;
    LAS float* sc = (LAS float*)(lds + PEER_SC); LAS unsigned* rec = (LAS unsigned*)(lds + PEER_REC);
    const int tok0 = tile * 32;
    const int rw = lane >> 4, li = lane & 15, tlr = wave * 4 + rw;
    LAS float* cscr = (LAS float*)(lds + PEER_CS) + wave * 512;
    bf16x8 fa[8], fb[8];
#if PEER_SELPF
    {   const int p = wave >> 2, kt = wave & 3;
        const bf16* ap = subk + ((size_t)((0 * 2 + p) * 128 + kt * 32 + r32)) * 128 + hi * 8; const bf16* bp = q + (size_t)(tok0 + r32) * 2048 + p * 128 + hi * 8;
#pragma unroll
        for (int st = 0; st < 8; ++st) { fa[st] = *(const bf16x8*)(ap + st * 16); fb[st] = *(const bf16x8*)(bp + st * 16); } }
#endif
#pragma unroll 1
    for (int h = 0; h < 8; ++h) {
        LAS float* scb = sc + (h & 1) * 8192;
        {
            const int p = wave >> 2, kt = wave & 3;
            f32x16 s;
#pragma unroll
            for (int i = 0; i < 16; ++i) s[i] = 0.f;
#if PEER_SELPF
#pragma unroll
            for (int st = 0; st < 8; ++st) s = __builtin_amdgcn_mfma_f32_32x32x16_bf16(fa[st], fb[st], s, 0, 0, 0);
            if (h + 1 < 8) {
                const bf16* ap = subk + ((size_t)(((h + 1) * 2 + p) * 128 + kt * 32 + r32)) * 128 + hi * 8; const bf16* bp = q + (size_t)(tok0 + r32) * 2048 + (h + 1) * 256 + p * 128 + hi * 8;
#pragma unroll
                for (int st = 0; st < 8; ++st) { fa[st] = *(const bf16x8*)(ap + st * 16); fb[st] = *(const bf16x8*)(bp + st * 16); }
            }
#else
            const bf16* ap = subk + ((size_t)((h * 2 + p) * 128 + kt * 32 + r32)) * 128 + hi * 8;
            const bf16* bp = q + (size_t)(tok0 + r32) * 2048 + h * 256 + p * 128 + hi * 8;
#pragma unroll
            for (int st = 0; st < 8; ++st) s = __builtin_amdgcn_mfma_f32_32x32x16_bf16(*(const bf16x8*)(ap + st * 16), *(const bf16x8*)(bp + st * 16), s, 0, 0, 0);
#endif
#pragma unroll
            for (int r = 0; r < 16; ++r) scb[(p * 32 + r32) * 128 + kt * 32 + crow(r, hi)] = s[r];
        }
        __syncthreads();
        {
            const LAS float* s0 = scb + tlr * 128; const LAS float* s1 = scb + (32 + tlr) * 128;
            unsigned ka[8], kb[8];
            { const f32x4 x0 = *(const LAS f32x4*)(s0 + li * 8), x1 = *(const LAS f32x4*)(s0 + li * 8 + 4), y0 = *(const LAS f32x4*)(s1 + li * 8), y1 = *(const LAS f32x4*)(s1 + li * 8 + 4);
#pragma unroll
              for (int k = 0; k < 4; ++k) { ka[k] = (ordf(x0[k]) & 0xFFFFFF80u) | (unsigned)(127 - (li * 8 + k)); ka[4 + k] = (ordf(x1[k]) & 0xFFFFFF80u) | (unsigned)(127 - (li * 8 + 4 + k));
                  kb[k] = (ordf(y0[k]) & 0xFFFFFF80u) | (unsigned)(127 - (li * 8 + k)); kb[4 + k] = (ordf(y1[k]) & 0xFFFFFF80u) | (unsigned)(127 - (li * 8 + 4 + k)); } }
            unsigned ra = 0u, rb = 0u;
#pragma unroll 1
            for (int r = 0; r < 16; ++r) {
                unsigned ma = ka[0], mb = kb[0];
#pragma unroll
                for (int k = 1; k < 8; ++k) { ma = ma > ka[k] ? ma : ka[k]; mb = mb > kb[k] ? mb : kb[k]; }
                unsigned t;
                t = dppu<0xB1>(ma); ma = ma > t ? ma : t; t = dppu<0xB1>(mb); mb = mb > t ? mb : t;
                t = dppu<0x4E>(ma); ma = ma > t ? ma : t; t = dppu<0x4E>(mb); mb = mb > t ? mb : t;
                t = dppu<0x141>(ma); ma = ma > t ? ma : t; t = dppu<0x141>(mb); mb = mb > t ? mb : t;
                t = dppu<0x140>(ma); ma = ma > t ? ma : t; t = dppu<0x140>(mb); mb = mb > t ? mb : t;
#pragma unroll
                for (int k = 0; k < 8; ++k) { ka[k] = ka[k] == ma ? 0u : ka[k]; kb[k] = kb[k] == mb ? 0u : kb[k]; }
                if (li == r) { ra = ma; rb = mb; }
            }
            const int ia = 127 - (int)(ra & 127u), ib = 127 - (int)(rb & 127u);
            const float av = s0[ia], bv = s1[ib];
            unsigned ck[4]; const int rowbase = lane & 48;
#pragma unroll
            for (int u = 0; u < 4; ++u) {
                const int c = li + 16 * u; int ci, cj; cand_ij(c < 50 ? c : 0, ci, cj);
                const float cand = __shfl(av, rowbase + ci) + __shfl(bv, rowbase + cj);
                const int ce = __shfl(ia, rowbase + ci) * 128 + __shfl(ib, rowbase + cj);
                cscr[rw * 64 + c] = cand; ((LAS int*)cscr)[256 + rw * 64 + c] = ce;
                ck[u] = c < 50 ? ((ordf(cand) & 0xFFFFFFC0u) | (unsigned)(63 - c)) : 0u;
            }
            unsigned rc = 0u;
#pragma unroll 1
            for (int r = 0; r < 16; ++r) {
                unsigned mc = ck[0] > ck[1] ? ck[0] : ck[1]; { const unsigned m2 = ck[2] > ck[3] ? ck[2] : ck[3]; mc = mc > m2 ? mc : m2; }
                unsigned t;
                t = dppu<0xB1>(mc); mc = mc > t ? mc : t; t = dppu<0x4E>(mc); mc = mc > t ? mc : t; t = dppu<0x141>(mc); mc = mc > t ? mc : t; t = dppu<0x140>(mc); mc = mc > t ? mc : t;
#pragma unroll
                for (int u = 0; u < 4; ++u) ck[u] = ck[u] == mc ? 0u : ck[u];
                if (li == r) rc = mc;
            }
            const int cw = 63 - (int)(rc & 63u);
            const float best = cscr[rw * 64 + cw]; const int be = ((LAS int*)cscr)[256 + rw * 64 + cw];
            const float mx = __shfl(best, rowbase);
            const float ex = __expf(best - mx);
            const float den = sum16(ex);
            rec[tlr * 128 + h * 16 + li] = (cvtpk(0.f, ex / den) & 0xffff0000u) | ((unsigned)rw << 14) | (unsigned)be;
        }
    }
    __syncthreads();
    if (SELONLY) return;
    {
        LAS unsigned* rec2 = (LAS unsigned*)(lds + PEER_SRT);
#if PEER_TOKPF
        {
            float su[8], sv[8];
#pragma unroll
            for (int k2 = 0; k2 < 8; ++k2) { const unsigned e = rec[wave * 512 + lane + 64 * k2] & 0x3FFFu; su[k2] = tscale[16384 + e]; sv[k2] = tscale[e]; }
#pragma unroll
            for (int k2 = 0; k2 < 8; ++k2) rec2[wave * 512 + lane + 64 * k2] = cvtpk(su[k2], sv[k2]);
        }
        u32x4 hn[4];
#pragma unroll
        for (int c4 = 0; c4 < 4; ++c4) hn[c4] = *(const u32x4*)(hbuf + ((size_t)tok0 + wave * 4) * 2048 + lane * 32 + 8 * c4);
#endif
#pragma unroll 1
        for (int j = 0; j < 4; ++j) {
            const int tl = wave * 4 + j; const size_t row = (size_t)tok0 + tl;
            const LAS unsigned* rcw = rec + tl * 128; LAS unsigned* rc2 = rec2 + tl * 128;
            u32x4 hh[4];
#if PEER_TOKPF
#pragma unroll
            for (int c4 = 0; c4 < 4; ++c4) { hh[c4] = hn[c4]; asm volatile("" : "+v"(hh[c4])); }
            if (j < 3) {
#pragma unroll
                for (int c4 = 0; c4 < 4; ++c4) hn[c4] = *(const u32x4*)(hbuf + (row + 1) * 2048 + lane * 32 + 8 * c4);
            }
#else
#pragma unroll
            for (int k2 = 0; k2 < 2; ++k2) { const unsigned e = rcw[lane + 64 * k2] & 0x3FFFu; rc2[lane + 64 * k2] = cvtpk(tscale[16384 + e], tscale[e]); }
#pragma unroll
            for (int c4 = 0; c4 < 4; ++c4) hh[c4] = *(const u32x4*)(hbuf + row * 2048 + lane * 32 + 8 * c4);
#pragma unroll
            for (int c4 = 0; c4 < 4; ++c4) asm volatile("" : "+v"(hh[c4]));
#endif
            f32x2 acc[16];
#pragma unroll
            for (int i = 0; i < 16; ++i) acc[i] = (f32x2){0.f, 0.f};
#pragma unroll 1
            for (int g0 = 0; g0 < 128; g0 += PEER_P) {
                u32x4 ura[PEER_P], vra[PEER_P]; u32x2 urb[PEER_P], vrb[PEER_P];
#pragma unroll
                for (int p = 0; p < PEER_P; ++p) {
                    const unsigned e = (unsigned)__builtin_amdgcn_readfirstlane((int)rcw[g0 + p]) & ((DRY && PEER_DRYMASK) ? 0x3FFu : 0x3FFFu);
                    const unsigned char* up = utab + (size_t)e * 1536; const unsigned char* vp = vtab + (size_t)e * 1536;
#if PEER_NT
                    ura[p] = __builtin_nontemporal_load((const u32x4*)(up + lane * 16)); urb[p] = __builtin_nontemporal_load((const u32x2*)(up + 1024 + lane * 8));
                    vra[p] = __builtin_nontemporal_load((const u32x4*)(vp + lane * 16)); vrb[p] = __builtin_nontemporal_load((const u32x2*)(vp + 1024 + lane * 8));
#else
                    ura[p] = *(const u32x4*)(up + lane * 16); urb[p] = *(const u32x2*)(up + 1024 + lane * 8);
                    vra[p] = *(const u32x4*)(vp + lane * 16); vrb[p] = *(const u32x2*)(vp + 1024 + lane * 8);
#endif
                }
                float part[PEER_P];
#pragma unroll
                for (int p = 0; p < PEER_P; ++p) {
                    const v6u_t up6 = {ura[p].x, ura[p].y, ura[p].z, ura[p].w, urb[p].x, urb[p].y};
                    const v32bf_t ub = fp6_to_bf16x32(up6);
                    float d = 0.f;
#pragma unroll
                    for (int k = 0; k < 16; ++k) { const bf16x2_t uu = {ub[2 * k], ub[2 * k + 1]}; const unsigned hw = hh[k >> 2][k & 3];     d = __builtin_amdgcn_fdot2_f32_bf16(uu, __builtin_bit_cast(bf16x2_t, hw), d, false); }
                    part[p] = d;
                }
                float v4[4], v2[2], v1;
                { const bool up = (lane & 32) != 0;
#pragma unroll
                  for (int i = 0; i < 4; ++i) { const float keep = up ? part[i + 4] : part[i], snd = up ? part[i] : part[i + 4]; v4[i] = keep + __shfl_xor(snd, 32); } }
                { const bool up = (lane & 16) != 0;
#pragma unroll
                  for (int i = 0; i < 2; ++i) { const float keep = up ? v4[i + 2] : v4[i], snd = up ? v4[i] : v4[i + 2]; v2[i] = keep + __shfl_xor(snd, 16); } }
                { const bool up = (lane & 8) != 0; const float keep = up ? v2[1] : v2[0], snd = up ? v2[0] : v2[1]; v1 = keep + __shfl_xor(snd, 8); }
                v1 += __shfl_xor(v1, 4); v1 += __shfl_xor(v1, 2); v1 += __shfl_xor(v1, 1);
                const int ek = 4 * (lane >> 5) + 2 * ((lane >> 4) & 1) + ((lane >> 3) & 1);
                const unsigned rk = rcw[g0 + ek], sk = rc2[g0 + ek];
                const float cf = __uint_as_float(rk & 0xffff0000u) * gelu_tanh(v1 * __uint_as_float(sk & 0xffff0000u)) * __uint_as_float(sk << 16);
#pragma unroll
                for (int p = 0; p < PEER_P; ++p) {
                    const float ck = __int_as_float(__builtin_amdgcn_readlane(__float_as_int(cf), (((p >> 2) & 1) << 5) | (((p >> 1) & 1) << 4) | ((p & 1) << 3)));
                    const f32x2 ck2 = {ck, ck};
                    const v6u_t vp6 = {vra[p].x, vra[p].y, vra[p].z, vra[p].w, vrb[p].x, vrb[p].y};
                    const v32f_t vf = fp6_to_f32x32(vp6);
#pragma unroll
                    for (int i = 0; i < 16; ++i) acc[i] = __builtin_elementwise_fma((f32x2){vf[2 * i], vf[2 * i + 1]}, ck2, acc[i]);
                }
            }
            if (DRY) {
#pragma unroll
                for (int i = 0; i < 16; ++i) asm volatile("" :: "v"(acc[i]));
                continue;
            }
            bf16* xr = xbuf + row * 2048 + lane * 32; const float* gt = gate + (size_t)(row >> 13) * 6144 + lane * 32;
            float ss = 0.f;
#pragma unroll
            for (int c4 = 0; c4 < 4; ++c4) {
                const u32x4 xw = *(const u32x4*)(xr + 8 * c4); const f32x4 g0 = *(const f32x4*)(gt + 8 * c4), g1 = *(const f32x4*)(gt + 8 * c4 + 4);
                f32x4 xa, xb2;
                xa.x = bflo(xw.x) + g0.x * acc[4 * c4].x; xa.y = bfhi(xw.x) + g0.y * acc[4 * c4].y; xa.z = bflo(xw.y) + g0.z * acc[4 * c4 + 1].x; xa.w = bfhi(xw.y) + g0.w * acc[4 * c4 + 1].y;
                xb2.x = bflo(xw.z) + g1.x * acc[4 * c4 + 2].x; xb2.y = bfhi(xw.z) + g1.y * acc[4 * c4 + 2].y; xb2.z = bflo(xw.w) + g1.z * acc[4 * c4 + 3].x; xb2.w = bfhi(xw.w) + g1.w * acc[4 * c4 + 3].y;
                if (MODE == 0) {
                    const u32x4 pw = pack8(xa, xb2); *(u32x4*)(xr + 8 * c4) = pw;
                    xa = (f32x4){bflo(pw.x), bfhi(pw.x), bflo(pw.y), bfhi(pw.y)}; xb2 = (f32x4){bflo(pw.z), bfhi(pw.z), bflo(pw.w), bfhi(pw.w)};
                }
                acc[4 * c4] = (f32x2){xa.x, xa.y}; acc[4 * c4 + 1] = (f32x2){xa.z, xa.w}; acc[4 * c4 + 2] = (f32x2){xb2.x, xb2.y}; acc[4 * c4 + 3] = (f32x2){xb2.z, xb2.w};
                ss += (xa.x * xa.x + xa.y * xa.y) + (xa.z * xa.z + xa.w * xa.w) + (xb2.x * xb2.x + xb2.y * xb2.y) + (xb2.z * xb2.z + xb2.w * xb2.w);
            }
            const float rn = 1.0f / sqrtf(wave_sum(ss) * (1.f / DM) + NORM_EPS);
            if (MODE == 0) {
                const float* md = mod_next + (size_t)(row >> 13) * 6144 + lane * 32; const float* gn = g_next + lane * 32;
                unsigned ow[16];
#pragma unroll
                for (int q4 = 0; q4 < 8; ++q4) { const f32x4 gg = *(const f32x4*)(gn + 4 * q4), sc4 = *(const f32x4*)(md + 2048 + 4 * q4), sh4 = *(const f32x4*)(md + 4 * q4);
                    ow[2 * q4] = cvtpk(acc[2 * q4].x * rn * gg.x * (1.f + sc4.x) + sh4.x, acc[2 * q4].y * rn * gg.y * (1.f + sc4.y) + sh4.y);
                    ow[2 * q4 + 1] = cvtpk(acc[2 * q4 + 1].x * rn * gg.z * (1.f + sc4.z) + sh4.z, acc[2 * q4 + 1].y * rn * gg.w * (1.f + sc4.w) + sh4.w); }
                bf16* hw = hbuf + row * 2048 + lane * 32;
#pragma unroll
                for (int q4 = 0; q4 < 4; ++q4) *(u32x4*)(hw + 8 * q4) = (u32x4){ow[4 * q4], ow[4 * q4 + 1], ow[4 * q4 + 2], ow[4 * q4 + 3]};
            } else {
                const float* gn = g_next + lane * 32;
#pragma unroll
                for (int q4 = 0; q4 < 8; ++q4) { const f32x4 gg = *(const f32x4*)(gn + 4 * q4); f32x4 o;
                    o.x = acc[2 * q4].x * rn * gg.x; o.y = acc[2 * q4].y * rn * gg.y; o.z = acc[2 * q4 + 1].x * rn * gg.z; o.w = acc[2 * q4 + 1].y * rn * gg.w;
                    *(f32x4*)(fout + row * 2048 + lane * 32 + 4 * q4) = o; }
            }
        }
    }
    __syncthreads();
#undef PWS
#undef q
#undef subk
#undef utab
#undef vtab
#undef tscale
#undef hbuf
#undef xbuf
#undef fout
#undef gate
#undef g_next
#undef mod_next
}
namespace flow {
constexpr size_t WS_FLOW = WS_CTL + 40960;
constexpr int SLOT_LDS = LDS_BYTES - 16;
#define FLOW_RLX __ATOMIC_RELAXED, __HIP_MEMORY_SCOPE_AGENT
#ifndef FLOW_BFS
#define FLOW_BFS 0
#endif
#ifndef FLOW_PCAP
#define FLOW_PCAP 24
#endif
struct R1 {
    static constexpr int NST = 5, BASE = 0, PST = 3;
    static __device__ __forceinline__ int cnt(int st) { return st == 1 ? 4 : st == 4 ? 15 : 8; }
    static __device__ __forceinline__ int dep(int st) { return st - 1; }
    static __device__ __forceinline__ int depn(int st) { return st == 2 ? 4 : 8; }
    static __device__ __forceinline__ int prio(int p) { return p == 4 ? 4 : 3 - p; }
};
struct R2 {
    static constexpr int NST = 4, BASE = 1024, PST = 3;
    static __device__ __forceinline__ int cnt(int st) { return st == 1 ? 4 : 8; }
    static __device__ __forceinline__ int dep(int st) { return st - 1; }
    static __device__ __forceinline__ int depn(int st) { return st == 2 ? 4 : 8; }
    static __device__ __forceinline__ int prio(int p) { return FLOW_BFS ? p : 3 - p; }
};
struct Q { unsigned* base; int home; unsigned par; };
__device__ __forceinline__ unsigned* arrive_ctr(const Q& q, int st, int rt) { return q.base + (rt & 7) * 64 + 16 + st * 8 + (rt >> 3); }
__device__ __forceinline__ unsigned* pact_ctr(const Q& q, int xq) { return q.base + xq * 64 + 8; }
template <class R>
__device__ __forceinline__ int scan_xcd(const Q& q, int xq, int only) {
    const int lane = threadIdx.x & 63; const bool l0 = (lane == 0);
    unsigned* blk = q.base + xq * 64;
    const int v = (int)__hip_atomic_load(blk + lane, FLOW_RLX);
    bool all_ex = true;
    for (int p = 0; p < R::NST; ++p) {
        const int st = only >= 0 ? only : R::prio(p), c = R::cnt(st);
        const int h = __builtin_amdgcn_readlane(v, st);
        if (h < 8 * c) {
            all_ex = false;
            const int kk = h / c, ix = h - kk * c;
            const bool dep_ok = R::dep(st) < 0 || __builtin_amdgcn_readlane(v, 16 + R::dep(st) * 8 + kk) >= R::depn(st);
            const bool cap_ok = st != R::PST || __builtin_amdgcn_readlane(v, 8) < FLOW_PCAP;
            if (dep_ok && cap_ok) {
                unsigned ok = 0u; if (l0) { unsigned ex = (unsigned)h; ok = __hip_atomic_compare_exchange_strong(blk + st, &ex, (unsigned)h + 1u, __ATOMIC_RELAXED, __ATOMIC_RELAXED, __HIP_MEMORY_SCOPE_AGENT) ? 1u : 0u; }
                if (!__builtin_amdgcn_readfirstlane((int)ok)) return -3;
                if (st == R::PST && l0) (void)__hip_atomic_fetch_add(blk + 8, 1u, FLOW_RLX);
                return (xq << 24) | (st << 16) | ((kk * 8 + xq) << 8) | ix;
            }
        }
        if (only >= 0) break;
    }
    return all_ex ? -2 : -1;
}
template <class R, bool IN_GEMM>
__device__ __forceinline__ int pop(LAS unsigned char* lds, Q& q, int only) {
    if (!IN_GEMM) __syncthreads();
    LAS volatile int* slot = (LAS volatile int*)(lds + SLOT_LDS) + (q.par & 1u);
    if (__builtin_amdgcn_readfirstlane((int)(threadIdx.x >> 6)) == 0) {
        int r = -1;
        if (IN_GEMM) { do { r = scan_xcd<R>(q, q.home, only); } while (r == -3); if (r < 0) r = -1; }
        else for (;;) {
            bool all_ex = true;
            for (int xi = 0; xi < 8; ++xi) { const int xq = (q.home + xi) & 7; int c;
                do { c = scan_xcd<R>(q, xq, -1); } while (c == -3);
                if (c >= 0) { r = c; break; } if (c == -1) all_ex = false; }
            if (r >= 0 || all_ex) break;
            r = -1; __builtin_amdgcn_s_sleep(64);
        }
        if (threadIdx.x == 0) *slot = r;
        asm volatile("s_waitcnt lgkmcnt(0)" ::: "memory");
    }
    __builtin_amdgcn_s_barrier();
    const int r = __builtin_amdgcn_readfirstlane(*slot);
    ++q.par;
    return r;
}
__device__ __forceinline__ void acquire() { __builtin_amdgcn_fence(__ATOMIC_ACQUIRE, "agent"); }
template <bool RAW_BAR>
__device__ __forceinline__ void publish(unsigned* c, unsigned* dec) {
    asm volatile("s_waitcnt vmcnt(0)" ::: "memory");
    if (RAW_BAR) __builtin_amdgcn_s_barrier(); else __syncthreads();
    if (threadIdx.x == 0) { __builtin_amdgcn_fence(__ATOMIC_RELEASE, "agent"); asm volatile("s_waitcnt vmcnt(0)" ::: "memory"); (void)__hip_atomic_fetch_add(c, 1u, FLOW_RLX);
        if (dec) (void)__hip_atomic_fetch_sub(dec, 1u, FLOW_RLX); }
}
template <class R, int ST>
struct GOrder {
    LAS unsigned char* lds; Q* q; int first;
    __device__ __forceinline__ bool next(int i, pg8::Unit& u) {
        const int t = (i == 0) ? first : pop<R, true>(lds, *q, ST);
        if (t >= 0) { u.pm = (t >> 8) & 255; u.pn = t & 255; return true; }
        return false;
    }
    __device__ __forceinline__ void a_ready(const pg8::Unit&) const { if (R::dep(ST) >= 0) acquire(); }
    __device__ __forceinline__ void done(const pg8::Unit& u) const { publish<true>(arrive_ctr(*q, ST, u.pm), nullptr); }
};
}
#ifndef CONV_COAL
#define CONV_COAL 0
#endif
#ifndef P9_SKIP5
#define P9_SKIP5 0
#endif
#ifndef PRO_SKIP
#define PRO_SKIP 0
#endif
#ifndef DEFER_PRO
#define DEFER_PRO 0
#endif


constexpr int N_PHASES = 17;
#ifndef STOP_AFTER
#define STOP_AFTER 15
#endif
#ifndef N_LAUNCH_MODE
#define N_LAUNCH_MODE 1
#endif

__device__ __forceinline__ void cvt_rows_bf16(const float* src, bf16* dst, size_t nvec8, size_t gtid, size_t nthr) {
    for (size_t i = gtid; i < nvec8; i += nthr) {
        const f32x4 a = *(const f32x4*)(src + i * 8), b = *(const f32x4*)(src + i * 8 + 4);
        u32x4 w; w.x = cvtpk(a.x, a.y); w.y = cvtpk(a.z, a.w); w.z = cvtpk(b.x, b.y); w.w = cvtpk(b.z, b.w);
        *(u32x4*)(dst + i * 8) = w;
    }
}
typedef float v16f_t __attribute__((ext_vector_type(16)));

#ifndef FP6_INTERLEAVED
#define FP6_INTERLEAVED 1
#endif
__device__ __forceinline__ void row_to_fp6_pre(const float* src, f32x4 (&v)[8], int lane) {
#pragma unroll
    for (int q = 0; q < 8; ++q) v[q] = NT_ONCE ? __builtin_nontemporal_load((const f32x4*)(src + lane * 32 + 4 * q)) : *(const f32x4*)(src + lane * 32 + 4 * q);
}
__device__ __forceinline__ void row_load_coal(const float* src, f32x4 (&raw)[8], int lane) {
#pragma unroll
    for (int q = 0; q < 8; ++q) raw[q] = *(const f32x4*)(src + q * 256 + lane * 4);
}
__device__ __forceinline__ void row_xpose(const f32x4 (&raw)[8], f32x4 (&v)[8], LAS float* scr, int lane) {
#pragma unroll
    for (int q = 0; q < 8; ++q) *(LAS f32x4*)(scr + q * 288 + lane * 4 + 4 * (lane >> 3)) = raw[q];
    asm volatile("s_waitcnt lgkmcnt(0)" ::: "memory");
#pragma unroll
    for (int q = 0; q < 8; ++q) v[q] = *(const LAS f32x4*)(scr + lane * 36 + 4 * q);
    asm volatile("s_waitcnt lgkmcnt(0)" ::: "memory");
}
__device__ __forceinline__ void row_to_fp6(const float* src, unsigned char* dst, float* scale, int lane, const f32x4 (*pre)[8] = nullptr) {
    f32x4 v[8]; float am = 0.f;
#pragma unroll
    for (int q = 0; q < 8; ++q) { v[q] = pre ? (*pre)[q] : (NT_ONCE ? __builtin_nontemporal_load((const f32x4*)(src + lane * 32 + 4 * q)) : *(const f32x4*)(src + lane * 32 + 4 * q)); const f32x4 a = __builtin_elementwise_abs(v[q]); am = fmaxf(am, fmaxf(fmaxf(a.x, a.y), fmaxf(a.z, a.w))); }
#pragma unroll
    for (int o = 1; o < 64; o <<= 1) am = fmaxf(am, __shfl_xor(am, o));
    const float sc = am > 0.f ? am * (1.f / 7.5f) : 1.f, inv = 1.f / sc;
    if (lane == 0) *scale = sc;
    v16f_t x, y;
#pragma unroll
    for (int i = 0; i < 16; ++i) {
        const int ex = FP6_INTERLEAVED ? 2 * i : i, ey = FP6_INTERLEAVED ? 2 * i + 1 : 16 + i;
        x[i] = v[ex >> 2][ex & 3] * inv; y[i] = v[ey >> 2][ey & 3] * inv;
    }
    const v6u_t p = __builtin_amdgcn_cvt_scalef32_2xpk16_fp6_f32(x, y, 1.0f);
    *(u32x4*)(dst + lane * 16) = (u32x4){p[0], p[1], p[2], p[3]}; *(u32x2*)(dst + 1024 + lane * 8) = (u32x2){p[4], p[5]};
}
__device__ __forceinline__ void ada_item(KArgs Ap, LAS unsigned char* lds, int it) {
    LAS float* sv = (LAS float*)lds; LAS float* red = (LAS float*)(lds + 32768); float* mod = (float*)((*Ap).ws + WS_MOD);
    const int li = it / 48, cgp = it % 48;
    for (int k = threadIdx.x; k < 4096; k += NTHREADS) sv[k] = siluf_((*Ap).in[1][k]);
    __syncthreads();
    gemv_item(sv, 2048, (*Ap).in[2] + (size_t)li * 2048 * 6144, 6144, cgp * 128, red, mod + (size_t)(li * 2) * 6144, mod + (size_t)(li * 2 + 1) * 6144, (*Ap).in[3] + (size_t)li * 6144);
}
__device__ __forceinline__ void phase_prologue(KArgs Ap, LAS unsigned char* lds, int vcu, int G, int skip = 0) {
    const int tid = threadIdx.x, lane = tid & 63, wave = __builtin_amdgcn_readfirstlane(tid >> 6), bx = blockIdx.x;
    unsigned char* ws = Ap->ws;
#define A (*Ap)
    {
        LAS float* sv = (LAS float*)lds; LAS float* red = (LAS float*)(lds + 32768);
        float* mod = (float*)(ws + WS_MOD); float* bias1 = (float*)(ws + WS_BIAS1);
        if (!(skip & 1)) for (int it = bx; it < 196; it += G) {
            __syncthreads();
            if (it < 192) {
                if (DEFER_PRO && G == 256 && it >= 48) continue;
                ada_item(Ap, lds, it);
            } else {
                const int kv = (it - 192) >> 1, cgp = (it - 192) & 1;
                for (int k = tid; k < 4096; k += NTHREADS) { const float p = A.in[12][(size_t)kv * 4096 + k]; sv[k] = p; sv[4096 + k] = p; }
                __syncthreads();
                gemv_item(sv, 4096, A.in[13] + (size_t)kv * 4096 * 256, 256, cgp * 128, red, bias1 + kv * 256, bias1 + 512, nullptr);
            }
        }
        __syncthreads();
    }
    {
        LAS float* scr = (LAS float*)(lds + wave * 16384);
        const int gw = vcu * NWAVES + wave, NGW = G * NWAVES;
        constexpr int I0 = 4608, I1 = I0 + 2048, I2 = I1 + 3648, I3 = I2 + 2048, I4 = I3 + 2048, I5 = I4 + 2048, I6 = I5 + 512, I7 = I6 + 512, I8 = I7 + 16, I9 = I8 + 16;
        if (!(skip & 2)) for (int it = gw; it < I9; it += NGW) {
            if (it < I0) transpose_item(A.in[5], 2048, 4608, (bf16*)(ws + WS_WIN0), 1, scr, it, lane);
            else if (it < I1) transpose_item(A.in[6], 2048, 2048, (bf16*)(ws + WS_WOUT0), 0, scr, it - I0, lane);
            else if (it < I2) transpose_item(A.in[10], 2048, 3632, (bf16*)(ws + WS_WIN1), 2, scr, it - I1, lane);
            else if (it < I3) { if (!(DEFER_PRO && G == 256)) transpose_item(A.in[11], 2048, 2048, (bf16*)(ws + WS_WOUT1), 0, scr, it - I2, lane); }
            else if (it < I4) transpose_item(A.in[15], 2048, 2048, (bf16*)(ws + WS_WQ0), 0, scr, it - I3, lane);
            else if (it < I5) { if (!(DEFER_PRO && G == 256)) transpose_item(A.in[15] + (size_t)2048 * 2048, 2048, 2048, (bf16*)(ws + WS_WQ1), 0, scr, it - I4, lane); }
            else if (it < I6) transpose_item(A.in[13], 4096, 256, (bf16*)(ws + WS_W1T), 0, scr, it - I5, lane);
            else if (it < I7) transpose_item(A.in[13] + (size_t)4096 * 256, 4096, 256, (bf16*)(ws + WS_W1T) + (size_t)256 * 4096, 0, scr, it - I6, lane);
            else if (it < I8) transpose_item(A.in[14], 256, 128, (bf16*)(ws + WS_W2T), 3, scr, it - I7, lane);
            else transpose_item(A.in[14] + (size_t)256 * 128, 256, 128, (bf16*)(ws + WS_W2T) + (size_t)256 * 256, 0, scr, it - I8, lane);
        }
    }
    if (CONV_COAL) __syncthreads();
    {
        const size_t gtid = (size_t)vcu * NTHREADS + tid, nthr = (size_t)G * NTHREADS;
        {
            const int gw2 = vcu * NWAVES + wave, NGW2 = G * NWAVES;
            if (!(skip & 4)) for (int r = gw2; r < 2 * 16384; r += 2 * NGW2) {
                const int r2 = r + NGW2;
                const int tb = r >> 14, e = r & 16383; const float* src = (tb & 1 ? A.in[18] : A.in[17]) + ((size_t)(tb >> 1) * 16384 + e) * 2048;
                const int tb2 = r2 >> 14, e2 = r2 & 16383; const float* src2 = (tb2 & 1 ? A.in[18] : A.in[17]) + ((size_t)(tb2 >> 1) * 16384 + e2) * 2048;
                f32x4 pa[8], pb[8];
#if CONV_COAL
                { f32x4 ra[8], rb[8]; row_load_coal(src, ra, lane); row_load_coal(src2, rb, lane); LAS float* xs = (LAS float*)lds + wave * 4608; row_xpose(ra, pa, xs, lane); row_xpose(rb, pb, xs + 2304, lane); }
#else
                row_to_fp6_pre(src, pa, lane); row_to_fp6_pre(src2, pb, lane);
#endif
                row_to_fp6(src, ws + WS_TAB + (size_t)tb * 24 * MiB + (size_t)e * 1536, (float*)(ws + WS_TSCALE) + r, lane, &pa);
                row_to_fp6(src2, ws + WS_TAB + (size_t)tb2 * 24 * MiB + (size_t)e2 * 1536, (float*)(ws + WS_TSCALE) + r2, lane, &pb);
            }
        }
        cvt_rows_bf16(A.in[16], (bf16*)(ws + WS_SUBK), (size_t)2 * 8 * 2 * 128 * 128 / 8, gtid, nthr);
        f32x2* t64 = (f32x2*)(ws + WS_TAB64); f32x2* t128 = (f32x2*)(ws + WS_TAB128);
        if (!(skip & 8)) for (size_t i = gtid; i < (size_t)SEQ * 96; i += nthr) {
            const int pos = (int)(i / 96), r = (int)(i % 96);
            const bool is64 = r < 32; const int fi = is64 ? r : r - 32; const float dim = is64 ? 64.f : 128.f;
            const float inv = exp2f(-(2.f * (float)fi / dim) * 13.287712379549449f);
            const float ang = (float)pos * inv; float sn, cs; sincosf(ang, &sn, &cs);
            if (is64) t64[(size_t)pos * 32 + fi] = (f32x2){cs, sn}; else t128[(size_t)pos * 64 + fi] = (f32x2){cs, sn};
        }
        u32x4 z = {0u, 0u, 0u, 0u};
        for (size_t i = gtid; i < (size_t)208 * 2048 / 8; i += nthr) *(u32x4*)((bf16*)(ws + WS_WIN1) + (size_t)3632 * 2048 + i * 8) = z;
        for (size_t i = gtid; i < (size_t)2 * 128 * 256 / 8; i += nthr) { const size_t half = i / (128 * 256 / 8), r = i % (128 * 256 / 8); *(u32x4*)((bf16*)(ws + WS_W2T) + (half * 256 + 128) * 256 + r * 8) = z; }
    }
}
#undef A
template <bool XF32, bool ADDY = false>
__device__ __forceinline__ void adaln_rows(const void* X, const float* g, const float* mod, bf16* H, int vcu, int G, const bf16* Y = nullptr, bf16* XB = nullptr) {
    int tid_ = threadIdx.x; asm volatile("" : "+v"(tid_));
    const int lane = tid_ & 63, wave = __builtin_amdgcn_readfirstlane(tid_ >> 6);
    const int stride = G * NWAVES;
#pragma unroll 1
    for (int b = 0; b < T / SEQ; ++b) {
        f32x4 cs[8], sh[8];
#pragma unroll
        for (int j = 0; j < 8; ++j) { const int idx = lane * 8 + 512 * (j >> 1) + 4 * (j & 1);
            const f32x4 gg = *(const f32x4*)(g + idx), sc = *(const f32x4*)(mod + (size_t)b * 6144 + 2048 + idx);
            cs[j] = gg * (1.f + sc); sh[j] = *(const f32x4*)(mod + (size_t)b * 6144 + idx); }
        int row = b * SEQ + vcu * NWAVES + wave;
        if (row >= (b + 1) * SEQ) continue;
        f32x4 v[8];
        auto ld = [&](int r, f32x4 (&d)[8]) {
            if (XF32) { const float* xr = (const float*)X + (size_t)r * 2048;
#pragma unroll
                for (int j = 0; j < 8; ++j) d[j] = *(const f32x4*)(xr + lane * 8 + 512 * (j >> 1) + 4 * (j & 1)); }
            else { const bf16* xr = (const bf16*)X + (size_t)r * 2048;
#pragma unroll
                for (int j = 0; j < 4; ++j) { const u32x4 w = *(const u32x4*)(xr + lane * 8 + 512 * j);
                    d[2 * j] = (f32x4){bflo(w.x), bfhi(w.x), bflo(w.y), bfhi(w.y)}; d[2 * j + 1] = (f32x4){bflo(w.z), bfhi(w.z), bflo(w.w), bfhi(w.w)}; } }
            if (ADDY) {
                const bf16* yr = Y + (size_t)r * 2048; bf16* xo = XB + (size_t)r * 2048;
#pragma unroll
                for (int j = 0; j < 4; ++j) { const u32x4 w = *(const u32x4*)(yr + lane * 8 + 512 * j);
                    const f32x4 s0 = d[2 * j] + (f32x4){bflo(w.x), bfhi(w.x), bflo(w.y), bfhi(w.y)}, s1 = d[2 * j + 1] + (f32x4){bflo(w.z), bfhi(w.z), bflo(w.w), bfhi(w.w)};
                    const u32x4 pw = pack8(s0, s1); *(u32x4*)(xo + lane * 8 + 512 * j) = pw;
                    d[2 * j] = (f32x4){bflo(pw.x), bfhi(pw.x), bflo(pw.y), bfhi(pw.y)}; d[2 * j + 1] = (f32x4){bflo(pw.z), bfhi(pw.z), bflo(pw.w), bfhi(pw.w)}; }
            }
        };
        ld(row, v);
#pragma unroll 1
        for (; row < (b + 1) * SEQ; row += stride) {
            f32x4 nx[8]; const int rn = row + stride; const bool more = rn < (b + 1) * SEQ;
            if (!ADDY || more) ld(more ? rn : row, nx);
            float ss = 0.f;
#pragma unroll
            for (int j = 0; j < 8; ++j) ss += v[j].x * v[j].x + v[j].y * v[j].y + v[j].z * v[j].z + v[j].w * v[j].w;
            const float r = 1.0f / sqrtf(wave_sum(ss) * (1.f / DM) + NORM_EPS);
            bf16* hrow = H + (size_t)row * 2048;
#pragma unroll
            for (int j = 0; j < 4; ++j) {
                const f32x4 o0 = v[2 * j] * r * cs[2 * j] + sh[2 * j], o1 = v[2 * j + 1] * r * cs[2 * j + 1] + sh[2 * j + 1];
                u32x4 w; w.x = cvtpk(o0.x, o0.y); w.y = cvtpk(o0.z, o0.w); w.z = cvtpk(o1.x, o1.y); w.w = cvtpk(o1.z, o1.w);
                *(u32x4*)(hrow + lane * 8 + 512 * j) = w;
            }
#pragma unroll
            for (int j = 0; j < 8; ++j) v[j] = nx[j];
        }
    }
}
__device__ __forceinline__ void phase_adaln_bf(KArgs Ap, int li, int vcu, int G) {
    adaln_rows<false>((*Ap).ws + WS_XB, (*Ap).in[4] + (size_t)li * 2048, (const float*)((*Ap).ws + WS_MOD) + (size_t)li * 2 * 6144, (bf16*)((*Ap).ws + WS_H), vcu, G);
}
template <bool XF32>
__device__ __forceinline__ void phase_adaln_add(KArgs Ap, const void* xold, int li, int vcu, int G) {
    adaln_rows<XF32, true>(xold, (*Ap).in[4] + (size_t)li * 2048, (const float*)((*Ap).ws + WS_MOD) + (size_t)li * 2 * 6144, (bf16*)((*Ap).ws + WS_H), vcu, G, (const bf16*)((*Ap).ws + WS_Y), (bf16*)((*Ap).ws + WS_XB));
}
__device__ __forceinline__ void phase_adaln(KArgs Ap, const float* xsrc, int li, int vcu, int G) {
    adaln_rows<true>(xsrc, (*Ap).in[4] + (size_t)li * 2048, (const float*)((*Ap).ws + WS_MOD) + (size_t)li * 2 * 6144, (bf16*)((*Ap).ws + WS_H), vcu, G);
}
__device__ __forceinline__ void phase_final(KArgs Ap, const float* xsrc, int vcu, int G) {
    const int lane = threadIdx.x & 63, wave = __builtin_amdgcn_readfirstlane(threadIdx.x >> 6);
    for (int row = vcu * NWAVES + wave; row < T; row += G * NWAVES) final_row(xsrc + (size_t)row * 2048, (*Ap).in[19], (*Ap).out + (size_t)row * 2048, lane);
}

#undef A
__global__ void __launch_bounds__(NTHREADS, 2) fwd_kernel(Args Aunused) {
    extern __shared__ __attribute__((aligned(16))) unsigned char lds_raw[];
    LAS unsigned char* lds = (LAS unsigned char*)lds_raw;
    const int G = gridDim.x, bx = blockIdx.x;
    const int vcu = (G % 8 == 0) ? (bx % 8) * (G / 8) + bx / 8 : bx;
    cg::grid_group grid = cg::this_grid();
    const XcdBarrier xbar = xcd_barrier_post((unsigned*)(kargs()->ws + WS_CTL), (volatile unsigned*)(kargs()->ws + WS_CTL + 16384) + 16 * bx);
#define A (*kargs())
#define ws (kargs()->ws)
#define mod ((const float*)(ws + WS_MOD))
#define tab64 ((const f32x2*)(ws + WS_TAB64))
#define tab128 ((const f32x2*)(ws + WS_TAB128))
#define H ((bf16*)(ws + WS_H))
#define ATT ((bf16*)(ws + WS_ATT))
#define xbuf (kargs()->out)
#ifndef PHASE_MASK
#define PHASE_MASK 0x1FFFF
#endif
#define PH(k) ((((PHASE_MASK) >> (k)) & 1) && A.ph_lo <= (k) && (k) < A.ph_hi)
#define SEAM(k) do { if (PH(k) && PH((k) + 1)) { if ((k) == 0) grid.sync(); else xcd_barrier(xbar); } } while (0)
#ifndef PEER_SELONLY
#define PEER_SELONLY 0
#endif
#ifndef FLOW1
#define FLOW1 0
#endif
#ifndef P9_ALT
#define P9_ALT 1
#endif
#ifndef RESID_IN_NORM
#define RESID_IN_NORM 0
#endif
#ifndef FLOW2
#define FLOW2 0
#endif
#ifndef PEER_HALF_PROBE
#define PEER_HALF_PROBE 0
#endif
#ifndef REPEAT_PHASE
#define REPEAT_PHASE -1
#endif
#define REP(k) for (int rep_ = 0; rep_ < ((REPEAT_PHASE) == (k) ? 2 : 1); ++rep_, (((REPEAT_PHASE) == (k) && rep_ == 1) ? xcd_barrier(xbar) : (void)0))
    if (PH(0)) REP(0) { phase_prologue(kargs(), lds, vcu, G, rep_ ? (PRO_SKIP) : 0); }
    SEAM(0);
    if (PH(1)) REP(1) { phase_adaln(kargs(), A.in[0], 0, vcu, G); }
    SEAM(1);
    if (PH(2)) REP(2) { pg8::Gemm g{H, (const bf16*)(ws + WS_WIN0), T, 4608, 2048, 2048}; pg8::StaticOrder S; S.init(T, 4608, G, bx);
        EpiQKV0 E{(bf16*)(ws + WS_QKV), tab64}; pg8::gemm_phase<EpiQKV0, pg8::StaticOrder, true, true>(lds, g, S, E); }
    if (DEFER_PRO && PH(2) && bx >= 128 && G == 256) {
        for (int it = 48 + (bx - 128); it < 192; it += 128) { __syncthreads(); ada_item(kargs(), lds, it); }
        __syncthreads();
    }
    SEAM(2);
    if (PH(3)) REP(3) {
        const bf16* qkv = (const bf16*)(ws + WS_QKV);
        float lam;
        { const float* lv = A.in[7]; const int lane = threadIdx.x & 63; const float d1 = wave_sum(lv[lane] * lv[64 + lane]), d2 = wave_sum(lv[128 + lane] * lv[192 + lane]); lam = __expf(d1) - __expf(d2) + 0.2f; }
#ifndef SKIP_DA
#define SKIP_DA 0
#endif
        if (SKIP_DA) { for (size_t i = (size_t)vcu * NTHREADS + threadIdx.x; i < (size_t)T * 128; i += (size_t)G * NTHREADS) { const size_t r = i >> 7, cc = i & 127; *(u32x4*)(ATT + r * 2048 + cc * 8) = (u32x4){0u, 0u, 0u, 0u}; } }
        else for (int n = vcu; n < 256; n += G)
            for (int i = 0; i < 2; ++i) { const int bh = n >> 4, s = n & 15, qb = i == 0 ? s : 31 - s; __syncthreads(); da_unit(lds, qkv, ATT, bh >> 3, bh & 7, qb, lam, A.in[8], (float*)(ws + WS_SLOT)); }
#ifndef NAIVE_SWA
#define NAIVE_SWA 0
#endif
#ifndef SKIP_SWA
#define SKIP_SWA 0
#endif
        if (SKIP_SWA) { for (size_t i = (size_t)vcu * NTHREADS + threadIdx.x; i < (size_t)T * 128; i += (size_t)G * NTHREADS) { const size_t r = i >> 7, cc = i & 127; *(u32x4*)(ATT + r * 2048 + 1024 + cc * 8) = (u32x4){0u, 0u, 0u, 0u}; } }
        else if (NAIVE_SWA) { const int wv = __builtin_amdgcn_readfirstlane(threadIdx.x >> 6);
            for (int it = vcu * NWAVES + wv; it < T * 16; it += G * NWAVES) swa_naive(qkv, ATT, (it >> 4) >> 13, (it >> 4) & (SEQ - 1), it & 15, A.in[9], threadIdx.x & 63); }
        else
        for (int n = vcu; n < 1024; n += G) { __syncthreads(); swa_unit(lds, qkv, ATT, n >> 9, (n >> 7) & 3, n & 127, A.in[9]); }
    }
    SEAM(3);
#if FLOW1
    if (PH(4)) {
        using R = flow::R1;
        flow::Q fq{(unsigned*)(ws + flow::WS_FLOW) + R::BASE, (int)(xbar.x & 7u), 0u};
        for (int t = flow::pop<R, false>(lds, fq, -1); t >= 0; t = flow::pop<R, false>(lds, fq, -1)) {
            const int xq = (t >> 24) & 7, st = (t >> 16) & 255, rt = (t >> 8) & 255, ix = t & 255;
            if (st == 0) { pg8::Gemm g{ATT, (const bf16*)(ws + WS_WOUT0), T, 2048, 2048, 2048}; EpiResid<true> E{A.in[0], (bf16*)(ws + WS_XB), mod + 4096};
                flow::GOrder<R, 0> S{lds, &fq, t}; pg8::gemm_phase<EpiResid<true>, flow::GOrder<R, 0>, true, true>(lds, g, S, E); }
            else if (st == 2) { pg8::Gemm g{H, (const bf16*)(ws + WS_WQ0), T, 2048, 2048, 2048}; EpiPlain E{(bf16*)(ws + WS_Q1), 2048};
                flow::GOrder<R, 2> S{lds, &fq, t}; pg8::gemm_phase<EpiPlain, flow::GOrder<R, 2>, true, true>(lds, g, S, E); }
            else if (st == 4) { pg8::Gemm g{H, (const bf16*)(ws + WS_WIN1), T, 3840, 2048, 2048}; EpiQKV1 E{ws, tab128};
                flow::GOrder<R, 4> S{lds, &fq, t}; pg8::gemm_phase<EpiQKV1, flow::GOrder<R, 4>, true, true>(lds, g, S, E); }
            else if (st == 1) {
                flow::acquire();
                int tid_ = threadIdx.x; asm volatile("" : "+v"(tid_));
                const int lane = tid_ & 63, wave = __builtin_amdgcn_readfirstlane(tid_ >> 6);
                const float* md = mod + (size_t)1 * 2 * 6144; const float* gg = A.in[4] + (size_t)1 * 2048;
                for (int i = 0; i < 8; ++i) { const int row = rt * 256 + ix * 64 + wave * 8 + i; adaln_row_bf((const bf16*)(ws + WS_XB) + (size_t)row * 2048, gg, md + (size_t)(row >> 13) * 6144, H + (size_t)row * 2048, lane); }
                flow::publish<false>(flow::arrive_ctr(fq, 1, rt), nullptr);
            } else {
                flow::acquire();
                peer_tile<0>(lds, rt * 8 + ix, 0, xbar);
                flow::publish<false>(flow::arrive_ctr(fq, 3, rt), flow::pact_ctr(fq, xq));
            }
        }
    }
#else
#if RESID_IN_NORM
    if (PH(4)) REP(4) { pg8::Gemm g{ATT, (const bf16*)(ws + WS_WOUT0), T, 2048, 2048, 2048}; pg8::StaticOrder S; S.init(T, 2048, G, bx);
        EpiGate E{(bf16*)(ws + WS_Y), mod + 4096}; pg8::gemm_phase<EpiGate, pg8::StaticOrder, true, true>(lds, g, S, E); }
    SEAM(4);
    if (PH(5)) { phase_adaln_add<true>(kargs(), A.in[0], 1, vcu, G); }
#else
    if (PH(4)) REP(4) { pg8::Gemm g{ATT, (const bf16*)(ws + WS_WOUT0), T, 2048, 2048, 2048}; pg8::StaticOrder S; S.init(T, 2048, G, bx);
        EpiResid<true> E{A.in[0], (bf16*)(ws + WS_XB), mod + 4096}; pg8::gemm_phase<EpiResid<true>, pg8::StaticOrder, true, true>(lds, g, S, E); }
    SEAM(4);
    if (PH(5)) REP(5) { phase_adaln_bf(kargs(), 1, vcu, G); }
#endif
    SEAM(5);
    if (PH(6)) REP(6) { pg8::Gemm g{H, (const bf16*)(ws + WS_WQ0), T, 2048, 2048, 2048}; pg8::StaticOrder S; S.init(T, 2048, G, bx);
        EpiPlain E{(bf16*)(ws + WS_Q1), 2048}; pg8::gemm_phase<EpiPlain, pg8::StaticOrder, true, true>(lds, g, S, E); }
    SEAM(6);
    if (PH(7)) REP(7) {
        if (REPEAT_PHASE == 7 && rep_ == 0 && PEER_HALF_PROBE >= 2) {
            if (((bx >> 3) & 1) == 0) { if (PEER_HALF_PROBE == 2) for (int tile = vcu; tile < 512; tile += G) peer_tile<0, true, false>(lds, tile, 0, xbar); }
            else { const int c = (bx >> 4) * 8 + (bx & 7);
                for (int r2 = 0; r2 < 2; ++r2) { pg8::Gemm g{H, (const bf16*)(ws + WS_WQ0), T, 2048, 2048, 2048}; pg8::StaticOrder S; S.init(T, 2048, 128, c);
                    EpiPlain E{ATT, 2048}; pg8::gemm_phase<EpiPlain, pg8::StaticOrder, true, true>(lds, g, S, E); } }
        } else
        for (int tile = vcu; tile < 512; tile += G)
            if (REPEAT_PHASE == 7 && rep_ == 0) { if (!(PEER_HALF_PROBE) || ((bx >> 3) & 1) == 0) peer_tile<0, true, (PEER_SELONLY != 0)>(lds, tile, 0, xbar); }
            else peer_tile<0>(lds, tile, 0, xbar);
    }
    SEAM(7);
    if (PH(8)) REP(8) { pg8::Gemm g{H, (const bf16*)(ws + WS_WIN1), T, 3840, 2048, 2048}; pg8::StaticOrder S; S.init(T, 3840, G, bx);
        EpiQKV1 E{ws, tab128}; pg8::gemm_phase<EpiQKV1, pg8::StaticOrder, true, true>(lds, g, S, E); }
#endif
    if (DEFER_PRO && PH(8) && bx >= 192 && G == 256) {
        __syncthreads();
        const int lane = threadIdx.x & 63, wv = __builtin_amdgcn_readfirstlane(threadIdx.x >> 6);
        LAS float* scr = (LAS float*)(lds + wv * 16384);
        for (int it = (bx - 192) * NWAVES + wv; it < 4096; it += 64 * NWAVES) {
            if (it < 2048) transpose_item(A.in[11], 2048, 2048, (bf16*)(ws + WS_WOUT1), 0, scr, it, lane);
            else transpose_item(A.in[15] + (size_t)2048 * 2048, 2048, 2048, (bf16*)(ws + WS_WQ1), 0, scr, it - 2048, lane);
        }
        __syncthreads();
    }
    SEAM(8);
    if (PH(9) && bx >= 16) {
        const int lane = threadIdx.x & 63, wv = __builtin_amdgcn_readfirstlane(threadIdx.x >> 6);
#pragma unroll 1
        for (int half = 0; half < 2; ++half) {
            if ((half == 0) == (((bx >> 3) & 1) == 0 || !P9_ALT)) {
                for (int un = bx - 16; un < 1024; un += G - 16) nsa_window_unit(lds, un >> 9, (un >> 8) & 1, un & 255);
                __syncthreads();
            } else {
                const int cvi = (P9_SKIP5 && G == 256) ? bx - 80 : bx - 16, cvn = (P9_SKIP5 && G == 256) ? 176 : G - 16;
                if (cvi >= 0)
                for (int r = 2 * 16384 + cvi * NWAVES + wv; r < 4 * 16384; r += 2 * cvn * NWAVES) {
                    const int r2 = r + cvn * NWAVES; const bool two = r2 < 4 * 16384;
                    const int tb = r >> 14, e = r & 16383; const float* src = (tb & 1 ? A.in[18] : A.in[17]) + ((size_t)(tb >> 1) * 16384 + e) * 2048;
                    const int rr = two ? r2 : r, tb2 = rr >> 14, e2 = rr & 16383; const float* src2 = (tb2 & 1 ? A.in[18] : A.in[17]) + ((size_t)(tb2 >> 1) * 16384 + e2) * 2048;
                    f32x4 pa[8], pb[8];
#if CONV_COAL
                    { f32x4 ra[8], rb[8]; row_load_coal(src, ra, lane); row_load_coal(src2, rb, lane); LAS float* xs = (LAS float*)lds + wv * 4608; row_xpose(ra, pa, xs, lane); row_xpose(rb, pb, xs + 2304, lane); }
#else
                    row_to_fp6_pre(src, pa, lane); row_to_fp6_pre(src2, pb, lane);
#endif
                    row_to_fp6(src, ws + WS_TAB + (size_t)tb * 24 * MiB + (size_t)e * 1536, (float*)(ws + WS_TSCALE) + r, lane, &pa);
                    if (two) row_to_fp6(src2, ws + WS_TAB + (size_t)tb2 * 24 * MiB + (size_t)e2 * 1536, (float*)(ws + WS_TSCALE) + rr, lane, &pb);
                }
            }
        }
    }
    if (PH(9)) REP(9) { pg8::Gemm g{(const bf16*)(ws + WS_KCVC), (const bf16*)(ws + WS_W1T), 4096, 512, 4096, 2048}; CmpOrder S{bx};
        EpiCmp1 E{(bf16*)(ws + WS_HID), (const float*)(ws + WS_BIAS1)}; pg8::gemm_phase<EpiCmp1, CmpOrder, false, true>(lds, g, S, E); }
    SEAM(9);
    if (PH(10)) { pg8::Gemm g{(const bf16*)(ws + WS_HID), (const bf16*)(ws + WS_W2T), 4096, 512, 256, 256}; CmpOrder S{bx};
        EpiCmp2 E{(bf16*)(ws + WS_KCMP), (bf16*)(ws + WS_VCMP), tab128}; pg8::gemm_phase<EpiCmp2, CmpOrder, false, true>(lds, g, S, E); }
    SEAM(10);
    if (PH(11)) REP(11) {
        if (vcu < 256) {
#pragma unroll 1
            for (int i = 0; i < 4; ++i) nsa_unit(lds, i >> 1, i & 1, (i & 1) ? 255 - vcu : vcu);
        }
    }
    SEAM(11);
#if FLOW2
    if (PH(12)) {
        using R = flow::R2;
        flow::Q fq{(unsigned*)(ws + flow::WS_FLOW) + R::BASE, (int)(xbar.x & 7u), 0u};
        for (int t = flow::pop<R, false>(lds, fq, -1); t >= 0; t = flow::pop<R, false>(lds, fq, -1)) {
            const int xq = (t >> 24) & 7, st = (t >> 16) & 255, rt = (t >> 8) & 255, ix = t & 255;
            if (st == 0) { pg8::Gemm g{ATT, (const bf16*)(ws + WS_WOUT1), T, 2048, 2048, 2048}; EpiResid<false> E{(const bf16*)(ws + WS_XB), (bf16*)(ws + WS_XB), mod + (size_t)2 * 2 * 6144 + 4096};
                flow::GOrder<R, 0> S{lds, &fq, t}; pg8::gemm_phase<EpiResid<false>, flow::GOrder<R, 0>, true, true>(lds, g, S, E); }
            else if (st == 2) { pg8::Gemm g{H, (const bf16*)(ws + WS_WQ1), T, 2048, 2048, 2048}; EpiPlain E{(bf16*)(ws + WS_Q1), 2048};
                flow::GOrder<R, 2> S{lds, &fq, t}; pg8::gemm_phase<EpiPlain, flow::GOrder<R, 2>, true, true>(lds, g, S, E); }
            else if (st == 1) {
                flow::acquire();
                int tid_ = threadIdx.x; asm volatile("" : "+v"(tid_));
                const int lane = tid_ & 63, wave = __builtin_amdgcn_readfirstlane(tid_ >> 6);
                const float* md = mod + (size_t)3 * 2 * 6144; const float* gg = A.in[4] + (size_t)3 * 2048;
                for (int i = 0; i < 8; ++i) { const int row = rt * 256 + ix * 64 + wave * 8 + i; adaln_row_bf((const bf16*)(ws + WS_XB) + (size_t)row * 2048, gg, md + (size_t)(row >> 13) * 6144, H + (size_t)row * 2048, lane); }
                flow::publish<false>(flow::arrive_ctr(fq, 1, rt), nullptr);
            } else {
                flow::acquire();
                peer_tile<1>(lds, rt * 8 + ix, 1, xbar);
                flow::publish<false>(flow::arrive_ctr(fq, 3, rt), flow::pact_ctr(fq, xq));
            }
        }
    }
#else
#if RESID_IN_NORM
    if (PH(12)) REP(12) { pg8::Gemm g{ATT, (const bf16*)(ws + WS_WOUT1), T, 2048, 2048, 2048}; pg8::StaticOrder S; S.init(T, 2048, G, bx);
        EpiGate E{(bf16*)(ws + WS_Y), mod + (size_t)2 * 2 * 6144 + 4096}; pg8::gemm_phase<EpiGate, pg8::StaticOrder, true, true>(lds, g, S, E); }
    SEAM(12);
    if (PH(13)) phase_adaln_add<false>(kargs(), ws + WS_XB, 3, vcu, G);
#else
    if (PH(12)) REP(12) { pg8::Gemm g{ATT, (const bf16*)(ws + WS_WOUT1), T, 2048, 2048, 2048}; pg8::StaticOrder S; S.init(T, 2048, G, bx);
        EpiResid<false> E{(const bf16*)(ws + WS_XB), (bf16*)(ws + WS_XB), mod + (size_t)2 * 2 * 6144 + 4096}; pg8::gemm_phase<EpiResid<false>, pg8::StaticOrder, true, true>(lds, g, S, E); }
    SEAM(12);
    if (PH(13)) phase_adaln_bf(kargs(), 3, vcu, G);
#endif
    SEAM(13);
    if (PH(14)) REP(14) { pg8::Gemm g{H, (const bf16*)(ws + WS_WQ1), T, 2048, 2048, 2048}; pg8::StaticOrder S; S.init(T, 2048, G, bx);
        EpiPlain E{(bf16*)(ws + WS_Q1), 2048}; pg8::gemm_phase<EpiPlain, pg8::StaticOrder, true, true>(lds, g, S, E); }
    SEAM(14);
    if (PH(15)) REP(15) {
        for (int tile = vcu; tile < 512; tile += G)
            peer_tile<1>(lds, tile, 1, xbar);
    }
#endif
    SEAM(15);
    if (PH(16)) phase_final(kargs(), (STOP_AFTER < 4) ? A.in[0] : (const float*)xbuf, vcu, G);
#undef PH
#undef SEAM
#undef A
#undef ws
#undef mod
#undef tab64
#undef tab128
#undef H
#undef ATT
#undef xbuf
}

extern "C" void kernel_launch(void* const* d_in, const int* in_sizes, int n_in, void* d_out, int out_size, void* d_ws, size_t ws_size, hipStream_t stream) {
    static int grid = 0;
    if (grid == 0) {
        if (n_in != 20 || out_size != T * DM || ws_size < WS_END) { fprintf(stderr, "kernel_launch: unexpected problem (n_in %d out %d ws %zu)\n", n_in, out_size, ws_size); grid = -1; return; }
        int dev = 0, cus = 0, per_cu = 0;
        hipGetDevice(&dev); hipDeviceGetAttribute(&cus, hipDeviceAttributeMultiprocessorCount, dev);
        hipFuncSetAttribute((const void*)fwd_kernel, hipFuncAttributeMaxDynamicSharedMemorySize, LDS_BYTES);
        hipOccupancyMaxActiveBlocksPerMultiprocessor(&per_cu, (const void*)fwd_kernel, NTHREADS, LDS_BYTES);
        (void)hipGetLastError();
        if (per_cu < 1) { fprintf(stderr, "kernel_launch: occupancy query says %d blocks per CU\n", per_cu); per_cu = 1; }
        grid = cus;
        if (grid > 256) grid = 256;
    }
    if (grid < 0) return;
    (void)hipMemsetAsync((char*)d_ws + WS_CTL, 0, 65536, stream);
    Args a{};
    for (int i = 0; i < 20; ++i) a.in[i] = (const float*)d_in[i];
    a.out = (float*)d_out; a.ws = (unsigned char*)d_ws;
#if N_LAUNCH_MODE == 1
    a.ph_lo = 0; a.ph_hi = (STOP_AFTER < 15) ? N_PHASES : 16;
    if (STOP_AFTER < 15) {
        a.ph_hi = STOP_AFTER + 1; void* args1[] = {&a};
        hipLaunchCooperativeKernel((const void*)fwd_kernel, dim3(grid), dim3(NTHREADS), args1, LDS_BYTES, stream);
        Args b = a; b.ph_lo = 16; b.ph_hi = 17; void* args2[] = {&b};
        hipLaunchCooperativeKernel((const void*)fwd_kernel, dim3(grid), dim3(NTHREADS), args2, LDS_BYTES, stream);
    } else {
        void* args[] = {&a};
        hipError_t e = hipLaunchCooperativeKernel((const void*)fwd_kernel, dim3(grid), dim3(NTHREADS), args, LDS_BYTES, stream);
        if (e != hipSuccess) fprintf(stderr, "cooperative launch failed: %s (grid %d)\n", hipGetErrorString(e), grid);
    }
#else
    for (int p = 0; p < N_PHASES; ++p) {
        if (p > STOP_AFTER && p != 16) continue;
        if (p == 16 && STOP_AFTER >= 15) continue;
        Args b = a; b.ph_lo = p; b.ph_hi = p + 1;
        hipLaunchKernelGGL(fwd_kernel, dim3(grid), dim3(NTHREADS), LDS_BYTES, stream, b);
    }
#endif
}
```

```cpp
#include <hip/hip_runtime.h>
#include <hip/hip_cooperative_groups.h>
#include <cstdio>
#include <cstdint>
namespace pg8 {
#define PG8_LAS __attribute__((address_space(3)))
typedef unsigned short bf16_t;
typedef short bf16x8 __attribute__((ext_vector_type(8)));
typedef float f32x4 __attribute__((ext_vector_type(4)));
typedef unsigned u32x4 __attribute__((ext_vector_type(4)));
constexpr int BM = 256, BK = 64, HALF = 128, HTB = HALF * BK * 2  , STAGE_BYTES = 8 * HTB, NXCD = 8, WGM = 8;

__host__ __device__ __forceinline__ int lds_byte(int r, int c) { const int st = (r >> 4) * 2 + (c >> 5), rr = r & 15, cc = c & 31, ob = rr * 64 + cc * 2; return st * 1024 + (ob ^ (((ob >> 9) & 1) << 5)); }
__host__ __device__ __forceinline__ void stage_rc(int b, int& R, int& C) { const int st = b / 1024, sb = b % 1024, swz = sb ^ (((sb >> 9) & 1) << 5); R = (st >> 1) * 16 + swz / 64; C = (st & 1) * 32 + (swz % 64) / 2; }
__host__ __device__ __forceinline__ int perm32(int rho) { const int n = rho >> 4, i = rho & 15; return 8 * (i >> 2) + 4 * n + (i & 3); }

struct Unit { int pm, pn; };
struct Gemm { const bf16_t* A; const bf16_t* Bt; int M, N, K, lda; };

struct StaticOrder {
    int nM, nN, nwg, G, c;
    __host__ __device__ void init(int M, int N, int G_, int c_) { nM = M / BM; nN = N / BM; nwg = nM * nN; G = G_; c = c_; }
    __host__ __device__ bool next(int i, Unit& u) const {
        const long L = (long)i * G + c; if (L >= nwg) return false;
        int wgid = (int)L; { const int q = nwg / NXCD, r = nwg % NXCD, xcd = wgid % NXCD, off = wgid / NXCD; wgid = (xcd < r ? xcd * (q + 1) : r * (q + 1) + (xcd - r) * q) + off; }
        const int nig = WGM * nN, gid = wgid / nig, fm = gid * WGM, gsz = (nM - fm) < WGM ? (nM - fm) : WGM;
        u.pm = fm + ((wgid % nig) % gsz); u.pn = (wgid % nig) / gsz; return true;
    }
    __device__ __forceinline__ void a_ready(const Unit&) const {}
    __device__ __forceinline__ void done(const Unit&) const {}
};

__device__ __forceinline__ unsigned cvt_pk_bf16(float lo, float hi) { unsigned r; asm volatile("v_cvt_pk_bf16_f32 %0, %1, %2" : "=v"(r) : "v"(lo), "v"(hi)); return r; }
typedef float f32x2 __attribute__((ext_vector_type(2)));
template <class Epi, class Sched, bool ALIGN_EPI = false, bool SP2 = false>
__device__ __forceinline__ void gemm_phase(PG8_LAS unsigned char* lds, const Gemm g, Sched& S, const Epi& E) {
    int tid_ = threadIdx.x; asm volatile("" : "+v"(tid_));
    const int tid = tid_, wid = __builtin_amdgcn_readfirstlane(tid >> 6), lane = tid & 63, wr = wid >> 2, wc = wid & 3, fr = lane & 15, fq = lane >> 4;
    const int K = g.K, nt = K / BK, LDA = g.lda;
    unsigned voffA[2], voffB[2];
#pragma unroll
    for (int i = 0; i < 2; ++i) { int R, C; stage_rc(tid * 16 + i * 8192, R, C); const int Rb = Epi::PERM ? ((R & ~31) + perm32(R & 31)) : R;
        voffA[i] = (unsigned)(R * LDA + C) * 2u; voffB[i] = (unsigned)(Rb * K + C) * 2u; }
    const size_t kstep = (size_t)(BK * 2);
    const size_t hstepB = (size_t)HALF * K * 2, hstepA = (size_t)HALF * LDA * 2;
    const size_t tstepA = 2 * hstepA, tstepB = 2 * hstepB;
    const unsigned ldsw = (unsigned)wid * 1024u;
    const int aoff = lds_byte(wr * 64 + fr, fq * 8), boff = lds_byte(wc * 32 + fr, fq * 8);
#define PG8_SA(b, h) (((b) * 2 + (h)) * HTB)
#define PG8_SB(b, h) ((4 + (b) * 2 + (h)) * HTB)
#define PG8_STAGE(bufoff, gbase, voff) do { _Pragma("unroll") for (int _i = 0; _i < 2; ++_i) \
        __builtin_amdgcn_global_load_lds((const unsigned*)((const char*)(gbase) + (voff)[_i]), (PG8_LAS unsigned*)(lds + (bufoff) + ldsw + _i * 8192), 16, 0, 0); } while (0)
#define PG8_LDA(dst, b, h) do { _Pragma("unroll") for (int m = 0; m < 4; ++m) _Pragma("unroll") for (int k = 0; k < 2; ++k) dst[m][k] = *(const PG8_LAS bf16x8*)(lds + PG8_SA(b, h) + aoff + m * 2048 + k * 1024); } while (0)
#define PG8_LDB(dst, b, h) do { _Pragma("unroll") for (int n = 0; n < 2; ++n) _Pragma("unroll") for (int k = 0; k < 2; ++k) dst[n][k] = *(const PG8_LAS bf16x8*)(lds + PG8_SB(b, h) + boff + n * 2048 + k * 1024); } while (0)
#define PG8_MMA(ai, bj, At, Bt) do { __builtin_amdgcn_s_setprio(1); _Pragma("unroll") for (int m = 0; m < 4; ++m) _Pragma("unroll") for (int n = 0; n < 2; ++n) _Pragma("unroll") for (int k = 0; k < 2; ++k) \
        acc[ai][bj][m][n] = __builtin_amdgcn_mfma_f32_16x16x32_bf16(Bt[n][k], At[m][k], acc[ai][bj][m][n], 0, 0, 0); __builtin_amdgcn_s_setprio(0); } while (0)
#define PG8_WAIT_V(n) asm volatile("s_waitcnt vmcnt(" #n ")" ::: "memory")
#define PG8_WAIT_L(n) asm volatile("s_waitcnt lgkmcnt(" #n ")" ::: "memory")
#define PG8_BAR __builtin_amdgcn_s_barrier()
#define PG8_SCHED __builtin_amdgcn_sched_barrier(0)
    Unit cur, nxt; int ui = 0;
    if (!S.next(0, cur)) return;
    f32x4 acc[2][2][4][2];
#pragma unroll
    for (int a = 0; a < 2; ++a)
#pragma unroll
        for (int b = 0; b < 2; ++b)
#pragma unroll
            for (int m = 0; m < 4; ++m)
#pragma unroll
                for (int n = 0; n < 2; ++n) acc[a][b][m][n] = (f32x4){0.f, 0.f, 0.f, 0.f};
    bf16x8 At[4][2], B0[2][2], B1[2][2];
    const char* cA = (const char*)g.A + (size_t)cur.pm * tstepA; const char* cB = (const char*)g.Bt + (size_t)cur.pn * tstepB;
    S.a_ready(cur);
    if constexpr (SP2) {
        PG8_STAGE(PG8_SB(0, 0), cB, voffB); PG8_STAGE(PG8_SB(0, 1), cB + hstepB, voffB); PG8_STAGE(PG8_SA(0, 0), cA, voffA); PG8_STAGE(PG8_SA(0, 1), cA + hstepA, voffA);
        if (wr == 1) PG8_BAR;
        PG8_WAIT_V(2); PG8_BAR;
        PG8_STAGE(PG8_SB(1, 0), cB + kstep, voffB); PG8_STAGE(PG8_SA(1, 0), cA + kstep, voffA); PG8_STAGE(PG8_SB(1, 1), cB + hstepB + kstep, voffB);
        PG8_WAIT_V(6); PG8_BAR;
    } else {
        PG8_STAGE(PG8_SB(0, 0), cB, voffB); PG8_STAGE(PG8_SA(0, 0), cA, voffA); PG8_STAGE(PG8_SB(0, 1), cB + hstepB, voffB); PG8_STAGE(PG8_SA(0, 1), cA + hstepA, voffA);
        if (wr == 1) PG8_BAR;
        PG8_WAIT_V(4); PG8_BAR;
        PG8_STAGE(PG8_SB(1, 0), cB + kstep, voffB); PG8_STAGE(PG8_SA(1, 0), cA + kstep, voffA); PG8_STAGE(PG8_SB(1, 1), cB + hstepB + kstep, voffB);
        PG8_WAIT_V(6); PG8_BAR;
    }
    for (;;) {
        const bool has_next = S.next(ui + 1, nxt);
        const char* nA = has_next ? (const char*)g.A + (size_t)nxt.pm * tstepA : cA; const char* nB = has_next ? (const char*)g.Bt + (size_t)nxt.pn * tstepB : cB;
        for (int t = 0; t < nt; t += 2) {
            const bool last = (t == nt - 2);
            const char* a1 = cA + (size_t)(t + 1) * kstep;
            const char* a2 = last ? nA : cA + (size_t)(t + 2) * kstep; const char* b2 = last ? nB : cB + (size_t)(t + 2) * kstep;
            const char* a3 = a2 + kstep; const char* b3 = b2 + kstep;
            if (last && has_next) S.a_ready(nxt);
            if constexpr (SP2) {
            PG8_LDB(B0, 0, 0); PG8_LDB(B1, 0, 1); PG8_SCHED; PG8_LDA(At, 0, 0); PG8_STAGE(PG8_SA(1, 1), a1 + hstepA, voffA);
            PG8_WAIT_V(8); PG8_WAIT_L(0); PG8_BAR; PG8_MMA(0, 0, At, B0); PG8_MMA(0, 1, At, B1); PG8_BAR; PG8_SCHED;
            PG8_LDA(At, 0, 1); PG8_STAGE(PG8_SB(0, 0), b2, voffB); PG8_STAGE(PG8_SB(0, 1), b2 + hstepB, voffB); PG8_STAGE(PG8_SA(0, 0), a2, voffA);
            PG8_WAIT_V(8); PG8_WAIT_L(0); PG8_BAR; PG8_MMA(1, 0, At, B0); PG8_MMA(1, 1, At, B1); PG8_BAR; PG8_SCHED;
            PG8_LDB(B0, 1, 0); PG8_LDB(B1, 1, 1); PG8_SCHED; PG8_LDA(At, 1, 0); PG8_STAGE(PG8_SA(0, 1), a2 + hstepA, voffA);
            PG8_WAIT_V(8); PG8_WAIT_L(0); PG8_BAR; PG8_MMA(0, 0, At, B0); PG8_MMA(0, 1, At, B1); PG8_BAR; PG8_SCHED;
            PG8_LDA(At, 1, 1); PG8_STAGE(PG8_SB(1, 0), b3, voffB); PG8_STAGE(PG8_SB(1, 1), b3 + hstepB, voffB); PG8_STAGE(PG8_SA(1, 0), a3, voffA);
            PG8_WAIT_V(8); PG8_WAIT_L(0); PG8_BAR; PG8_MMA(1, 0, At, B0); PG8_MMA(1, 1, At, B1); PG8_BAR; PG8_SCHED;
            } else {
            PG8_LDB(B0, 0, 0); PG8_SCHED; PG8_LDA(At, 0, 0); PG8_STAGE(PG8_SA(1, 1), a1 + hstepA, voffA);
            PG8_WAIT_L(8); PG8_BAR; PG8_WAIT_L(0); PG8_MMA(0, 0, At, B0); PG8_BAR; PG8_SCHED;
            PG8_LDB(B1, 0, 1); PG8_STAGE(PG8_SB(0, 0), b2, voffB);
            PG8_BAR; PG8_WAIT_L(0); PG8_MMA(0, 1, At, B1); PG8_BAR;
            PG8_LDA(At, 0, 1); PG8_STAGE(PG8_SA(0, 0), a2, voffA);
            PG8_BAR; PG8_WAIT_L(0); PG8_MMA(1, 0, At, B0); PG8_BAR; PG8_SCHED;
            PG8_STAGE(PG8_SB(0, 1), b2 + hstepB, voffB);
            PG8_WAIT_V(6); PG8_BAR; PG8_MMA(1, 1, At, B1); PG8_BAR;
            PG8_LDB(B0, 1, 0); PG8_SCHED; PG8_LDA(At, 1, 0); PG8_STAGE(PG8_SA(0, 1), a2 + hstepA, voffA);
            PG8_WAIT_L(8); PG8_BAR; PG8_WAIT_L(0); PG8_MMA(0, 0, At, B0); PG8_BAR; PG8_SCHED;
            PG8_LDB(B1, 1, 1); PG8_STAGE(PG8_SB(1, 0), b3, voffB);
            PG8_BAR; PG8_WAIT_L(0); PG8_MMA(0, 1, At, B1); PG8_BAR;
            PG8_LDA(At, 1, 1); PG8_STAGE(PG8_SA(1, 0), a3, voffA);
            PG8_BAR; PG8_WAIT_L(0); PG8_MMA(1, 0, At, B0); PG8_BAR; PG8_SCHED;
            PG8_STAGE(PG8_SB(1, 1), b3 + hstepB, voffB);
            PG8_WAIT_V(6); PG8_BAR; PG8_MMA(1, 1, At, B1); PG8_BAR;
            }
        }
        if constexpr (ALIGN_EPI) { if (wr == 0) PG8_BAR; }
        if constexpr (!Epi::AFTER_DRAIN) { E(acc, cur, wr, wc, fr, fq); S.done(cur); }
        if (!has_next) break;
#pragma unroll
        for (int a = 0; a < 2; ++a)
#pragma unroll
            for (int b = 0; b < 2; ++b)
#pragma unroll
                for (int m = 0; m < 4; ++m)
#pragma unroll
                    for (int n = 0; n < 2; ++n) acc[a][b][m][n] = (f32x4){0.f, 0.f, 0.f, 0.f};
        cur = nxt; cA = nA; cB = nB; ++ui;
        if constexpr (ALIGN_EPI) { if (wr == 1) PG8_BAR; }
    }
    PG8_WAIT_V(0);
    if constexpr (!ALIGN_EPI) { if (wr == 0) PG8_BAR; }
    PG8_BAR;
    if constexpr (Epi::AFTER_DRAIN) { E.fused(acc, cur, wr, wc, fr, fq, lds, wid, lane); S.done(cur); }
#undef PG8_SA
#undef PG8_SB
#undef PG8_STAGE
#undef PG8_LDA
#undef PG8_LDB
#undef PG8_MMA
#undef PG8_WAIT_V
#undef PG8_WAIT_L
#undef PG8_BAR
#undef PG8_SCHED
}
}

namespace cg = cooperative_groups;
#define LAS __attribute__((address_space(3)))
typedef unsigned short bf16;
typedef short bf16x8 __attribute__((ext_vector_type(8)));
typedef short s16x4 __attribute__((ext_vector_type(4)));
typedef float f32x2 __attribute__((ext_vector_type(2)));
typedef float f32x4 __attribute__((ext_vector_type(4)));
typedef float f32x16 __attribute__((ext_vector_type(16)));
typedef unsigned u32x2 __attribute__((ext_vector_type(2)));
typedef unsigned u32x4 __attribute__((ext_vector_type(4)));
typedef __bf16 bf16x2_t __attribute__((ext_vector_type(2)));

constexpr int NB = 2, SEQ = 8192, T = NB * SEQ, DM = 2048;
constexpr float LOG2E = 1.4426950408889634f;
constexpr float NORM_EPS = 1e-6f;
constexpr int NTHREADS = 512, NWAVES = 8;
constexpr int LDS_BYTES = 160 * 1024;
constexpr float NEG_BIG = -1e30f;

constexpr size_t MiB = 1u << 20;
constexpr size_t WS_CTL = 0;
constexpr size_t WS_ROWSQ = 656 * MiB;
constexpr size_t WS_SW = 1 * MiB + 512 * 1024;
constexpr size_t WS_MOD = 1 * MiB;
constexpr size_t WS_TAB64 = 2 * MiB;
constexpr size_t WS_TAB128 = 4 * MiB;
constexpr size_t WS_BIAS1 = 8 * MiB;
constexpr size_t WS_SUBK = 9 * MiB;
constexpr size_t WS_W2T = 10 * MiB;
constexpr size_t WS_W1T = 11 * MiB;
constexpr size_t WS_WIN0 = 16 * MiB;
constexpr size_t WS_WOUT0 = 34 * MiB;
constexpr size_t WS_WIN1 = 42 * MiB;
constexpr size_t WS_WOUT1 = 57 * MiB;
constexpr size_t WS_WQ0 = 65 * MiB;
constexpr size_t WS_WQ1 = 73 * MiB;
constexpr size_t WS_SLOT = 81 * MiB;
constexpr size_t WS_U0 = 128 * MiB;
constexpr size_t WS_TAB = WS_U0;
constexpr size_t WS_TSCALE = WS_U0 + 128 * MiB;
constexpr size_t WS_H = 384 * MiB;
constexpr size_t WS_ATT = 448 * MiB;
constexpr size_t WS_QKV = 512 * MiB;
constexpr size_t WS_Q1 = 512 * MiB;
constexpr size_t WS_KSL = 576 * MiB;
constexpr size_t WS_VSL = 584 * MiB;
constexpr size_t WS_KW = 592 * MiB;
constexpr size_t WS_VW = 600 * MiB;
constexpr size_t WS_KCVC = 608 * MiB;
constexpr size_t WS_GATES = 626 * MiB;
constexpr size_t WS_HID = 630 * MiB;
constexpr size_t WS_KCMP = 633 * MiB;
constexpr size_t WS_VCMP = 634 * MiB;
constexpr size_t WS_Y = 576 * MiB;
constexpr size_t WS_XB = 656 * MiB;
constexpr size_t WS_END = 720 * MiB;

__device__ __forceinline__ unsigned cvtpk(float lo, float hi) { f32x2 v = {lo, hi}; bf16x2_t b = __builtin_convertvector(v, bf16x2_t); return __builtin_bit_cast(unsigned, b); }
__device__ __forceinline__ float bf2f(unsigned short b) { return __uint_as_float((unsigned)b << 16); }
__device__ __forceinline__ float bflo(unsigned w) { return __uint_as_float(w << 16); }
__device__ __forceinline__ float bfhi(unsigned w) { return __uint_as_float(w & 0xffff0000u); }
__device__ __forceinline__ float wave_sum(float v) {
#pragma unroll
    for (int o = 1; o < 64; o <<= 1) v += __shfl_xor(v, o);
    return v;
}
__device__ __forceinline__ float sum32(float v) {
    auto rr = __builtin_amdgcn_permlane32_swap(__float_as_uint(v), __float_as_uint(v), false, false);
    return __uint_as_float(rr[0]) + __uint_as_float(rr[1]);
}
__device__ __forceinline__ float max32(float v) {
    auto rr = __builtin_amdgcn_permlane32_swap(__float_as_uint(v), __float_as_uint(v), false, false);
    return fmaxf(__uint_as_float(rr[0]), __uint_as_float(rr[1]));
}
__device__ __forceinline__ float gelu_tanh(float x) {
    const float u = 0.7978845608028654f * (x + 0.044715f * x * x * x);
    const float e = __expf(2.f * u);
    const float th = 1.f - 2.f * __builtin_amdgcn_rcpf(e + 1.f);
    return 0.5f * x * (1.f + th);
}
__device__ __forceinline__ float sigmoidf_(float x) { return 1.f / (1.f + __expf(-x)); }
__device__ __forceinline__ float siluf_(float x) { return x / (1.f + __expf(-x)); }

#ifndef NT_ONCE
#define NT_ONCE 0
#endif
__device__ __forceinline__ void gemv_item(const LAS float* sv, int K, const float* W, int ldw, int col0, LAS float* red, float* out0, float* out1, const float* bias) {
    const int tid = threadIdx.x, lane = tid & 63, w = __builtin_amdgcn_readfirstlane(tid >> 6);
    const int kw = K / 8, kb = w * kw;
    float a00 = 0.f, a01 = 0.f, a10 = 0.f, a11 = 0.f;
    const float* wp = W + (size_t)kb * ldw + col0 + 2 * lane;
#pragma unroll 32
    for (int k = 0; k < kw; ++k) {
        const f32x2 wv = NT_ONCE ? __builtin_nontemporal_load((const f32x2*)(wp + (size_t)k * ldw)) : *(const f32x2*)(wp + (size_t)k * ldw);
        const float s0 = sv[kb + k], s1 = sv[K + kb + k];
        a00 += s0 * wv.x; a01 += s0 * wv.y; a10 += s1 * wv.x; a11 += s1 * wv.y;
    }
    red[(w * 2 + 0) * 128 + 2 * lane] = a00; red[(w * 2 + 0) * 128 + 2 * lane + 1] = a01;
    red[(w * 2 + 1) * 128 + 2 * lane] = a10; red[(w * 2 + 1) * 128 + 2 * lane + 1] = a11;
    __syncthreads();
    if (tid < 256) {
        const int v = tid >> 7, c = tid & 127; float s = 0.f;
#pragma unroll
        for (int ww = 0; ww < 8; ++ww) s += red[(ww * 2 + v) * 128 + c];
        if (bias) s += bias[col0 + c];
        (v == 0 ? out0 : out1)[col0 + c] = s;
    }
    __syncthreads();
}
__device__ __forceinline__ int rope64_pos(int n) { const int d = n & 63; return (n & ~63) | ((d < 32) ? 2 * d : 2 * (d - 32) + 1); }
__device__ __forceinline__ int rope128_pos(int n) { const int d = n & 127; return (n & ~127) | ((d < 64) ? 2 * d : 2 * (d - 64) + 1); }
__device__ __forceinline__ int dst_row(int mode, int n) {
    if (mode == 1) {
        if (n < 2048) return rope64_pos(n);
        if (n < 3072) return n;
        if (n < 4352) return rope64_pos(n);
        return n;
    }
    if (mode == 2) {
        if (n < 2048) return rope128_pos(n);
        if (n < 2560) return n;
        if (n < 2816) return rope128_pos(n);
        if (n < 3072) return n;
        if (n < 3328) return rope128_pos(n);
        return n;
    }
    if (mode == 3) return rope128_pos(n);
    return n;
}
__device__ __forceinline__ void transpose_item(const float* W, int K, int N, bf16* WT, int mode, LAS float* scr, int item, int lane) {
    const int nblk = (N + 31) / 32, kb = item / nblk, nb = item % nblk, k0 = 64 * kb, n0 = 32 * nb;
    const int nn = n0 + (lane & 31); const bool okn = nn < N;
    float tv[32];
#pragma unroll
    for (int i = 0; i < 32; ++i) { const int kk = 2 * i + (lane >> 5); tv[i] = okn ? (NT_ONCE ? __builtin_nontemporal_load(W + (size_t)(k0 + kk) * N + nn) : W[(size_t)(k0 + kk) * N + nn]) : 0.f; }
#pragma unroll
    for (int i = 0; i < 32; ++i) { const int kk = 2 * i + (lane >> 5); scr[kk * 33 + (lane & 31)] = tv[i]; }
    asm volatile("s_waitcnt lgkmcnt(0)" ::: "memory");
    const int c = lane & 7;
#pragma unroll
    for (int j = 0; j < 4; ++j) {
        const int nl = (lane >> 3) + 8 * j, n = n0 + nl; const LAS float* s = scr + (8 * c) * 33 + nl;
        u32x4 o; o.x = cvtpk(s[0 * 33], s[1 * 33]); o.y = cvtpk(s[2 * 33], s[3 * 33]); o.z = cvtpk(s[4 * 33], s[5 * 33]); o.w = cvtpk(s[6 * 33], s[7 * 33]);
        if (n < N) *(u32x4*)(WT + (size_t)dst_row(mode, n) * K + k0 + 8 * c) = o;
    }
    asm volatile("s_waitcnt lgkmcnt(0)" ::: "memory");
}

__device__ __forceinline__ void adaln_row(const float* xrow, const float* g, const float* mod, bf16* hrow, int lane) {
    f32x4 v[8]; float ss = 0.f;
#pragma unroll
    for (int j = 0; j < 4; ++j) {
        v[2 * j] = *(const f32x4*)(xrow + lane * 8 + 512 * j); v[2 * j + 1] = *(const f32x4*)(xrow + lane * 8 + 512 * j + 4);
        ss += v[2 * j].x * v[2 * j].x + v[2 * j].y * v[2 * j].y + v[2 * j].z * v[2 * j].z + v[2 * j].w * v[2 * j].w;
        ss += v[2 * j + 1].x * v[2 * j + 1].x + v[2 * j + 1].y * v[2 * j + 1].y + v[2 * j + 1].z * v[2 * j + 1].z + v[2 * j + 1].w * v[2 * j + 1].w;
    }
    const float r = 1.0f / sqrtf(wave_sum(ss) * (1.f / DM) + NORM_EPS);
#pragma unroll
    for (int j = 0; j < 4; ++j) {
        const int idx = lane * 8 + 512 * j;
        f32x4 o[2];
#pragma unroll
        for (int q = 0; q < 2; ++q) {
            const f32x4 gg = *(const f32x4*)(g + idx + 4 * q), sh = *(const f32x4*)(mod + idx + 4 * q), sc = *(const f32x4*)(mod + 2048 + idx + 4 * q);
            o[q] = v[2 * j + q] * r * gg * (1.f + sc) + sh;
        }
        u32x4 w; w.x = cvtpk(o[0].x, o[0].y); w.y = cvtpk(o[0].z, o[0].w); w.z = cvtpk(o[1].x, o[1].y); w.w = cvtpk(o[1].z, o[1].w);
        *(u32x4*)(hrow + idx) = w;
    }
}
__device__ __forceinline__ void adaln_row2(const float* xa, const float* xb, const float* g, const float* moda, const float* modb, bf16* ha, bf16* hb, int lane) {
    f32x4 va[8], vb[8]; float sa = 0.f, sb = 0.f;
#pragma unroll
    for (int j = 0; j < 8; ++j) { va[j] = *(const f32x4*)(xa + lane * 8 + 512 * (j >> 1) + 4 * (j & 1)); vb[j] = *(const f32x4*)(xb + lane * 8 + 512 * (j >> 1) + 4 * (j & 1)); }
#pragma unroll
    for (int j = 0; j < 8; ++j) { sa += va[j].x * va[j].x + va[j].y * va[j].y + va[j].z * va[j].z + va[j].w * va[j].w; sb += vb[j].x * vb[j].x + vb[j].y * vb[j].y + vb[j].z * vb[j].z + vb[j].w * vb[j].w; }
    const float ra = 1.0f / sqrtf(wave_sum(sa) * (1.f / DM) + NORM_EPS), rb = 1.0f / sqrtf(wave_sum(sb) * (1.f / DM) + NORM_EPS);
#pragma unroll
    for (int j = 0; j < 4; ++j) {
        const int idx = lane * 8 + 512 * j;
        f32x4 oa[2], ob[2];
#pragma unroll
        for (int q = 0; q < 2; ++q) {
            const f32x4 gg = *(const f32x4*)(g + idx + 4 * q);
            oa[q] = va[2 * j + q] * ra * gg * (1.f + *(const f32x4*)(moda + 2048 + idx + 4 * q)) + *(const f32x4*)(moda + idx + 4 * q);
            ob[q] = vb[2 * j + q] * rb * gg * (1.f + *(const f32x4*)(modb + 2048 + idx + 4 * q)) + *(const f32x4*)(modb + idx + 4 * q);
        }
        u32x4 w; w.x = cvtpk(oa[0].x, oa[0].y); w.y = cvtpk(oa[0].z, oa[0].w); w.z = cvtpk(oa[1].x, oa[1].y); w.w = cvtpk(oa[1].z, oa[1].w);
        *(u32x4*)(ha + idx) = w;
        w.x = cvtpk(ob[0].x, ob[0].y); w.y = cvtpk(ob[0].z, ob[0].w); w.z = cvtpk(ob[1].x, ob[1].y); w.w = cvtpk(ob[1].z, ob[1].w);
        *(u32x4*)(hb + idx) = w;
    }
}
__device__ __forceinline__ void adaln_row_bf(const bf16* xrow, const float* g, const float* mod, bf16* hrow, int lane) {
    f32x4 v[8]; float ss = 0.f;
#pragma unroll
    for (int j = 0; j < 4; ++j) {
        const u32x4 w = *(const u32x4*)(xrow + lane * 8 + 512 * j);
        v[2 * j] = (f32x4){bflo(w.x), bfhi(w.x), bflo(w.y), bfhi(w.y)}; v[2 * j + 1] = (f32x4){bflo(w.z), bfhi(w.z), bflo(w.w), bfhi(w.w)};
        ss += v[2 * j].x * v[2 * j].x + v[2 * j].y * v[2 * j].y + v[2 * j].z * v[2 * j].z + v[2 * j].w * v[2 * j].w;
        ss += v[2 * j + 1].x * v[2 * j + 1].x + v[2 * j + 1].y * v[2 * j + 1].y + v[2 * j + 1].z * v[2 * j + 1].z + v[2 * j + 1].w * v[2 * j + 1].w;
    }
    const float r = 1.0f / sqrtf(wave_sum(ss) * (1.f / DM) + NORM_EPS);
#pragma unroll
    for (int j = 0; j < 4; ++j) {
        const int idx = lane * 8 + 512 * j;
        f32x4 o[2];
#pragma unroll
        for (int q = 0; q < 2; ++q) {
            const f32x4 gg = *(const f32x4*)(g + idx + 4 * q), sh = *(const f32x4*)(mod + idx + 4 * q), sc = *(const f32x4*)(mod + 2048 + idx + 4 * q);
            o[q] = v[2 * j + q] * r * gg * (1.f + sc) + sh;
        }
        u32x4 w; w.x = cvtpk(o[0].x, o[0].y); w.y = cvtpk(o[0].z, o[0].w); w.z = cvtpk(o[1].x, o[1].y); w.w = cvtpk(o[1].z, o[1].w);
        *(u32x4*)(hrow + idx) = w;
    }
}
__device__ __forceinline__ void final_row(const float* xrow, const float* g, float* orow, int lane) {
    f32x4 v[8]; float ss = 0.f;
#pragma unroll
    for (int j = 0; j < 8; ++j) { v[j] = *(const f32x4*)(xrow + lane * 8 + 512 * (j >> 1) + 4 * (j & 1)); ss += v[j].x * v[j].x + v[j].y * v[j].y + v[j].z * v[j].z + v[j].w * v[j].w; }
    const float r = 1.0f / sqrtf(wave_sum(ss) * (1.f / DM) + NORM_EPS);
#pragma unroll
    for (int j = 0; j < 8; ++j) { const int idx = lane * 8 + 512 * (j >> 1) + 4 * (j & 1); const f32x4 gg = *(const f32x4*)(g + idx); *(f32x4*)(orow + idx) = v[j] * r * gg; }
}

#define EPI_ROWS_BEGIN _Pragma("unroll") for (int ai = 0; ai < 2; ++ai) { _Pragma("unroll") for (int m = 0; m < 4; ++m) { const int row = u.pm * 256 + wr * 64 + fr + ai * 128 + m * 16; _Pragma("unroll") for (int bj = 0; bj < 2; ++bj) { \
        const int col = u.pn * 256 + bj * 128 + wc * 32 + 8 * fq; f32x4 v0 = acc[ai][bj][m][0], v1 = acc[ai][bj][m][1];
#define EPI_ROWS_END } } }
#define EPI_HALVES _Pragma("unroll") for (int ai = 0; ai < 2; ++ai)
#define EPI_CHUNKS _Pragma("unroll") for (int m = 0; m < 4; ++m) _Pragma("unroll") for (int bj = 0; bj < 2; ++bj)
#define EPI_RC const int ci = m * 2 + bj, row = u.pm * 256 + wr * 64 + fr + ai * 128 + m * 16, col = u.pn * 256 + bj * 128 + wc * 32 + 8 * fq; (void)ci;
#ifndef EPI_BATCH
#define EPI_BATCH 0
#endif
__device__ __forceinline__ void rope8t(f32x4& v0, f32x4& v1, const f32x4& t0, const f32x4& t1) {
    f32x4 a, b;
    a.x = v0.x * t0.x - v0.y * t0.y; a.y = v0.y * t0.x + v0.x * t0.y;
    a.z = v0.z * t0.z - v0.w * t0.w; a.w = v0.w * t0.z + v0.z * t0.w;
    b.x = v1.x * t1.x - v1.y * t1.y; b.y = v1.y * t1.x + v1.x * t1.y;
    b.z = v1.z * t1.z - v1.w * t1.w; b.w = v1.w * t1.z + v1.z * t1.w;
    v0 = a; v1 = b;
}
__device__ __forceinline__ void rope8(f32x4& v0, f32x4& v1, const f32x2* tab) {
    const f32x4 t0 = *(const f32x4*)tab, t1 = *(const f32x4*)(tab + 2);
    f32x4 a, b;
    a.x = v0.x * t0.x - v0.y * t0.y; a.y = v0.y * t0.x + v0.x * t0.y;
    a.z = v0.z * t0.z - v0.w * t0.w; a.w = v0.w * t0.z + v0.z * t0.w;
    b.x = v1.x * t1.x - v1.y * t1.y; b.y = v1.y * t1.x + v1.x * t1.y;
    b.z = v1.z * t1.z - v1.w * t1.w; b.w = v1.w * t1.z + v1.z * t1.w;
    v0 = a; v1 = b;
}
__device__ __forceinline__ u32x4 pack8(const f32x4& v0, const f32x4& v1) { u32x4 w; w.x = cvtpk(v0.x, v0.y); w.y = cvtpk(v0.z, v0.w); w.z = cvtpk(v1.x, v1.y); w.w = cvtpk(v1.z, v1.w); return w; }

constexpr float QSCALE64 = 0.125f * LOG2E;
constexpr float QSCALE128 = 0.08838834764831845f * LOG2E;

struct EpiQKV0 {
    static constexpr bool PERM = true, AFTER_DRAIN = false;
    bf16* out; const f32x2* tab64;
    __device__ __forceinline__ void operator()(const f32x4 (&acc)[2][2][4][2], const pg8::Unit& u, int wr, int wc, int fr, int fq) const {
        const int pn = u.pn;
        const bool rope = (pn < 8) || (pn >= 12 && pn < 17);
        const float sc = (pn < 4 || (pn >= 12 && pn < 16)) ? QSCALE64 : 1.f;
#if EPI_BATCH
        EPI_HALVES {
            f32x4 t0[8], t1[8];
            if (rope) {
                EPI_CHUNKS { EPI_RC const f32x2* tp = tab64 + (size_t)(row & (SEQ - 1)) * 32 + ((col & 63) >> 1); t0[ci] = *(const f32x4*)tp; t1[ci] = *(const f32x4*)(tp + 2); }
#pragma unroll
                for (int c8 = 0; c8 < 8; ++c8) { asm volatile("" : "+v"(t0[c8])); asm volatile("" : "+v"(t1[c8])); }
            }
            EPI_CHUNKS { EPI_RC f32x4 v0 = acc[ai][bj][m][0], v1 = acc[ai][bj][m][1];
                if (rope) rope8t(v0, v1, t0[ci], t1[ci]);
                v0 = v0 * sc; v1 = v1 * sc;
                *(u32x4*)(out + (size_t)row * 4608 + col) = pack8(v0, v1); }
        }
#else
        EPI_ROWS_BEGIN
            if (rope) rope8(v0, v1, tab64 + (size_t)(row & (SEQ - 1)) * 32 + ((col & 63) >> 1));
            v0 = v0 * sc; v1 = v1 * sc;
            *(u32x4*)(out + (size_t)row * 4608 + col) = pack8(v0, v1);
        EPI_ROWS_END
#endif
    }
};
struct EpiQKV1 {
    static constexpr bool PERM = true, AFTER_DRAIN = false;
    unsigned char* ws; const f32x2* tab128;
    __device__ __forceinline__ void operator()(const f32x4 (&acc)[2][2][4][2], const pg8::Unit& u, int wr, int wc, int fr, int fq) const {
        const int pn = u.pn;
        const bool rope = (pn < 8) || pn == 10 || pn == 12;
#if EPI_BATCH
        EPI_HALVES {
            f32x4 t0[8], t1[8];
            if (rope) {
                EPI_CHUNKS { EPI_RC const f32x2* tp = tab128 + (size_t)(row & (SEQ - 1)) * 64 + ((col & 127) >> 1); t0[ci] = *(const f32x4*)tp; t1[ci] = *(const f32x4*)(tp + 2); }
#pragma unroll
                for (int c8 = 0; c8 < 8; ++c8) { asm volatile("" : "+v"(t0[c8])); asm volatile("" : "+v"(t1[c8])); }
            }
            EPI_CHUNKS { EPI_RC f32x4 v0 = acc[ai][bj][m][0], v1 = acc[ai][bj][m][1];
            if (rope) rope8t(v0, v1, t0[ci], t1[ci]);
            if (pn < 8) { v0 = v0 * QSCALE128; v1 = v1 * QSCALE128; *(u32x4*)((bf16*)(ws + WS_Q1) + (size_t)row * 2048 + col) = pack8(v0, v1); }
            else if (pn < 10) {
                const int c = col & 255, h = c >> 7, d0 = c & 127, b = row >> 13, s = row & (SEQ - 1);
                *(u32x4*)((bf16*)(ws + WS_KCVC) + ((((size_t)(pn - 8) * 2 + b) * 2 + h) * SEQ + s) * 128 + d0) = pack8(v0, v1);
            } else if (pn < 14) {
                const size_t off = (pn == 10) ? WS_KSL : (pn == 11) ? WS_VSL : (pn == 12) ? WS_KW : WS_VW;
                *(u32x4*)((bf16*)(ws + off) + (size_t)row * 256 + (col & 255)) = pack8(v0, v1);
            } else {
                const int c = col - 3584;
                if (c < 48) { float* gp = (float*)(ws + WS_GATES) + (size_t)row * 48 + c;
                    f32x4 a, b2; a.x = sigmoidf_(v0.x); a.y = sigmoidf_(v0.y); a.z = sigmoidf_(v0.z); a.w = sigmoidf_(v0.w);
                    b2.x = sigmoidf_(v1.x); b2.y = sigmoidf_(v1.y); b2.z = sigmoidf_(v1.z); b2.w = sigmoidf_(v1.w);
                    *(f32x4*)gp = a; *(f32x4*)(gp + 4) = b2; }
            }
            }
        }
#else
        EPI_ROWS_BEGIN
            if (rope) rope8(v0, v1, tab128 + (size_t)(row & (SEQ - 1)) * 64 + ((col & 127) >> 1));
            if (pn < 8) { v0 = v0 * QSCALE128; v1 = v1 * QSCALE128; *(u32x4*)((bf16*)(ws + WS_Q1) + (size_t)row * 2048 + col) = pack8(v0, v1); }
            else if (pn < 10) {
                const int c = col & 255, h = c >> 7, d0 = c & 127, b = row >> 13, s = row & (SEQ - 1);
                *(u32x4*)((bf16*)(ws + WS_KCVC) + ((((size_t)(pn - 8) * 2 + b) * 2 + h) * SEQ + s) * 128 + d0) = pack8(v0, v1);
            } else if (pn < 14) {
                const size_t off = (pn == 10) ? WS_KSL : (pn == 11) ? WS_VSL : (pn == 12) ? WS_KW : WS_VW;
                *(u32x4*)((bf16*)(ws + off) + (size_t)row * 256 + (col & 255)) = pack8(v0, v1);
            } else {
                const int c = col - 3584;
                if (c < 48) { float* gp = (float*)(ws + WS_GATES) + (size_t)row * 48 + c;
                    f32x4 a, b2; a.x = sigmoidf_(v0.x); a.y = sigmoidf_(v0.y); a.z = sigmoidf_(v0.z); a.w = sigmoidf_(v0.w);
                    b2.x = sigmoidf_(v1.x); b2.y = sigmoidf_(v1.y); b2.z = sigmoidf_(v1.z); b2.w = sigmoidf_(v1.w);
                    *(f32x4*)gp = a; *(f32x4*)(gp + 4) = b2; }
            }
        EPI_ROWS_END
#endif
    }
};
struct EpiGate {
    static constexpr bool PERM = true, AFTER_DRAIN = false;
    bf16* y; const float* gate;
    __device__ __forceinline__ void operator()(const f32x4 (&acc)[2][2][4][2], const pg8::Unit& u, int wr, int wc, int fr, int fq) const {
        EPI_ROWS_BEGIN
            const float* gp = gate + (size_t)(row >> 13) * 6144 + col;
            const f32x4 g0 = *(const f32x4*)gp, g1 = *(const f32x4*)(gp + 4);
            *(u32x4*)(y + (size_t)row * 2048 + col) = pack8(g0 * v0, g1 * v1);
        EPI_ROWS_END
    }
};
template <bool XOLD_F32>
struct EpiResid {
    static constexpr bool PERM = true, AFTER_DRAIN = false;
    const void* xold; bf16* xnew; const float* gate;
    __device__ __forceinline__ void operator()(const f32x4 (&acc)[2][2][4][2], const pg8::Unit& u, int wr, int wc, int fr, int fq) const {
#if EPI_BATCH
        const float* gp0 = gate + (size_t)((u.pm * 256) >> 13) * 6144 + u.pn * 256 + wc * 32 + 8 * fq;
        f32x4 gg[2][2];
#pragma unroll
        for (int bj = 0; bj < 2; ++bj) { gg[bj][0] = *(const f32x4*)(gp0 + bj * 128); gg[bj][1] = *(const f32x4*)(gp0 + bj * 128 + 4); }
        EPI_HALVES {
            if (XOLD_F32) {
                f32x4 x0[8], x1[8];
                EPI_CHUNKS { EPI_RC const float* xp = (const float*)xold + (size_t)row * 2048 + col; x0[ci] = *(const f32x4*)xp; x1[ci] = *(const f32x4*)(xp + 4); }
#pragma unroll
                for (int c8 = 0; c8 < 8; ++c8) { asm volatile("" : "+v"(x0[c8])); asm volatile("" : "+v"(x1[c8])); }
                EPI_CHUNKS { EPI_RC const f32x4 v0 = acc[ai][bj][m][0], v1 = acc[ai][bj][m][1];
                    *(u32x4*)(xnew + (size_t)row * 2048 + col) = pack8(x0[ci] + gg[bj][0] * v0, x1[ci] + gg[bj][1] * v1); }
            } else {
                u32x4 xw[8];
                EPI_CHUNKS { EPI_RC xw[ci] = *(const u32x4*)((const bf16*)xold + (size_t)row * 2048 + col); }
#pragma unroll
                for (int c8 = 0; c8 < 8; ++c8) asm volatile("" : "+v"(xw[c8]));
                EPI_CHUNKS { EPI_RC const f32x4 v0 = acc[ai][bj][m][0], v1 = acc[ai][bj][m][1]; const u32x4 w = xw[ci];
                    const f32x4 x0 = {bflo(w.x), bfhi(w.x), bflo(w.y), bfhi(w.y)}, x1 = {bflo(w.z), bfhi(w.z), bflo(w.w), bfhi(w.w)};
                    *(u32x4*)(xnew + (size_t)row * 2048 + col) = pack8(x0 + gg[bj][0] * v0, x1 + gg[bj][1] * v1); }
            }
        }
#else
        EPI_ROWS_BEGIN
            const float* gp = gate + (size_t)(row >> 13) * 6144 + col;
            const f32x4 g0 = *(const f32x4*)gp, g1 = *(const f32x4*)(gp + 4);
            f32x4 x0, x1;
            if (XOLD_F32) { const float* xp = (const float*)xold + (size_t)row * 2048 + col; x0 = *(const f32x4*)xp; x1 = *(const f32x4*)(xp + 4); }
            else { const u32x4 w = *(const u32x4*)((const bf16*)xold + (size_t)row * 2048 + col); x0 = (f32x4){bflo(w.x), bfhi(w.x), bflo(w.y), bfhi(w.y)}; x1 = (f32x4){bflo(w.z), bfhi(w.z), bflo(w.w), bfhi(w.w)}; }
            *(u32x4*)(xnew + (size_t)row * 2048 + col) = pack8(x0 + g0 * v0, x1 + g1 * v1);
        EPI_ROWS_END
#endif
    }
};
#ifndef QNT
#define QNT 0
#endif
struct EpiPlain {
    static constexpr bool PERM = true, AFTER_DRAIN = false;
    bf16* out; int ld;
    __device__ __forceinline__ void operator()(const f32x4 (&acc)[2][2][4][2], const pg8::Unit& u, int wr, int wc, int fr, int fq) const {
        EPI_ROWS_BEGIN
#if QNT
            __builtin_nontemporal_store(pack8(v0, v1), (u32x4*)(out + (size_t)row * ld + col));
#else
            *(u32x4*)(out + (size_t)row * ld + col) = pack8(v0, v1);
#endif
        EPI_ROWS_END
    }
};
struct EpiCmp1 {
    static constexpr bool PERM = true, AFTER_DRAIN = false;
    bf16* hid; const float* bias1;
    __device__ __forceinline__ void operator()(const f32x4 (&acc)[2][2][4][2], const pg8::Unit& u, int wr, int wc, int fr, int fq) const {
        EPI_ROWS_BEGIN
            const int c = col & 255; const float* bp = bias1 + u.pn * 256 + c;
            const f32x4 b0 = *(const f32x4*)bp, b1 = *(const f32x4*)(bp + 4);
            v0 = v0 + b0; v1 = v1 + b1;
            v0.x = gelu_tanh(v0.x); v0.y = gelu_tanh(v0.y); v0.z = gelu_tanh(v0.z); v0.w = gelu_tanh(v0.w);
            v1.x = gelu_tanh(v1.x); v1.y = gelu_tanh(v1.y); v1.z = gelu_tanh(v1.z); v1.w = gelu_tanh(v1.w);
            *(u32x4*)(hid + (size_t)row * 256 + c) = pack8(v0, v1);
        EPI_ROWS_END
    }
};
struct EpiCmp2 {
    static constexpr bool PERM = true, AFTER_DRAIN = false;
    bf16* kcmp; bf16* vcmp; const f32x2* tab128;
    __device__ __forceinline__ void operator()(const f32x4 (&acc)[2][2][4][2], const pg8::Unit& u, int wr, int wc, int fr, int fq) const {
        EPI_ROWS_BEGIN
            const int c = col & 255;
            if (c < 128) {
                const int r = row & 2047;
                if (u.pn == 0) { int pos = 16 * (r & 511) + 31; pos = pos > SEQ - 1 ? SEQ - 1 : pos; rope8(v0, v1, tab128 + (size_t)pos * 64 + (c >> 1)); }
                *(u32x4*)((u.pn == 0 ? kcmp : vcmp) + (size_t)r * 128 + c) = pack8(v0, v1);
            }
        EPI_ROWS_END
    }
};
struct CmpOrder {
    int c;
    __device__ __forceinline__ bool next(int i, pg8::Unit& u) const { if (i > 0 || c >= 16) return false; u.pm = c; u.pn = c >> 3; return true; }
    __device__ __forceinline__ void a_ready(const pg8::Unit&) const {}
    __device__ __forceinline__ void done(const pg8::Unit&) const {}
};

__device__ __forceinline__ int crow(int r, int hi) { return (r & 3) + 8 * (r >> 2) + 4 * hi; }
__device__ __forceinline__ float max3f(float a, float b, float c) { float r; asm("v_max3_f32 %0, %1, %2, %3" : "=v"(r) : "v"(a), "v"(b), "v"(c)); return r; }
__device__ __forceinline__ float max2f(float a, float b) { float r; asm("v_max_f32_e32 %0, %1, %2" : "=v"(r) : "v"(a), "v"(b)); return r; }
#ifndef QK_INIT
#define QK_INIT 1
#endif
constexpr float RESCALE_THR = 8.0f;
typedef short v4i16_t __attribute__((ext_vector_type(4)));

template <int DQK, int DV> struct AT {
    static constexpr int KP = DQK + 8, VP = DV + 32;
    static constexpr int KBYTES = 64 * KP * 2, VBYTES = 64 * VP * 2;
    static constexpr int KCH = 64 * DQK / 8 / NTHREADS, VCH = 64 * DV / 8 / NTHREADS;
    static constexpr int KOFF = 0, VOFF = KBYTES;
    static constexpr int BYTES = KBYTES + VBYTES;
};

template <int DX, int NCH>
__device__ __forceinline__ void tile_load(u32x4 (&reg)[NCH], const bf16* g, int pitch, int key0, int kmax, int tid) {
    asm volatile("" : "+v"(tid));
#pragma unroll
    for (int i = 0; i < NCH; ++i) {
        const int id = tid + NTHREADS * i, row = id / (DX / 8), ch = id % (DX / 8);
        int key = key0 + row; key = key < 0 ? 0 : (key > kmax ? kmax : key);
        reg[i] = *(const u32x4*)(g + (size_t)key * pitch + ch * 8);
    }
}
template <int DX, int NCH, int PITCH = DX + 8>
__device__ __forceinline__ void tile_store(const u32x4 (&reg)[NCH], LAS unsigned char* l, int tid) {
    asm volatile("" : "+v"(tid));
#pragma unroll
    for (int i = 0; i < NCH; ++i) {
        const int id = tid + NTHREADS * i, row = id / (DX / 8), ch = id % (DX / 8);
        *(LAS u32x4*)(l + (row * PITCH + ch * 8) * 2) = reg[i];
    }
}
__device__ __forceinline__ void glds16(const void* gsrc, unsigned lds_dst) { unsigned keep;
    asm volatile("s_mov_b32 %0, m0\n\ts_mov_b32 m0, %2\n\ts_nop 0\n\tglobal_load_lds_dwordx4 %1, off\n\ts_mov_b32 m0, %0" : "=&s"(keep) : "v"(gsrc), "s"(lds_dst) : "memory"); }
template <int PITCH> struct DmaN { static constexpr int CPR = PITCH / 8, NI = 64 * CPR / 64, NIW = (NI + 7) / 8; static_assert((64 * PITCH * 2) % 1024 == 0, "tile image must be whole 1 KiB pieces"); };
template <int DX, int PITCH>
__device__ __forceinline__ void tile_dma(const bf16* g, int pitch, int key0, int kmax, unsigned lds_tile, unsigned lds_dump, int wave, int lane) {
    typedef DmaN<PITCH> D;
#pragma unroll
    for (int j = 0; j < D::NIW; ++j) {
        const int idx = j * 8 + wave; const bool ok = idx < D::NI;
        const int gch = (ok ? idx : 0) * 64 + lane, row = gch / D::CPR, ch = gch % D::CPR;
        int key = key0 + row; key = key < 0 ? 0 : (key > kmax ? kmax : key);
        const bf16* src = g + (size_t)key * pitch + (ch < DX / 8 ? ch : 0) * 8;
        glds16(src, (unsigned)__builtin_amdgcn_readfirstlane((int)(ok ? lds_tile + (unsigned)idx * 1024u : lds_dump)));
    }
}
template <int N> __device__ __forceinline__ void wait_bar() { asm volatile("s_waitcnt vmcnt(%0) lgkmcnt(0)\n\ts_barrier" :: "i"(N) : "memory"); }
__device__ __forceinline__ unsigned lds_addr(const LAS unsigned char* p) { return (unsigned)(__UINTPTR_TYPE__)p; }
template <int DQK, bool QL = false>
__device__ __forceinline__ void qk_tile(const LAS unsigned char* kl, const bf16x8 (&qf)[QL ? 1 : DQK / 16], f32x16& s0, f32x16& s1, int lane, const LAS unsigned char* ql = nullptr, float init = 0.f) {
    const int r32 = lane & 31, hi = lane >> 5;
    const LAS unsigned char* p = kl + (r32 * (DQK + 8) + hi * 8) * 2;
#pragma unroll
    for (int i = 0; i < 16; ++i) { s0[i] = init; s1[i] = init; }
#pragma unroll
    for (int sg = 0; sg < DQK / 64; ++sg) {
        bf16x8 a0[4], a1[4];
#pragma unroll
        for (int st = 0; st < 4; ++st) { a0[st] = *(const LAS bf16x8*)(p + (sg * 4 + st) * 32); a1[st] = *(const LAS bf16x8*)(p + 32 * (DQK + 8) * 2 + (sg * 4 + st) * 32); }
        __builtin_amdgcn_s_setprio(1);
#pragma unroll
        for (int st = 0; st < 4; ++st) {
            const bf16x8 qv = QL ? *(const LAS bf16x8*)(ql + (sg * 4 + st) * 32) : qf[QL ? 0 : sg * 4 + st];
            s0 = __builtin_amdgcn_mfma_f32_32x32x16_bf16(a0[st], qv, s0, 0, 0, 0);
            s1 = __builtin_amdgcn_mfma_f32_32x32x16_bf16(a1[st], qv, s1, 0, 0, 0);
        }
        __builtin_amdgcn_s_setprio(0);
        if (DQK > 64) __builtin_amdgcn_sched_barrier(0);
    }
}
__device__ __forceinline__ bf16x8 pfrag(const f32x16& p, int s) {
    u32x4 w; w.x = cvtpk(p[8 * s + 0], p[8 * s + 1]); w.y = cvtpk(p[8 * s + 2], p[8 * s + 3]); w.z = cvtpk(p[8 * s + 4], p[8 * s + 5]); w.w = cvtpk(p[8 * s + 6], p[8 * s + 7]);
    return __builtin_bit_cast(bf16x8, w);
}
template <int DV>
__device__ __forceinline__ void pv_tile(const LAS unsigned char* vl, const f32x16& p0, const f32x16& p1, f32x16 (&O)[DV / 32], int lane) {
    const int hi = lane >> 5, g1 = (lane >> 4) & 1, i = lane & 15, q = i >> 2, pp = i & 3;
    const LAS unsigned char* vb = vl + ((4 * hi + q) * (DV + 32) + 16 * g1 + 4 * pp) * 2;
    v4i16_t lo[2][DV / 32], hh[2][DV / 32];
#pragma unroll
    for (int dt = 0; dt < DV / 32; ++dt) { lo[0][dt] = __builtin_amdgcn_ds_read_tr16_b64_v4i16((LAS v4i16_t*)(vb + dt * 64)); hh[0][dt] = __builtin_amdgcn_ds_read_tr16_b64_v4i16((LAS v4i16_t*)(vb + dt * 64 + 8 * (DV + 32) * 2)); }
#pragma unroll
    for (int ks = 0; ks < 4; ++ks) {
        const bf16x8 pf = pfrag((ks & 2) ? p1 : p0, ks & 1);
        if (ks < 3) {
#pragma unroll
            for (int dt = 0; dt < DV / 32; ++dt) { const LAS unsigned char* a = vb + (16 * (ks + 1)) * (DV + 32) * 2 + dt * 64;
                lo[(ks + 1) & 1][dt] = __builtin_amdgcn_ds_read_tr16_b64_v4i16((LAS v4i16_t*)a); hh[(ks + 1) & 1][dt] = __builtin_amdgcn_ds_read_tr16_b64_v4i16((LAS v4i16_t*)(a + 8 * (DV + 32) * 2)); }
        }
        __builtin_amdgcn_s_setprio(1);
#pragma unroll
        for (int dt = 0; dt < DV / 32; ++dt) {
            const bf16x8 vf = __builtin_shufflevector(lo[ks & 1][dt], hh[ks & 1][dt], 0, 1, 2, 3, 4, 5, 6, 7);
            O[dt] = __builtin_amdgcn_mfma_f32_32x32x16_bf16(vf, pf, O[dt], 0, 0, 0);
        }
        __builtin_amdgcn_s_setprio(0);
        __builtin_amdgcn_sched_barrier(0);
    }
}
struct MaskCausal { int tpos; __device__ __forceinline__ bool full(int k0, bool) const { return k0 + 63 <= tpos; } __device__ __forceinline__ bool prep(int k0) const { return k0 <= tpos; } __device__ __forceinline__ bool valid(int k, bool) const { return k <= tpos; } };
struct MaskWindow { int tpos, w; __device__ __forceinline__ bool full(int k0, bool) const { return k0 + 63 <= tpos && k0 > tpos - w; } __device__ __forceinline__ bool prep(int k0) const { return k0 <= tpos && k0 + 63 > tpos - w; } __device__ __forceinline__ bool valid(int k, bool) const { return k <= tpos && k > tpos - w; } };
struct MaskCmp { int cmax; __device__ __forceinline__ bool full(int k0, bool) const { return k0 + 63 <= cmax; } __device__ __forceinline__ bool prep(int k0) const { return k0 <= cmax; } __device__ __forceinline__ bool valid(int k, bool) const { return k <= cmax; } };
struct MaskSel { int tpos; unsigned long long lo, hi2;
    __device__ __forceinline__ bool prep(int k0) const { const int j = k0 >> 6; return k0 <= tpos && (((j < 64 ? (lo >> j) : (hi2 >> (j - 64))) & 1ull) != 0ull); }
    __device__ __forceinline__ bool full(int k0, bool act) const { return act && k0 + 63 <= tpos; }
    __device__ __forceinline__ bool valid(int k, bool act) const { return act && k <= tpos; } };

template <class M> __device__ __forceinline__ float mask_tile(f32x16& s0, f32x16& s1, int key0, const M& mk, bool act, int lane) {
    const int hi = lane >> 5; float mx = -INFINITY;
    if (__all(mk.full(key0, act))) {
#pragma unroll
        for (int r = 0; r < 16; ++r) mx = max3f(mx, s0[r], s1[r]);
        return mx;
    }
#pragma unroll
    for (int r = 0; r < 16; ++r) {
        const int k = key0 + crow(r, hi);
        s0[r] = mk.valid(k, act) ? s0[r] : -INFINITY; s1[r] = mk.valid(k + 32, act) ? s1[r] : -INFINITY;
        mx = max3f(mx, s0[r], s1[r]);
    }
    return mx;
}
template <int DV> __device__ __forceinline__ void online_update(f32x16& s0, f32x16& s1, float mx, float& m, float& l, f32x16 (&O)[DV / 32], float c = 0.f) {
    mx = max32(mx) - c;
    const float mn = (mx - m > RESCALE_THR) ? mx : m, alpha = __builtin_amdgcn_exp2f(m - mn);
    const float d = mn + c;
    if (__any(d != 0.f)) {
#pragma unroll
        for (int r = 0; r < 16; ++r) { s0[r] -= d; s1[r] -= d; }
    }
    float ps = 0.f;
#pragma unroll
    for (int r = 0; r < 16; ++r) { s0[r] = __builtin_amdgcn_exp2f(s0[r]); s1[r] = __builtin_amdgcn_exp2f(s1[r]); ps += s0[r] + s1[r]; }
    l = l * alpha + ps; m = mn;
    if (__any(alpha != 1.f)) {
#pragma unroll
        for (int dt = 0; dt < DV / 32; ++dt)
#pragma unroll
            for (int r = 0; r < 16; ++r) O[dt][r] *= alpha;
    }
}

template <int DQK, bool QL>
__device__ __forceinline__ void qk_half(const LAS unsigned char* kl, const bf16x8 (&qf)[QL ? 1 : DQK / 16], f32x16& s, int kt, int lane, const LAS unsigned char* ql) {
    const int r32 = lane & 31, hi = lane >> 5;
    const LAS unsigned char* p = kl + ((kt * 32 + r32) * (DQK + 8) + hi * 8) * 2;
#pragma unroll
    for (int i = 0; i < 16; ++i) s[i] = 0.f;
#pragma unroll
    for (int sg = 0; sg < DQK / 64; ++sg) {
        bf16x8 a0[4];
#pragma unroll
        for (int st = 0; st < 4; ++st) a0[st] = *(const LAS bf16x8*)(p + (sg * 4 + st) * 32);
        __builtin_amdgcn_s_setprio(1);
#pragma unroll
        for (int st = 0; st < 4; ++st) { const bf16x8 qv = QL ? *(const LAS bf16x8*)(ql + (sg * 4 + st) * 32) : qf[QL ? 0 : sg * 4 + st]; s = __builtin_amdgcn_mfma_f32_32x32x16_bf16(a0[st], qv, s, 0, 0, 0); }
        __builtin_amdgcn_s_setprio(0);
        if (DQK > 64) __builtin_amdgcn_sched_barrier(0);
    }
}
template <class M> __device__ __forceinline__ float mask_half(f32x16& s, int key0, const M& mk, bool act, int lane, bool allfull) {
    const int hi = lane >> 5; float mx = -INFINITY;
    if (allfull) {
#pragma unroll
        for (int r = 0; r < 16; r += 2) mx = max3f(mx, s[r], s[r + 1]);
        return mx;
    }
#pragma unroll
    for (int r = 0; r < 16; ++r) { const int k = key0 + crow(r, hi); s[r] = mk.valid(k, act) ? s[r] : -INFINITY; mx = fmaxf(mx, s[r]); }
    return mx;
}
template <int DV> __device__ __forceinline__ void online_half(f32x16& s, float mx, float& m, float& l, f32x16 (&O)[DV / 32]) {
    mx = max32(mx);
    const float mn = (mx - m > RESCALE_THR) ? mx : m, alpha = __builtin_amdgcn_exp2f(m - mn);
    float ps = 0.f;
#pragma unroll
    for (int r = 0; r < 16; ++r) { s[r] = __builtin_amdgcn_exp2f(s[r] - mn); ps += s[r]; }
    l = l * alpha + ps; m = mn;
    if (__any(alpha != 1.f)) {
#pragma unroll
        for (int dt = 0; dt < DV / 32; ++dt)
#pragma unroll
            for (int r = 0; r < 16; ++r) O[dt][r] *= alpha;
    }
}
template <int DV>
__device__ __forceinline__ void pv_half(const LAS unsigned char* vl, const f32x16& p, int kt, f32x16 (&O)[DV / 32], int lane) {
    const int hi = lane >> 5, g1 = (lane >> 4) & 1, i = lane & 15, q = i >> 2, pp = i & 3;
    const LAS unsigned char* vb = vl + ((kt * 32 + 4 * hi + q) * (DV + 32) + 16 * g1 + 4 * pp) * 2;
#pragma unroll
    for (int ks = 0; ks < 2; ++ks) {
        const bf16x8 pf = pfrag(p, ks);
        v4i16_t lo[DV / 32], hh[DV / 32];
#pragma unroll
        for (int dt = 0; dt < DV / 32; ++dt) { const LAS unsigned char* a = vb + (16 * ks) * (DV + 32) * 2 + dt * 64;
            lo[dt] = __builtin_amdgcn_ds_read_tr16_b64_v4i16((LAS v4i16_t*)a); hh[dt] = __builtin_amdgcn_ds_read_tr16_b64_v4i16((LAS v4i16_t*)(a + 8 * (DV + 32) * 2)); }
        __builtin_amdgcn_s_setprio(1);
#pragma unroll
        for (int dt = 0; dt < DV / 32; ++dt) { const bf16x8 vf = __builtin_shufflevector(lo[dt], hh[dt], 0, 1, 2, 3, 4, 5, 6, 7); O[dt] = __builtin_amdgcn_mfma_f32_32x32x16_bf16(vf, pf, O[dt], 0, 0, 0); }
        __builtin_amdgcn_s_setprio(0);
        if (DV > 64) __builtin_amdgcn_sched_barrier(0);
    }
}
template <int DQK, int DV, class M, bool SPLIT = false, int TPS = 1, int NSLOT = 3>
__device__ __forceinline__ void attn_run(LAS unsigned char* lds, const bf16* Kg, int kpitch, const bf16* Vg, int vpitch, int kmax, int t_lo, int t_hi,
                                         const bf16x8 (&qf)[DQK / 16], f32x16 (&O)[DV / 32], float& m, float& l, const M& mk) {
    typedef AT<DQK, DV> A;
    constexpr int NT = (DmaN<A::KP>::NIW + DmaN<A::VP>::NIW) * TPS;
    constexpr int SB = A::BYTES * TPS;
    const int tid = threadIdx.x, lane = tid & 63, wave = __builtin_amdgcn_readfirstlane(tid >> 6);
    if (t_lo >= t_hi) return;
    const int ns = (t_hi - t_lo + TPS - 1) / TPS;
    const unsigned ring = lds_addr(lds), dump = ring + (unsigned)(NSLOT * SB);
#define ATT_DMA(st, slot) do { _Pragma("unroll 1") for (int u_ = 0; u_ < TPS; ++u_) { const int tt_ = t_lo + (st) * TPS + u_; \
        tile_dma<DQK, A::KP>(Kg, kpitch, tt_ * 64, kmax, ring + (unsigned)(slot) * SB + u_ * A::BYTES + A::KOFF, dump, wave, lane); \
        tile_dma<DV, A::VP>(Vg, vpitch, tt_ * 64, kmax, ring + (unsigned)(slot) * SB + u_ * A::BYTES + A::VOFF, dump, wave, lane); } } while (0)
    ATT_DMA(0, 0);
    if (NSLOT == 3) { if (1 < ns) { ATT_DMA(1, 1); wait_bar<NT>(); } else wait_bar<0>(); }
    else wait_bar<0>();
    int slot = 0;
#pragma unroll 1
    for (int s = 0; s < ns; ++s) {
        const int sn = (slot == 0) ? NSLOT - 1 : slot - 1;
        if (s + NSLOT - 1 < ns) ATT_DMA(s + NSLOT - 1, sn);
#pragma unroll 1
        for (int u = 0; u < TPS; ++u) {
            const int t = t_lo + s * TPS + u;
            LAS unsigned char* cur = lds + slot * SB + u * A::BYTES;
            const bool act = (t < t_hi) && mk.prep(t * 64);
            if (__any(act)) {
                if (SPLIT) {
                    const bool allfull = __all(mk.full(t * 64, act));
#pragma unroll
                    for (int kt = 0; kt < 2; ++kt) {
                        f32x16 sh;
                        qk_half<DQK, false>(cur + A::KOFF, qf, sh, kt, lane, nullptr);
                        const float mx = mask_half(sh, t * 64 + kt * 32, mk, act, lane, allfull);
                        online_half<DV>(sh, mx, m, l, O);
                        pv_half<DV>(cur + A::VOFF, sh, kt, O, lane);
                    }
                } else {
                    f32x16 s0, s1;
                    const float cinit = QK_INIT ? ((m > 0.5f * NEG_BIG) ? -m : 0.f) : 0.f;
                    qk_tile<DQK, false>(cur + A::KOFF, qf, s0, s1, lane, nullptr, cinit);
                    const float mx = mask_tile(s0, s1, t * 64, mk, act, lane);
                    online_update<DV>(s0, s1, mx, m, l, O, cinit);
                    pv_tile<DV>(cur + A::VOFF, s0, s1, O, lane);
                }
            }
        }
        if (NSLOT == 3 && s + 2 < ns) wait_bar<NT>(); else wait_bar<0>();
        slot = (slot == NSLOT - 1) ? 0 : slot + 1;
    }
#undef ATT_DMA
}
template <int DQK> __device__ __forceinline__ void load_q(bf16x8 (&qf)[DQK / 16], const bf16* qrow, int lane) {
    const int hi = lane >> 5;
#pragma unroll
    for (int st = 0; st < DQK / 16; ++st) qf[st] = *(const bf16x8*)(qrow + st * 16 + hi * 8);
#pragma unroll
    for (int st = 0; st < DQK / 16; ++st) asm volatile("" : "+v"(qf[st]));
}
#ifndef DA_TPS
#define DA_TPS 2
#define DA_NSLOT 2
#endif

__device__ __forceinline__ void da_unit(LAS unsigned char* lds, const bf16* qkv, bf16* att, int b, int h, int qb, float lam, const float* subln, float* slotbase) {
    const int tid = threadIdx.x, lane = tid & 63, wave = __builtin_amdgcn_readfirstlane(tid >> 6), r32 = lane & 31, hi = lane >> 5;
    const int tpos = qb * 256 + wave * 32 + r32; const size_t row = (size_t)b * SEQ + tpos;
    unsigned o0p[32];
    const bf16* base = qkv + (size_t)b * SEQ * 4608;
    f32x16 O[4]; float ss = 0.f;
#pragma unroll 1
    for (int map = 0; map < 2; ++map) {
        bf16x8 qf[4]; load_q<64>(qf, qkv + row * 4608 + map * 512 + h * 64, lane);
#pragma unroll
        for (int dt = 0; dt < 4; ++dt)
#pragma unroll
            for (int r = 0; r < 16; ++r) O[dt][r] = 0.f;
        float m = NEG_BIG, l = 0.f;
        attn_run<64, 128, MaskCausal, false, DA_TPS, DA_NSLOT>(lds, base + 1024 + map * 512 + h * 64, 4608, base + 2048 + h * 128, 4608, SEQ - 1, 0, 4 * (qb + 1), qf, O, m, l, MaskCausal{tpos});
        const float inv = 1.f / sum32(l);
        if (map == 0) {
#pragma unroll
            for (int dt = 0; dt < 4; ++dt)
#pragma unroll
                for (int r = 0; r < 16; r += 2) o0p[dt * 8 + (r >> 1)] = cvtpk(O[dt][r] * inv, O[dt][r + 1] * inv);
        } else {
#pragma unroll
            for (int dt = 0; dt < 4; ++dt)
#pragma unroll
                for (int r = 0; r < 16; r += 2) { const unsigned w = o0p[dt * 8 + (r >> 1)];
                    const float oa = bflo(w) - lam * (O[dt][r] * inv), ob = bfhi(w) - lam * (O[dt][r + 1] * inv); O[dt][r] = oa; O[dt][r + 1] = ob; ss += oa * oa + ob * ob; }
        }
    }
    const float rn = 1.0f / sqrtf(sum32(ss) * (1.f / 128.f) + NORM_EPS) * 0.8f;
    bf16* orow = att + row * 2048 + h * 128;
#pragma unroll
    for (int dt = 0; dt < 4; ++dt)
#pragma unroll
        for (int g4 = 0; g4 < 4; ++g4) {
            const int d = dt * 32 + 8 * g4 + 4 * hi; const f32x4 sg = *(const f32x4*)(subln + d);
            u32x2 w; w.x = cvtpk(O[dt][4 * g4] * rn * sg.x, O[dt][4 * g4 + 1] * rn * sg.y); w.y = cvtpk(O[dt][4 * g4 + 2] * rn * sg.z, O[dt][4 * g4 + 3] * rn * sg.w);
            *(u32x2*)(orow + d) = w;
        }
}
__device__ __forceinline__ void swa_unit(LAS unsigned char* lds, const bf16* qkv, bf16* att, int b, int kvh, int tb, const float* sinks) {
    const int tid = threadIdx.x, lane = tid & 63, wave = __builtin_amdgcn_readfirstlane(tid >> 6), c = lane & 31, hi = lane >> 5;
    const int t0 = tb * 64, tpos = t0 + wave * 8 + (c >> 2), qh = kvh * 4 + (c & 3); const size_t row = (size_t)b * SEQ + tpos;
    const bf16* base = qkv + (size_t)b * SEQ * 4608;
    bf16x8 qf[4]; load_q<64>(qf, qkv + row * 4608 + 3072 + qh * 64, lane);
    f32x16 O[2];
#pragma unroll
    for (int dt = 0; dt < 2; ++dt)
#pragma unroll
        for (int r = 0; r < 16; ++r) O[dt][r] = 0.f;
    float m = sinks[qh] * LOG2E, l = (hi == 0) ? 1.f : 0.f;
    asm volatile("" : "+v"(m));
    const int t_lo = tb >= 2 ? tb - 2 : 0;
    attn_run<64, 64, MaskWindow>(lds, base + 4096 + kvh * 64, 4608, base + 4352 + kvh * 64, 4608, SEQ - 1, t_lo, tb + 1, qf, O, m, l, MaskWindow{tpos, 128});
    const float inv = 1.f / sum32(l);
    bf16* orow = att + row * 2048 + 1024 + qh * 64;
#pragma unroll
    for (int dt = 0; dt < 2; ++dt)
#pragma unroll
        for (int g4 = 0; g4 < 4; ++g4) {
            const int d = dt * 32 + 8 * g4 + 4 * hi;
            u32x2 w; w.x = cvtpk(O[dt][4 * g4] * inv, O[dt][4 * g4 + 1] * inv); w.y = cvtpk(O[dt][4 * g4 + 2] * inv, O[dt][4 * g4 + 3] * inv);
            *(u32x2*)(orow + d) = w;
        }
}

__device__ __forceinline__ void swa_naive(const bf16* qkv, bf16* att, int b, int tpos, int qh, const float* sinks, int lane) {
    const size_t row = (size_t)b * SEQ + tpos; const int kvh = qh >> 2;
    const bf16* q = qkv + row * 4608 + 3072 + qh * 64;
    float sc[2];
#pragma unroll
    for (int j = 0; j < 2; ++j) {
        const int key = tpos - 127 + lane + 64 * j;
        float s = -INFINITY;
        if (key >= 0) { const bf16* k = qkv + ((size_t)b * SEQ + key) * 4608 + 4096 + kvh * 64; float a = 0.f; for (int d = 0; d < 64; ++d) a += bf2f(q[d]) * bf2f(k[d]); s = a; }
        sc[j] = s;
    }
    const float snk = sinks[qh] * LOG2E;
    float mx = fmaxf(fmaxf(sc[0], sc[1]), snk);
#pragma unroll
    for (int o = 1; o < 64; o <<= 1) mx = fmaxf(mx, __shfl_xor(mx, o));
    const float p0 = exp2f(sc[0] - mx), p1 = exp2f(sc[1] - mx);
    const float den = wave_sum(p0 + p1) + exp2f(snk - mx);
    float acc = 0.f;
    for (int kk = 0; kk < 128; ++kk) {
        const int key = tpos - 127 + kk; const float p = __shfl(kk < 64 ? p0 : p1, kk & 63);
        if (key >= 0) acc += p * bf2f(qkv[((size_t)b * SEQ + key) * 4608 + 4352 + kvh * 64 + lane]);
    }
    const float o = acc / den;
    att[row * 2048 + 1024 + qh * 64 + lane] = (bf16)(cvtpk(o, 0.f) & 0xffffu);
}

struct Args { const float* in[20]; float* out; unsigned char* ws; int ph_lo, ph_hi; };
typedef const __attribute__((address_space(4))) Args* KArgs;
__device__ __forceinline__ KArgs kargs() { KArgs p = (KArgs)__builtin_amdgcn_kernarg_segment_ptr(); asm volatile("" : "+s"(p)); return p; }

template <int CTRL> __device__ __forceinline__ float dppf(float v) { return __int_as_float(__builtin_amdgcn_update_dpp(0, __float_as_int(v), CTRL, 0xF, 0xF, false)); }
template <int CTRL> __device__ __forceinline__ unsigned dppu(unsigned v) { return (unsigned)__builtin_amdgcn_update_dpp(0, (int)v, CTRL, 0xF, 0xF, false); }
__device__ __forceinline__ float sum8(float v) { v += dppf<0xB1>(v); v += dppf<0x4E>(v); v += dppf<0x141>(v); return v; }
__device__ __forceinline__ unsigned wave_max_u32(unsigned v) {
    unsigned t;
    t = dppu<0xB1>(v); v = v > t ? v : t;
    t = dppu<0x4E>(v); v = v > t ? v : t;
    t = dppu<0x141>(v); v = v > t ? v : t;
    t = dppu<0x140>(v); v = v > t ? v : t;
    const unsigned a = __builtin_amdgcn_readlane(v, 0), b = __builtin_amdgcn_readlane(v, 16), c = __builtin_amdgcn_readlane(v, 32), d = __builtin_amdgcn_readlane(v, 48);
    const unsigned ab = a > b ? a : b, cd = c > d ? c : d;
    return ab > cd ? ab : cd;
}
__device__ __forceinline__ unsigned ordf(float f) { const unsigned u = __float_as_uint(f); return u ^ ((u >> 31) ? 0xFFFFFFFFu : 0x80000000u); }

#ifndef NSA_SPLIT
#define NSA_SPLIT false
#endif
#ifndef NSA_PROBE
#define NSA_PROBE 0
#endif
#ifndef CMP_INIT
#define CMP_INIT 1
#endif
constexpr int NSA_TILE = AT<128, 128>::BYTES;
constexpr int NSA_OUT = 2 * NSA_TILE + 1024;
constexpr int NSA_IMPA = NSA_OUT + 65536, NSA_IMPP = 132, NSA_SEL = NSA_IMPA + 32 * NSA_IMPP * 4;
static_assert(NSA_SEL + 512 <= LDS_BYTES && 3 * NSA_TILE + 1024 <= NSA_IMPA, "nsa lds map");

template <int PASS>
__device__ __forceinline__ void nsa_cmp_pass(LAS unsigned char* lds, const bf16* Kg, const bf16* Vg, int t_hi, const bf16x8 (&qf)[8], f32x16 (&O)[4], float& m, float& l, float invl, const MaskCmp& mk, int tl) {
    typedef AT<128, 128> A;
    constexpr int NT = DmaN<A::KP>::NIW + (PASS == 2 ? DmaN<A::VP>::NIW : 0);
    const int tid = threadIdx.x, lane = tid & 63, hi = lane >> 5, wave = __builtin_amdgcn_readfirstlane(tid >> 6);
    LAS float* impA = (LAS float*)(lds + NSA_IMPA);
    const unsigned ring = lds_addr(lds), dump = ring + 3u * A::BYTES;
#define CMP_DMA(t, slot) do { tile_dma<128, A::KP>(Kg, 128, (t) * 64, 511, ring + (unsigned)(slot) * A::BYTES + A::KOFF, dump, wave, lane); \
                              if (PASS == 2) tile_dma<128, A::VP>(Vg, 128, (t) * 64, 511, ring + (unsigned)(slot) * A::BYTES + A::VOFF, dump, wave, lane); } while (0)
    CMP_DMA(0, 0);
    if (1 < t_hi) { CMP_DMA(1, 1); wait_bar<NT>(); } else wait_bar<0>();
    float carry = 0.f;
    int slot = 0;
#pragma unroll 1
    for (int t = 0; t < t_hi; ++t) {
        LAS unsigned char* cur = lds + slot * A::BYTES;
        const int s2 = slot == 0 ? 2 : slot - 1;
        if (t + 2 < t_hi) CMP_DMA(t + 2, s2);
        const bool act = mk.prep(t * 64);
        if (__any(act)) {
            f32x16 s0, s1;
            const float cinit = (CMP_INIT && PASS == 2) ? ((invl > 0.f) ? __builtin_amdgcn_logf(invl) - m : -INFINITY) : 0.f;
            qk_tile<128, false>(cur + A::KOFF, qf, s0, s1, lane, nullptr, cinit);
            float mx = mask_tile(s0, s1, t * 64, mk, act, lane);
            if (PASS == 1) {
                mx = max32(mx);
                const float mn = fmaxf(m, mx), alpha = __builtin_amdgcn_exp2f(m - mn); float ps = 0.f;
#pragma unroll
                for (int r = 0; r < 16; ++r) ps += __builtin_amdgcn_exp2f(s0[r] - mn) + __builtin_amdgcn_exp2f(s1[r] - mn);
                l = l * alpha + ps; m = mn;
            } else {
#pragma unroll
                for (int r = 0; r < 16; ++r) {
                    if (CMP_INIT) { s0[r] = __builtin_amdgcn_exp2f(s0[r]); s1[r] = __builtin_amdgcn_exp2f(s1[r]); }
                    else { s0[r] = __builtin_amdgcn_exp2f(s0[r] - m) * invl; s1[r] = __builtin_amdgcn_exp2f(s1[r] - m) * invl; } }
#pragma unroll
                for (int kt = 0; kt < 2; ++kt) {
                    const f32x16& p = kt ? s1 : s0;
#pragma unroll
                    for (int g4 = 0; g4 < 4; ++g4) {
                        auto rr = __builtin_amdgcn_permlane32_swap(__float_as_uint(p[4 * g4 + 3]), __float_as_uint(p[4 * g4 + 3]), false, false);
                        const float prev = hi ? __uint_as_float(rr[0]) : carry;
                        carry = __uint_as_float(rr[1]);
                        float a = p[4 * g4] + p[4 * g4 + 1] + p[4 * g4 + 2] + 0.5f * (p[4 * g4 + 3] + prev);
                        a = sum8(a);
                        const int si = 16 * t + 8 * kt + 2 * g4 + hi;
                        if ((lane & 7) == 0) impA[tl * NSA_IMPP + si] = a;
                    }
                }
                pv_tile<128>(cur + A::VOFF, s0, s1, O, lane);
            }
        }
        if (t + 2 < t_hi) wait_bar<NT>(); else wait_bar<0>();
        slot = slot == 2 ? 0 : slot + 1;
    }
#undef CMP_DMA
}
__device__ __forceinline__ void nsa_window_unit(LAS unsigned char* lds, int b, int kvh, int tb) {
#define ws (kargs()->ws)
    const int tid = threadIdx.x, lane = tid & 63, wave = __builtin_amdgcn_readfirstlane(tid >> 6), c = lane & 31, hi = lane >> 5;
    const int t0 = tb * 32, tl = wave * 4 + (c >> 3), tok = t0 + tl, qh = kvh * 8 + (c & 7); const size_t row = (size_t)b * SEQ + tok;
    __syncthreads();
    bf16x8 qf[8]; load_q<128>(qf, (const bf16*)(ws + WS_Q1) + row * 2048 + qh * 128, lane);
    f32x16 O[4];
#pragma unroll
    for (int dt = 0; dt < 4; ++dt)
#pragma unroll
        for (int r = 0; r < 16; ++r) O[dt][r] = 0.f;
    float m = NEG_BIG, l = 0.f;
    const MaskWindow mk{tok, 512};
    const bf16* Kg = (const bf16*)(ws + WS_KW) + (size_t)b * SEQ * 256 + kvh * 128; const bf16* Vg = (const bf16*)(ws + WS_VW) + (size_t)b * SEQ * 256 + kvh * 128;
    const int t_lo = t0 >= 511 ? ((t0 - 511) >> 6) : 0;
    attn_run<128, 128, MaskWindow, NSA_SPLIT, 1, 2>(lds, Kg, 256, Vg, 256, SEQ - 1, t_lo, ((t0 + 31) >> 6) + 1, qf, O, m, l, mk);
    l = sum32(l);
    const float sc = ((const float*)(ws + WS_GATES))[row * 48 + 2 * 16 + qh] / l;
    bf16* orow = (bf16*)(ws + WS_ATT) + row * 2048 + qh * 128;
#pragma unroll
    for (int dt = 0; dt < 4; ++dt)
#pragma unroll
        for (int g4 = 0; g4 < 4; ++g4) {
            u32x2 w; w.x = cvtpk(sc * O[dt][4 * g4], sc * O[dt][4 * g4 + 1]); w.y = cvtpk(sc * O[dt][4 * g4 + 2], sc * O[dt][4 * g4 + 3]);
            *(u32x2*)(orow + dt * 32 + 8 * g4 + 4 * hi) = w;
        }
#undef ws
}
__device__ __forceinline__ void nsa_unit(LAS unsigned char* lds, int b, int kvh, int tb) {
#define ws (kargs()->ws)
    const int tid = threadIdx.x, lane = tid & 63, wave = __builtin_amdgcn_readfirstlane(tid >> 6), c = lane & 31, hi = lane >> 5;
    const int t0 = tb * 32, tl = wave * 4 + (c >> 3), tok = t0 + tl, qh = kvh * 8 + (c & 7); const size_t row = (size_t)b * SEQ + tok;
    LAS float* impA = (LAS float*)(lds + NSA_IMPA);
    LAS unsigned long long* selm = (LAS unsigned long long*)(lds + NSA_SEL);
    LAS unsigned* outl = (LAS unsigned*)(lds + NSA_OUT) + wave * 2048;

#define NSA_SLOT ((float*)(ws + WS_SLOT) + ((size_t)blockIdx.x * NWAVES + wave) * 4096)
#define NSA_GATE(br) (((const float*)(ws + WS_GATES))[((size_t)b * SEQ + t0 + wave * 4 + (c >> 3)) * 48 + (br) * 16 + kvh * 8 + (c & 7)])
    __syncthreads();
    bf16x8 qf[8]; load_q<128>(qf, (const bf16*)(ws + WS_Q1) + row * 2048 + qh * 128, lane);
    for (int i = tid; i < 32 * NSA_IMPP; i += NTHREADS) impA[i] = 0.f;
    f32x16 O[4];
    {
        const bf16* Kc = (const bf16*)(ws + WS_KCMP) + (size_t)(b * 2 + kvh) * 512 * 128; const bf16* Vc = (const bf16*)(ws + WS_VCMP) + (size_t)(b * 2 + kvh) * 512 * 128;
        const MaskCmp mk{(tok - 31) >> 4};
        const int t_hi = ((2 * tb) >> 6) + 1;
        float m = NEG_BIG, l = 0.f;
#if NSA_PROBE == 3
        { nsa_cmp_pass<1>(lds, Kc, Vc, t_hi, qf, O, m, l, 0.f, mk, tl); float l2 = sum32(l); const float iv = l2 > 0.f ? 1.f / l2 : 0.f;
#pragma unroll
          for (int dt = 0; dt < 4; ++dt)
#pragma unroll
            for (int r = 0; r < 16; ++r) O[dt][r] = 0.f;
          nsa_cmp_pass<2>(lds, Kc, Vc, t_hi, qf, O, m, l, iv, mk, tl);
#pragma unroll
          for (int dt = 0; dt < 4; ++dt) asm volatile("" :: "v"(O[dt]));
          m = NEG_BIG; l = 0.f; }
#endif
        nsa_cmp_pass<1>(lds, Kc, Vc, t_hi, qf, O, m, l, 0.f, mk, tl);
        l = sum32(l); const float invl = l > 0.f ? 1.f / l : 0.f;
#pragma unroll
        for (int dt = 0; dt < 4; ++dt)
#pragma unroll
            for (int r = 0; r < 16; ++r) O[dt][r] = 0.f;
        nsa_cmp_pass<2>(lds, Kc, Vc, t_hi, qf, O, m, l, invl, mk, tl);
        const float g0 = NSA_GATE(0);
#pragma unroll
        for (int dt = 0; dt < 4; ++dt)
#pragma unroll
            for (int r = 0; r < 16; r += 2) outl[(dt * 8 + (r >> 1)) * 64 + lane] = cvtpk(g0 * O[dt][r], g0 * O[dt][r + 1]);
    }
    asm volatile("s_waitcnt lgkmcnt(0)" ::: "memory");
    {
        const int rw = lane >> 4, li = lane & 15, tlj = wave * 4 + rw, cur = t0 >> 6;
        unsigned selb = 0u;
        if (cur < 16) {
#pragma unroll
            for (int k = 0; k < 8; ++k) selb |= (li * 8 + k <= cur) ? (1u << k) : 0u;
        } else {
            unsigned kk[8];
            { const f32x4 x0 = *(const LAS f32x4*)(impA + tlj * NSA_IMPP + li * 8), x1 = *(const LAS f32x4*)(impA + tlj * NSA_IMPP + li * 8 + 4);
#pragma unroll
              for (int k = 0; k < 8; ++k) { const int s = li * 8 + k; const float v = k < 4 ? x0[k & 3] : x1[k & 3];
                  const bool forced = (s == 0) || (s == cur) || (s == cur - 1);
                  kk[k] = (s > cur) ? 0u : ((forced ? 0xFFFFFF80u : (ordf(v) & 0xFFFFFF80u)) | (unsigned)(127 - s)); } }
#pragma unroll 1
            for (int r = 0; r < 16; ++r) {
                unsigned mk_ = kk[0];
#pragma unroll
                for (int k = 1; k < 8; ++k) mk_ = mk_ > kk[k] ? mk_ : kk[k];
                unsigned t;
                t = dppu<0xB1>(mk_); mk_ = mk_ > t ? mk_ : t; t = dppu<0x4E>(mk_); mk_ = mk_ > t ? mk_ : t; t = dppu<0x141>(mk_); mk_ = mk_ > t ? mk_ : t; t = dppu<0x140>(mk_); mk_ = mk_ > t ? mk_ : t;
#pragma unroll
                for (int k = 0; k < 8; ++k) { const bool hit = kk[k] == mk_; selb |= hit ? (1u << k) : 0u; kk[k] = hit ? 0u : kk[k]; }
            }
        }
        ((LAS unsigned char*)selm)[tlj * 16 + li] = (unsigned char)selb;
    }
    asm volatile("s_waitcnt lgkmcnt(0)" ::: "memory");
    {
        const MaskSel mk{tok, selm[tl * 2], selm[tl * 2 + 1]};
#pragma unroll
        for (int dt = 0; dt < 4; ++dt)
#pragma unroll
            for (int r = 0; r < 16; ++r) O[dt][r] = 0.f;
        float m = NEG_BIG, l = 0.f;
        const bf16* Kg = (const bf16*)(ws + WS_KSL) + (size_t)b * SEQ * 256 + kvh * 128; const bf16* Vg = (const bf16*)(ws + WS_VSL) + (size_t)b * SEQ * 256 + kvh * 128;
#if NSA_PROBE == 1
        { attn_run<128, 128, MaskSel, NSA_SPLIT, 1, 2>(lds, Kg, 256, Vg, 256, SEQ - 1, 0, ((t0 + 31) >> 6) + 1, qf, O, m, l, mk);
#pragma unroll
          for (int dt = 0; dt < 4; ++dt) { asm volatile("" :: "v"(O[dt]));
#pragma unroll
            for (int r = 0; r < 16; ++r) O[dt][r] = 0.f; }
          m = NEG_BIG; l = 0.f; }
#endif
        attn_run<128, 128, MaskSel, NSA_SPLIT, 1, 2>(lds, Kg, 256, Vg, 256, SEQ - 1, 0, ((t0 + 31) >> 6) + 1, qf, O, m, l, mk);
        l = sum32(l); const float sc = NSA_GATE(1) / l;
        bf16* orow = (bf16*)(ws + WS_ATT) + ((size_t)b * SEQ + t0 + wave * 4 + (c >> 3)) * 2048 + (kvh * 8 + (c & 7)) * 128;
#pragma unroll
        for (int dt = 0; dt < 4; ++dt)
#pragma unroll
            for (int g4 = 0; g4 < 4; ++g4) {
                const unsigned w0 = outl[(dt * 8 + 2 * g4) * 64 + lane], w1 = outl[(dt * 8 + 2 * g4 + 1) * 64 + lane];
                const u32x2 pw = *(const u32x2*)(orow + dt * 32 + 8 * g4 + 4 * hi);
                u32x2 w; w.x = cvtpk(bflo(w0) + bflo(pw.x) + sc * O[dt][4 * g4], bfhi(w0) + bfhi(pw.x) + sc * O[dt][4 * g4 + 1]);
                w.y = cvtpk(bflo(w1) + bflo(pw.y) + sc * O[dt][4 * g4 + 2], bfhi(w1) + bfhi(pw.y) + sc * O[dt][4 * g4 + 3]);
                *(u32x2*)(orow + dt * 32 + 8 * g4 + 4 * hi) = w;
            }
    }
#undef ws
}

#define XB_TMO      128
#define XB_XCNT(j)  (256  + 64 * (j))
#define XB_XSUB(j)  (1280 + 64 * (j))
#define XB_XGEN(j)  (2304 + 64 * (j))
#define XB_TOP      3328
#define XB_TOPGEN   3392
#define XCD_BAR_WORDS 3456
#define XB_SPIN_CAP (1u << 18)

__device__ __forceinline__ unsigned xb_ld(unsigned* p)              { return __hip_atomic_load(p, __ATOMIC_RELAXED, __HIP_MEMORY_SCOPE_AGENT); }
__device__ __forceinline__ unsigned xb_add(unsigned* p, unsigned v) { return __hip_atomic_fetch_add(p, v, __ATOMIC_RELAXED, __HIP_MEMORY_SCOPE_AGENT); }
__device__ __forceinline__ unsigned xb_xcc_id() { return (unsigned)__builtin_amdgcn_s_getreg((3 << 11) | 20) & 0xFu; }
#define XB_SPIN(cond, bar) do { unsigned _sp = 0; while (cond) { __builtin_amdgcn_s_sleep(1); \
    if ((++_sp & 255u) == 0u) { if (xb_ld(&(bar)[XB_TMO])) break; if (_sp > XB_SPIN_CAP) { atomicAdd(&(bar)[XB_TMO], 1u); break; } } } } while (0)

struct XcdBarrier {
    unsigned* bar; unsigned x;
    volatile unsigned* st;
};

__device__ __forceinline__ XcdBarrier xcd_barrier_post(unsigned* bar, volatile unsigned* st) {
    XcdBarrier b; b.bar = bar; b.x = xb_xcc_id(); b.st = st;
    if (threadIdx.x == 0) (void)xb_add(&bar[XB_XCNT(b.x)], 1u);
    return b;
}
__device__ __forceinline__ void xcd_barrier_complete(unsigned* bar, unsigned x, unsigned& nloc, unsigned& nx) {
    const unsigned G = gridDim.x * gridDim.y * gridDim.z;
    unsigned sum, cnt, mine, sp = 0u;
    for (;;) {
        sum = 0u; cnt = 0u; mine = 0u;
#pragma unroll
        for (unsigned j = 0; j < 16; ++j) { const unsigned c = xb_ld(&bar[XB_XCNT(j)]); sum += c; cnt += (c > 0u) ? 1u : 0u; mine = (j == x) ? c : mine; }
        if (sum == G) break;
        __builtin_amdgcn_s_sleep(1);
        if ((++sp & 255u) == 0u) { if (xb_ld(&bar[XB_TMO])) break; if (sp > XB_SPIN_CAP) { atomicAdd(&bar[XB_TMO], 1u); break; } }
    }
    nloc = mine > 0u ? mine : 1u; nx = cnt > 0u ? cnt : 1u;
}

__device__ __forceinline__ void xcd_barrier(const XcdBarrier& b) {
    asm volatile("s_waitcnt vmcnt(0)" ::: "memory");
    __syncthreads();
    if (threadIdx.x == 0) {
        unsigned* bar = b.bar;
        __builtin_amdgcn_s_waitcnt(0);
        unsigned nloc = b.st[0], nx = b.st[1];
        if (nloc == 0u) { xcd_barrier_complete(bar, b.x, nloc, nx); b.st[0] = nloc; b.st[1] = nx; }
        const unsigned old = xb_add(&bar[XB_XSUB(b.x)], 1u);
        const unsigned gen = old / nloc;
        if (old + 1u == (gen + 1u) * nloc) {
            __builtin_amdgcn_fence(__ATOMIC_RELEASE, "agent");
            asm volatile("s_waitcnt vmcnt(0)" ::: "memory");
            const unsigned og = xb_add(&bar[XB_TOP], 1u);
            const unsigned tg = og / nx;
            if (og + 1u == (tg + 1u) * nx) xb_add(&bar[XB_TOPGEN], 1u);
            else XB_SPIN(xb_ld(&bar[XB_TOPGEN]) == tg, bar);
            __builtin_amdgcn_fence(__ATOMIC_ACQUIRE, "agent");
            xb_add(&bar[XB_XGEN(b.x)], 1u);
            asm volatile("s_waitcnt vmcnt(0)" ::: "memory");
        } else {
            XB_SPIN(xb_ld(&bar[XB_XGEN(b.x)]) == gen, bar);
            __builtin_amdgcn_fence(__ATOMIC_ACQUIRE, "agent");
            asm volatile("s_waitcnt vmcnt(0)" ::: "memory");
        }
    }
    __syncthreads();
}

typedef unsigned v6u_t __attribute__((ext_vector_type(6)));
typedef float v32f_t __attribute__((ext_vector_type(32)));
typedef __bf16 v32bf_t __attribute__((ext_vector_type(32)));
__device__ __forceinline__ v32bf_t fp6_to_bf16x32(v6u_t p) { return __builtin_amdgcn_cvt_scalef32_pk32_bf16_fp6(p, 1.0f); }
__device__ __forceinline__ v32f_t fp6_to_f32x32(v6u_t p) { return __builtin_amdgcn_cvt_scalef32_pk32_f32_fp6(p, 1.0f); }
#define PEER_BKT(r) ((((r) >> 15) & 1u) << 8 | (((r) & 0x3FFFu) >> 6))
#ifndef PEER_HCOPY
#define PEER_HCOPY 0
#endif
#ifndef PEER_SORTK
#define PEER_SORTK 1
#endif
#ifndef PEER_SELPF
#define PEER_SELPF 1
#endif
#ifndef PEER_TOKPF
#define PEER_TOKPF 0
#endif
#ifndef PEER_DRYMASK
#define PEER_DRYMASK 0
#endif
#ifndef PEER_NT
#define PEER_NT 0
#endif
#ifndef PEER_NTX
#define PEER_NTX 0
#endif
#ifndef PEER_SWEEP_SYNC
#define PEER_SWEEP_SYNC 0
#endif
#ifndef PEER_P
#define PEER_P 8
#endif
constexpr int PEER_SC = 0, PEER_CS = 98304, PEER_REC = 131072, PEER_SRT = 147456;
__device__ __forceinline__ float sum16(float v) { v += dppf<0xB1>(v); v += dppf<0x4E>(v); v += dppf<0x141>(v); v += dppf<0x140>(v); return v; }
__device__ __forceinline__ float dot8(const u32x4& a, const u32x4& b, float acc) {
    acc = fmaf(bflo(a.x), bflo(b.x), acc); acc = fmaf(bfhi(a.x), bfhi(b.x), acc);
    acc = fmaf(bflo(a.y), bflo(b.y), acc); acc = fmaf(bfhi(a.y), bfhi(b.y), acc);
    acc = fmaf(bflo(a.z), bflo(b.z), acc); acc = fmaf(bfhi(a.z), bfhi(b.z), acc);
    acc = fmaf(bflo(a.w), bflo(b.w), acc); acc = fmaf(bfhi(a.w), bfhi(b.w), acc);
    return acc;
}
__device__ __forceinline__ void cand_ij(int c, int& i, int& j) {
    if (c < 16) { i = 0; j = c; } else if (c < 24) { i = 1; j = c - 16; } else if (c < 29) { i = 2; j = c - 24; } else if (c < 33) { i = 3; j = c - 29; }
    else if (c < 36) { i = 4; j = c - 33; } else if (c < 38) { i = 5; j = c - 36; } else if (c < 40) { i = 6; j = c - 38; } else if (c < 42) { i = 7; j = c - 40; }
    else { i = c - 34; j = 0; }
}
template <int MODE, bool DRY = false, bool SELONLY = false>
__device__ __forceinline__ void peer_tile(LAS unsigned char* lds, int tile, int layer, const XcdBarrier& xb) {
#define PWS (kargs()->ws)
#define q ((const bf16*)(PWS + WS_Q1))
#define subk ((const bf16*)(PWS + WS_SUBK) + (size_t)layer * (8 * 2 * 128 * 128))
#define utab ((const unsigned char*)(PWS + WS_TAB + (size_t)layer * 48 * MiB))
#define vtab ((const unsigned char*)(PWS + WS_TAB + (size_t)layer * 48 * MiB + 24 * MiB))
#define tscale ((const float*)(PWS + WS_TSCALE) + (size_t)layer * 2 * 16384)
#define hbuf ((bf16*)(PWS + WS_H))
#define xbuf ((bf16*)(PWS + WS_XB))
#define fout (kargs()->out)
#define gate ((const float*)(PWS + WS_MOD) + (size_t)(layer * 2 + 1) * 2 * 6144 + 4096)
#define g_next (MODE == 0 ? kargs()->in[4] + 2 * 2048 : kargs()->in[19])
#define mod_next ((const float*)(PWS + WS_MOD) + (size_t)2 * 2 * 6144)
    int tid_ = threadIdx.x; asm volatile("" : "+v"(tid_));
    const int tid = tid_, lane = tid & 63, wave = __builtin_amdgcn_readfirstlane(tid >> 6), r32 = lane & 31, hi = lane >> 5;
    LAS float* sc = (LAS float*)(lds + PEER_SC); LAS unsigned* rec = (LAS unsigned*)(lds + PEER_REC);
    const int tok0 = tile * 32;
    const int rw = lane >> 4, li = lane & 15, tlr = wave * 4 + rw;
    LAS float* cscr = (LAS float*)(lds + PEER_CS) + wave * 512;
    bf16x8 fa[8], fb[8];
#if PEER_SELPF
    {   const int p = wave >> 2, kt = wave & 3;
        const bf16* ap = subk + ((size_t)((0 * 2 + p) * 128 + kt * 32 + r32)) * 128 + hi * 8; const bf16* bp = q + (size_t)(tok0 + r32) * 2048 + p * 128 + hi * 8;
#pragma unroll
        for (int st = 0; st < 8; ++st) { fa[st] = *(const bf16x8*)(ap + st * 16); fb[st] = *(const bf16x8*)(bp + st * 16); } }
#endif
#pragma unroll 1
    for (int h = 0; h < 8; ++h) {
        LAS float* scb = sc + (h & 1) * 8192;
        {
            const int p = wave >> 2, kt = wave & 3;
            f32x16 s;
#pragma unroll
            for (int i = 0; i < 16; ++i) s[i] = 0.f;
#if PEER_SELPF
#pragma unroll
            for (int st = 0; st < 8; ++st) s = __builtin_amdgcn_mfma_f32_32x32x16_bf16(fa[st], fb[st], s, 0, 0, 0);
            if (h + 1 < 8) {
                const bf16* ap = subk + ((size_t)(((h + 1) * 2 + p) * 128 + kt * 32 + r32)) * 128 + hi * 8; const bf16* bp = q + (size_t)(tok0 + r32) * 2048 + (h + 1) * 256 + p * 128 + hi * 8;
#pragma unroll
                for (int st = 0; st < 8; ++st) { fa[st] = *(const bf16x8*)(ap + st * 16); fb[st] = *(const bf16x8*)(bp + st * 16); }
            }
#else
            const bf16* ap = subk + ((size_t)((h * 2 + p) * 128 + kt * 32 + r32)) * 128 + hi * 8;
            const bf16* bp = q + (size_t)(tok0 + r32) * 2048 + h * 256 + p * 128 + hi * 8;
#pragma unroll
            for (int st = 0; st < 8; ++st) s = __builtin_amdgcn_mfma_f32_32x32x16_bf16(*(const bf16x8*)(ap + st * 16), *(const bf16x8*)(bp + st * 16), s, 0, 0, 0);
#endif
#pragma unroll
            for (int r = 0; r < 16; ++r) scb[(p * 32 + r32) * 128 + kt * 32 + crow(r, hi)] = s[r];
        }
        __syncthreads();
        {
            const LAS float* s0 = scb + tlr * 128; const LAS float* s1 = scb + (32 + tlr) * 128;
            unsigned ka[8], kb[8];
            { const f32x4 x0 = *(const LAS f32x4*)(s0 + li * 8), x1 = *(const LAS f32x4*)(s0 + li * 8 + 4), y0 = *(const LAS f32x4*)(s1 + li * 8), y1 = *(const LAS f32x4*)(s1 + li * 8 + 4);
#pragma unroll
              for (int k = 0; k < 4; ++k) { ka[k] = (ordf(x0[k]) & 0xFFFFFF80u) | (unsigned)(127 - (li * 8 + k)); ka[4 + k] = (ordf(x1[k]) & 0xFFFFFF80u) | (unsigned)(127 - (li * 8 + 4 + k));
                  kb[k] = (ordf(y0[k]) & 0xFFFFFF80u) | (unsigned)(127 - (li * 8 + k)); kb[4 + k] = (ordf(y1[k]) & 0xFFFFFF80u) | (unsigned)(127 - (li * 8 + 4 + k)); } }
            unsigned ra = 0u, rb = 0u;
#if PEER_SORTK
#define PK_CE(x, y) { const unsigned h_ = x > y ? x : y, l_ = x > y ? y : x; x = h_; y = l_; }
#define PK_SORT8(v) PK_CE(v[0], v[1]) PK_CE(v[2], v[3]) PK_CE(v[4], v[5]) PK_CE(v[6], v[7]) PK_CE(v[0], v[2]) PK_CE(v[1], v[3]) PK_CE(v[4], v[6]) PK_CE(v[5], v[7]) PK_CE(v[1], v[2]) PK_CE(v[5], v[6]) \
                    PK_CE(v[0], v[4]) PK_CE(v[1], v[5]) PK_CE(v[2], v[6]) PK_CE(v[3], v[7]) PK_CE(v[2], v[4]) PK_CE(v[3], v[5]) PK_CE(v[1], v[2]) PK_CE(v[3], v[4]) PK_CE(v[5], v[6])
            PK_SORT8(ka) PK_SORT8(kb)
#pragma unroll 1
            for (int r = 0; r < 16; ++r) {
                unsigned ma = ka[0], mb = kb[0];
                unsigned t;
                t = dppu<0xB1>(ma); ma = ma > t ? ma : t; t = dppu<0xB1>(mb); mb = mb > t ? mb : t;
                t = dppu<0x4E>(ma); ma = ma > t ? ma : t; t = dppu<0x4E>(mb); mb = mb > t ? mb : t;
                t = dppu<0x141>(ma); ma = ma > t ? ma : t; t = dppu<0x141>(mb); mb = mb > t ? mb : t;
                t = dppu<0x140>(ma); ma = ma > t ? ma : t; t = dppu<0x140>(mb); mb = mb > t ? mb : t;
                const bool wa = ka[0] == ma, wb = kb[0] == mb;
#pragma unroll
                for (int k = 0; k < 7; ++k) { ka[k] = wa ? ka[k + 1] : ka[k]; kb[k] = wb ? kb[k + 1] : kb[k]; }
                ka[7] = wa ? 0u : ka[7]; kb[7] = wb ? 0u : kb[7];
                if (li == r) { ra = ma; rb = mb; }
            }
#undef PK_SORT8
#undef PK_CE
#else
#pragma unroll 1
            for (int r = 0; r < 16; ++r) {
                unsigned ma = ka[0], mb = kb[0];
#pragma unroll
                for (int k = 1; k < 8; ++k) { ma = ma > ka[k] ? ma : ka[k]; mb = mb > kb[k] ? mb : kb[k]; }
                unsigned t;
                t = dppu<0xB1>(ma); ma = ma > t ? ma : t; t = dppu<0xB1>(mb); mb = mb > t ? mb : t;
                t = dppu<0x4E>(ma); ma = ma > t ? ma : t; t = dppu<0x4E>(mb); mb = mb > t ? mb : t;
                t = dppu<0x141>(ma); ma = ma > t ? ma : t; t = dppu<0x141>(mb); mb = mb > t ? mb : t;
                t = dppu<0x140>(ma); ma = ma > t ? ma : t; t = dppu<0x140>(mb); mb = mb > t ? mb : t;
#pragma unroll
                for (int k = 0; k < 8; ++k) { ka[k] = ka[k] == ma ? 0u : ka[k]; kb[k] = kb[k] == mb ? 0u : kb[k]; }
                if (li == r) { ra = ma; rb = mb; }
            }
#endif
            const int ia = 127 - (int)(ra & 127u), ib = 127 - (int)(rb & 127u);
            const float av = s0[ia], bv = s1[ib];
            unsigned ck[4]; const int rowbase = lane & 48;
#pragma unroll
            for (int u = 0; u < 4; ++u) {
                const int c = li + 16 * u; int ci, cj; cand_ij(c < 50 ? c : 0, ci, cj);
                const float cand = __shfl(av, rowbase + ci) + __shfl(bv, rowbase + cj);
                const int ce = __shfl(ia, rowbase + ci) * 128 + __shfl(ib, rowbase + cj);
                cscr[rw * 64 + c] = cand; ((LAS int*)cscr)[256 + rw * 64 + c] = ce;
                ck[u] = c < 50 ? ((ordf(cand) & 0xFFFFFFC0u) | (unsigned)(63 - c)) : 0u;
            }
            unsigned rc = 0u;
#pragma unroll 1
            for (int r = 0; r < 16; ++r) {
                unsigned mc = ck[0] > ck[1] ? ck[0] : ck[1]; { const unsigned m2 = ck[2] > ck[3] ? ck[2] : ck[3]; mc = mc > m2 ? mc : m2; }
                unsigned t;
                t = dppu<0xB1>(mc); mc = mc > t ? mc : t; t = dppu<0x4E>(mc); mc = mc > t ? mc : t; t = dppu<0x141>(mc); mc = mc > t ? mc : t; t = dppu<0x140>(mc); mc = mc > t ? mc : t;
#pragma unroll
                for (int u = 0; u < 4; ++u) ck[u] = ck[u] == mc ? 0u : ck[u];
                if (li == r) rc = mc;
            }
            const int cw = 63 - (int)(rc & 63u);
            const float best = cscr[rw * 64 + cw]; const int be = ((LAS int*)cscr)[256 + rw * 64 + cw];
            const float mx = __shfl(best, rowbase);
            const float ex = __expf(best - mx);
            const float den = sum16(ex);
            rec[tlr * 128 + h * 16 + li] = (cvtpk(0.f, ex / den) & 0xffff0000u) | ((unsigned)rw << 14) | (unsigned)be;
        }
    }
    __syncthreads();
    if (SELONLY) return;
    {
        LAS unsigned* rec2 = (LAS unsigned*)(lds + PEER_SRT);
#if PEER_TOKPF
        {
            float su[8], sv[8];
#pragma unroll
            for (int k2 = 0; k2 < 8; ++k2) { const unsigned e = rec[wave * 512 + lane + 64 * k2] & 0x3FFFu; su[k2] = tscale[16384 + e]; sv[k2] = tscale[e]; }
#pragma unroll
            for (int k2 = 0; k2 < 8; ++k2) rec2[wave * 512 + lane + 64 * k2] = cvtpk(su[k2], sv[k2]);
        }
        u32x4 hn[4];
#pragma unroll
        for (int c4 = 0; c4 < 4; ++c4) hn[c4] = *(const u32x4*)(hbuf + ((size_t)tok0 + wave * 4) * 2048 + lane * 32 + 8 * c4);
#endif
#pragma unroll 1
        for (int j = 0; j < 4; ++j) {
            const int tl = wave * 4 + j; const size_t row = (size_t)tok0 + tl;
            const LAS unsigned* rcw = rec + tl * 128; LAS unsigned* rc2 = rec2 + tl * 128;
            u32x4 hh[4];
#if PEER_TOKPF
#pragma unroll
            for (int c4 = 0; c4 < 4; ++c4) { hh[c4] = hn[c4]; asm volatile("" : "+v"(hh[c4])); }
            if (j < 3) {
#pragma unroll
                for (int c4 = 0; c4 < 4; ++c4) hn[c4] = *(const u32x4*)(hbuf + (row + 1) * 2048 + lane * 32 + 8 * c4);
            }
#else
#pragma unroll
            for (int k2 = 0; k2 < 2; ++k2) { const unsigned e = rcw[lane + 64 * k2] & 0x3FFFu; rc2[lane + 64 * k2] = cvtpk(tscale[16384 + e], tscale[e]); }
#pragma unroll
            for (int c4 = 0; c4 < 4; ++c4) hh[c4] = *(const u32x4*)(hbuf + row * 2048 + lane * 32 + 8 * c4);
#pragma unroll
            for (int c4 = 0; c4 < 4; ++c4) asm volatile("" : "+v"(hh[c4]));
#endif
            f32x2 acc[16];
#pragma unroll
            for (int i = 0; i < 16; ++i) acc[i] = (f32x2){0.f, 0.f};
#pragma unroll 1
            for (int g0 = 0; g0 < 128; g0 += PEER_P) {
                u32x4 ura[PEER_P], vra[PEER_P]; u32x2 urb[PEER_P], vrb[PEER_P];
#pragma unroll
                for (int p = 0; p < PEER_P; ++p) {
                    const unsigned e = (unsigned)__builtin_amdgcn_readfirstlane((int)rcw[g0 + p]) & ((DRY && PEER_DRYMASK) ? 0x3FFu : 0x3FFFu);
                    const unsigned char* up = utab + (size_t)e * 1536; const unsigned char* vp = vtab + (size_t)e * 1536;
#if PEER_NT
                    ura[p] = __builtin_nontemporal_load((const u32x4*)(up + lane * 16)); urb[p] = __builtin_nontemporal_load((const u32x2*)(up + 1024 + lane * 8));
                    vra[p] = __builtin_nontemporal_load((const u32x4*)(vp + lane * 16)); vrb[p] = __builtin_nontemporal_load((const u32x2*)(vp + 1024 + lane * 8));
#else
                    ura[p] = *(const u32x4*)(up + lane * 16); urb[p] = *(const u32x2*)(up + 1024 + lane * 8);
                    vra[p] = *(const u32x4*)(vp + lane * 16); vrb[p] = *(const u32x2*)(vp + 1024 + lane * 8);
#endif
                }
                float part[PEER_P];
#pragma unroll
                for (int p = 0; p < PEER_P; ++p) {
                    const v6u_t up6 = {ura[p].x, ura[p].y, ura[p].z, ura[p].w, urb[p].x, urb[p].y};
                    const v32bf_t ub = fp6_to_bf16x32(up6);
                    float d = 0.f;
#pragma unroll
                    for (int k = 0; k < 16; ++k) { const bf16x2_t uu = {ub[2 * k], ub[2 * k + 1]}; const unsigned hw = hh[k >> 2][k & 3];     d = __builtin_amdgcn_fdot2_f32_bf16(uu, __builtin_bit_cast(bf16x2_t, hw), d, false); }
                    part[p] = d;
                }
                float v4[4], v2[2], v1;
                { const bool up = (lane & 32) != 0;
#pragma unroll
                  for (int i = 0; i < 4; ++i) { const float keep = up ? part[i + 4] : part[i], snd = up ? part[i] : part[i + 4]; v4[i] = keep + __shfl_xor(snd, 32); } }
                { const bool up = (lane & 16) != 0;
#pragma unroll
                  for (int i = 0; i < 2; ++i) { const float keep = up ? v4[i + 2] : v4[i], snd = up ? v4[i] : v4[i + 2]; v2[i] = keep + __shfl_xor(snd, 16); } }
                { const bool up = (lane & 8) != 0; const float keep = up ? v2[1] : v2[0], snd = up ? v2[0] : v2[1]; v1 = keep + __shfl_xor(snd, 8); }
                v1 += __shfl_xor(v1, 4); v1 += __shfl_xor(v1, 2); v1 += __shfl_xor(v1, 1);
                const int ek = 4 * (lane >> 5) + 2 * ((lane >> 4) & 1) + ((lane >> 3) & 1);
                const unsigned rk = rcw[g0 + ek], sk = rc2[g0 + ek];
                const float cf = __uint_as_float(rk & 0xffff0000u) * gelu_tanh(v1 * __uint_as_float(sk & 0xffff0000u)) * __uint_as_float(sk << 16);
#pragma unroll
                for (int p = 0; p < PEER_P; ++p) {
                    const float ck = __int_as_float(__builtin_amdgcn_readlane(__float_as_int(cf), (((p >> 2) & 1) << 5) | (((p >> 1) & 1) << 4) | ((p & 1) << 3)));
                    const f32x2 ck2 = {ck, ck};
                    const v6u_t vp6 = {vra[p].x, vra[p].y, vra[p].z, vra[p].w, vrb[p].x, vrb[p].y};
                    const v32f_t vf = fp6_to_f32x32(vp6);
#pragma unroll
                    for (int i = 0; i < 16; ++i) acc[i] = __builtin_elementwise_fma((f32x2){vf[2 * i], vf[2 * i + 1]}, ck2, acc[i]);
                }
            }
            if (DRY) {
#pragma unroll
                for (int i = 0; i < 16; ++i) asm volatile("" :: "v"(acc[i]));
                continue;
            }
            bf16* xr = xbuf + row * 2048 + lane * 32; const float* gt = gate + (size_t)(row >> 13) * 6144 + lane * 32;
            float ss = 0.f;
#pragma unroll
            for (int c4 = 0; c4 < 4; ++c4) {
                const u32x4 xw = *(const u32x4*)(xr + 8 * c4); const f32x4 g0 = *(const f32x4*)(gt + 8 * c4), g1 = *(const f32x4*)(gt + 8 * c4 + 4);
                f32x4 xa, xb2;
                xa.x = bflo(xw.x) + g0.x * acc[4 * c4].x; xa.y = bfhi(xw.x) + g0.y * acc[4 * c4].y; xa.z = bflo(xw.y) + g0.z * acc[4 * c4 + 1].x; xa.w = bfhi(xw.y) + g0.w * acc[4 * c4 + 1].y;
                xb2.x = bflo(xw.z) + g1.x * acc[4 * c4 + 2].x; xb2.y = bfhi(xw.z) + g1.y * acc[4 * c4 + 2].y; xb2.z = bflo(xw.w) + g1.z * acc[4 * c4 + 3].x; xb2.w = bfhi(xw.w) + g1.w * acc[4 * c4 + 3].y;
                if (MODE == 0) {
                    const u32x4 pw = pack8(xa, xb2); *(u32x4*)(xr + 8 * c4) = pw;
                    xa = (f32x4){bflo(pw.x), bfhi(pw.x), bflo(pw.y), bfhi(pw.y)}; xb2 = (f32x4){bflo(pw.z), bfhi(pw.z), bflo(pw.w), bfhi(pw.w)};
                }
                acc[4 * c4] = (f32x2){xa.x, xa.y}; acc[4 * c4 + 1] = (f32x2){xa.z, xa.w}; acc[4 * c4 + 2] = (f32x2){xb2.x, xb2.y}; acc[4 * c4 + 3] = (f32x2){xb2.z, xb2.w};
                ss += (xa.x * xa.x + xa.y * xa.y) + (xa.z * xa.z + xa.w * xa.w) + (xb2.x * xb2.x + xb2.y * xb2.y) + (xb2.z * xb2.z + xb2.w * xb2.w);
            }
            const float rn = 1.0f / sqrtf(wave_sum(ss) * (1.f / DM) + NORM_EPS);
            if (MODE == 0) {
                const float* md = mod_next + (size_t)(row >> 13) * 6144 + lane * 32; const float* gn = g_next + lane * 32;
                unsigned ow[16];
#pragma unroll
                for (int q4 = 0; q4 < 8; ++q4) { const f32x4 gg = *(const f32x4*)(gn + 4 * q4), sc4 = *(const f32x4*)(md + 2048 + 4 * q4), sh4 = *(const f32x4*)(md + 4 * q4);
                    ow[2 * q4] = cvtpk(acc[2 * q4].x * rn * gg.x * (1.f + sc4.x) + sh4.x, acc[2 * q4].y * rn * gg.y * (1.f + sc4.y) + sh4.y);
                    ow[2 * q4 + 1] = cvtpk(acc[2 * q4 + 1].x * rn * gg.z * (1.f + sc4.z) + sh4.z, acc[2 * q4 + 1].y * rn * gg.w * (1.f + sc4.w) + sh4.w); }
                bf16* hw = hbuf + row * 2048 + lane * 32;
#pragma unroll
                for (int q4 = 0; q4 < 4; ++q4) *(u32x4*)(hw + 8 * q4) = (u32x4){ow[4 * q4], ow[4 * q4 + 1], ow[4 * q4 + 2], ow[4 * q4 + 3]};
            } else {
                const float* gn = g_next + lane * 32;
#pragma unroll
                for (int q4 = 0; q4 < 8; ++q4) { const f32x4 gg = *(const f32x4*)(gn + 4 * q4); f32x4 o;
                    o.x = acc[2 * q4].x * rn * gg.x; o.y = acc[2 * q4].y * rn * gg.y; o.z = acc[2 * q4 + 1].x * rn * gg.z; o.w = acc[2 * q4 + 1].y * rn * gg.w;
                    *(f32x4*)(fout + row * 2048 + lane * 32 + 4 * q4) = o; }
            }
        }
    }
    __syncthreads();
#undef PWS
#undef q
#undef subk
#undef utab
#undef vtab
#undef tscale
#undef hbuf
#undef xbuf
#undef fout
#undef gate
#undef g_next
#undef mod_next
}
namespace flow {
constexpr size_t WS_FLOW = WS_CTL + 40960;
constexpr int SLOT_LDS = LDS_BYTES - 16;
#define FLOW_RLX __ATOMIC_RELAXED, __HIP_MEMORY_SCOPE_AGENT
#ifndef FLOW_BFS
#define FLOW_BFS 0
#endif
#ifndef FLOW_PCAP
#define FLOW_PCAP 24
#endif
struct R1 {
    static constexpr int NST = 5, BASE = 0, PST = 3;
    static __device__ __forceinline__ int cnt(int st) { return st == 1 ? 4 : st == 4 ? 15 : 8; }
    static __device__ __forceinline__ int dep(int st) { return st - 1; }
    static __device__ __forceinline__ int depn(int st) { return st == 2 ? 4 : 8; }
    static __device__ __forceinline__ int prio(int p) { return p == 4 ? 4 : 3 - p; }
};
struct R2 {
    static constexpr int NST = 4, BASE = 1024, PST = 3;
    static __device__ __forceinline__ int cnt(int st) { return st == 1 ? 4 : 8; }
    static __device__ __forceinline__ int dep(int st) { return st - 1; }
    static __device__ __forceinline__ int depn(int st) { return st == 2 ? 4 : 8; }
    static __device__ __forceinline__ int prio(int p) { return FLOW_BFS ? p : 3 - p; }
};
struct Q { unsigned* base; int home; unsigned par; };
__device__ __forceinline__ unsigned* arrive_ctr(const Q& q, int st, int rt) { return q.base + (rt & 7) * 64 + 16 + st * 8 + (rt >> 3); }
__device__ __forceinline__ unsigned* pact_ctr(const Q& q, int xq) { return q.base + xq * 64 + 8; }
template <class R>
__device__ __forceinline__ int scan_xcd(const Q& q, int xq, int only) {
    const int lane = threadIdx.x & 63; const bool l0 = (lane == 0);
    unsigned* blk = q.base + xq * 64;
    const int v = (int)__hip_atomic_load(blk + lane, FLOW_RLX);
    bool all_ex = true;
    for (int p = 0; p < R::NST; ++p) {
        const int st = only >= 0 ? only : R::prio(p), c = R::cnt(st);
        const int h = __builtin_amdgcn_readlane(v, st);
        if (h < 8 * c) {
            all_ex = false;
            const int kk = h / c, ix = h - kk * c;
            const bool dep_ok = R::dep(st) < 0 || __builtin_amdgcn_readlane(v, 16 + R::dep(st) * 8 + kk) >= R::depn(st);
            const bool cap_ok = st != R::PST || __builtin_amdgcn_readlane(v, 8) < FLOW_PCAP;
            if (dep_ok && cap_ok) {
                unsigned ok = 0u; if (l0) { unsigned ex = (unsigned)h; ok = __hip_atomic_compare_exchange_strong(blk + st, &ex, (unsigned)h + 1u, __ATOMIC_RELAXED, __ATOMIC_RELAXED, __HIP_MEMORY_SCOPE_AGENT) ? 1u : 0u; }
                if (!__builtin_amdgcn_readfirstlane((int)ok)) return -3;
                if (st == R::PST && l0) (void)__hip_atomic_fetch_add(blk + 8, 1u, FLOW_RLX);
                return (xq << 24) | (st << 16) | ((kk * 8 + xq) << 8) | ix;
            }
        }
        if (only >= 0) break;
    }
    return all_ex ? -2 : -1;
}
template <class R, bool IN_GEMM>
__device__ __forceinline__ int pop(LAS unsigned char* lds, Q& q, int only) {
    if (!IN_GEMM) __syncthreads();
    LAS volatile int* slot = (LAS volatile int*)(lds + SLOT_LDS) + (q.par & 1u);
    if (__builtin_amdgcn_readfirstlane((int)(threadIdx.x >> 6)) == 0) {
        int r = -1;
        if (IN_GEMM) { do { r = scan_xcd<R>(q, q.home, only); } while (r == -3); if (r < 0) r = -1; }
        else for (;;) {
            bool all_ex = true;
            for (int xi = 0; xi < 8; ++xi) { const int xq = (q.home + xi) & 7; int c;
                do { c = scan_xcd<R>(q, xq, -1); } while (c == -3);
                if (c >= 0) { r = c; break; } if (c == -1) all_ex = false; }
            if (r >= 0 || all_ex) break;
            r = -1; __builtin_amdgcn_s_sleep(64);
        }
        if (threadIdx.x == 0) *slot = r;
        asm volatile("s_waitcnt lgkmcnt(0)" ::: "memory");
    }
    __builtin_amdgcn_s_barrier();
    const int r = __builtin_amdgcn_readfirstlane(*slot);
    ++q.par;
    return r;
}
__device__ __forceinline__ void acquire() { __builtin_amdgcn_fence(__ATOMIC_ACQUIRE, "agent"); }
template <bool RAW_BAR>
__device__ __forceinline__ void publish(unsigned* c, unsigned* dec) {
    asm volatile("s_waitcnt vmcnt(0)" ::: "memory");
    if (RAW_BAR) __builtin_amdgcn_s_barrier(); else __syncthreads();
    if (threadIdx.x == 0) { __builtin_amdgcn_fence(__ATOMIC_RELEASE, "agent"); asm volatile("s_waitcnt vmcnt(0)" ::: "memory"); (void)__hip_atomic_fetch_add(c, 1u, FLOW_RLX);
        if (dec) (void)__hip_atomic_fetch_sub(dec, 1u, FLOW_RLX); }
}
template <class R, int ST>
struct GOrder {
    LAS unsigned char* lds; Q* q; int first;
    __device__ __forceinline__ bool next(int i, pg8::Unit& u) {
        const int t = (i == 0) ? first : pop<R, true>(lds, *q, ST);
        if (t >= 0) { u.pm = (t >> 8) & 255; u.pn = t & 255; return true; }
        return false;
    }
    __device__ __forceinline__ void a_ready(const pg8::Unit&) const { if (R::dep(ST) >= 0) acquire(); }
    __device__ __forceinline__ void done(const pg8::Unit& u) const { publish<true>(arrive_ctr(*q, ST, u.pm), nullptr); }
};
}
#ifndef CONV_COAL
#define CONV_COAL 0
#endif
#ifndef P9_SKIP5
#define P9_SKIP5 0
#endif
#ifndef PRO_SKIP
#define PRO_SKIP 0
#endif
#ifndef DEFER_PRO
#define DEFER_PRO 0
#endif


constexpr int N_PHASES = 17;
#ifndef STOP_AFTER
#define STOP_AFTER 15
#endif
#ifndef N_LAUNCH_MODE
#define N_LAUNCH_MODE 1
#endif

__device__ __forceinline__ void cvt_rows_bf16(const float* src, bf16* dst, size_t nvec8, size_t gtid, size_t nthr) {
    for (size_t i = gtid; i < nvec8; i += nthr) {
        const f32x4 a = *(const f32x4*)(src + i * 8), b = *(const f32x4*)(src + i * 8 + 4);
        u32x4 w; w.x = cvtpk(a.x, a.y); w.y = cvtpk(a.z, a.w); w.z = cvtpk(b.x, b.y); w.w = cvtpk(b.z, b.w);
        *(u32x4*)(dst + i * 8) = w;
    }
}
typedef float v16f_t __attribute__((ext_vector_type(16)));

#ifndef FP6_INTERLEAVED
#define FP6_INTERLEAVED 1
#endif
__device__ __forceinline__ void row_to_fp6_pre(const float* src, f32x4 (&v)[8], int lane) {
#pragma unroll
    for (int q = 0; q < 8; ++q) v[q] = NT_ONCE ? __builtin_nontemporal_load((const f32x4*)(src + lane * 32 + 4 * q)) : *(const f32x4*)(src + lane * 32 + 4 * q);
}
__device__ __forceinline__ void row_load_coal(const float* src, f32x4 (&raw)[8], int lane) {
#pragma unroll
    for (int q = 0; q < 8; ++q) raw[q] = *(const f32x4*)(src + q * 256 + lane * 4);
}
__device__ __forceinline__ void row_xpose(const f32x4 (&raw)[8], f32x4 (&v)[8], LAS float* scr, int lane) {
#pragma unroll
    for (int q = 0; q < 8; ++q) *(LAS f32x4*)(scr + q * 288 + lane * 4 + 4 * (lane >> 3)) = raw[q];
    asm volatile("s_waitcnt lgkmcnt(0)" ::: "memory");
#pragma unroll
    for (int q = 0; q < 8; ++q) v[q] = *(const LAS f32x4*)(scr + lane * 36 + 4 * q);
    asm volatile("s_waitcnt lgkmcnt(0)" ::: "memory");
}
__device__ __forceinline__ void row_to_fp6(const float* src, unsigned char* dst, float* scale, int lane, const f32x4 (*pre)[8] = nullptr) {
    f32x4 v[8]; float am = 0.f;
#pragma unroll
    for (int q = 0; q < 8; ++q) { v[q] = pre ? (*pre)[q] : (NT_ONCE ? __builtin_nontemporal_load((const f32x4*)(src + lane * 32 + 4 * q)) : *(const f32x4*)(src + lane * 32 + 4 * q)); const f32x4 a = __builtin_elementwise_abs(v[q]); am = fmaxf(am, fmaxf(fmaxf(a.x, a.y), fmaxf(a.z, a.w))); }
#pragma unroll
    for (int o = 1; o < 64; o <<= 1) am = fmaxf(am, __shfl_xor(am, o));
    const float sc = am > 0.f ? am * (1.f / 7.5f) : 1.f, inv = 1.f / sc;
    if (lane == 0) *scale = sc;
    v16f_t x, y;
#pragma unroll
    for (int i = 0; i < 16; ++i) {
        const int ex = FP6_INTERLEAVED ? 2 * i : i, ey = FP6_INTERLEAVED ? 2 * i + 1 : 16 + i;
        x[i] = v[ex >> 2][ex & 3] * inv; y[i] = v[ey >> 2][ey & 3] * inv;
    }
    const v6u_t p = __builtin_amdgcn_cvt_scalef32_2xpk16_fp6_f32(x, y, 1.0f);
    *(u32x4*)(dst + lane * 16) = (u32x4){p[0], p[1], p[2], p[3]}; *(u32x2*)(dst + 1024 + lane * 8) = (u32x2){p[4], p[5]};
}
__device__ __forceinline__ void ada_item(KArgs Ap, LAS unsigned char* lds, int it) {
    LAS float* sv = (LAS float*)lds; LAS float* red = (LAS float*)(lds + 32768); float* mod = (float*)((*Ap).ws + WS_MOD);
    const int li = it / 48, cgp = it % 48;
    for (int k = threadIdx.x; k < 4096; k += NTHREADS) sv[k] = siluf_((*Ap).in[1][k]);
    __syncthreads();
    gemv_item(sv, 2048, (*Ap).in[2] + (size_t)li * 2048 * 6144, 6144, cgp * 128, red, mod + (size_t)(li * 2) * 6144, mod + (size_t)(li * 2 + 1) * 6144, (*Ap).in[3] + (size_t)li * 6144);
}
__device__ __forceinline__ void phase_prologue(KArgs Ap, LAS unsigned char* lds, int vcu, int G, int skip = 0) {
    const int tid = threadIdx.x, lane = tid & 63, wave = __builtin_amdgcn_readfirstlane(tid >> 6), bx = blockIdx.x;
    unsigned char* ws = Ap->ws;
#define A (*Ap)
    {
        LAS float* sv = (LAS float*)lds; LAS float* red = (LAS float*)(lds + 32768);
        float* mod = (float*)(ws + WS_MOD); float* bias1 = (float*)(ws + WS_BIAS1);
        if (!(skip & 1)) for (int it = bx; it < 196; it += G) {
            __syncthreads();
            if (it < 192) {
                if (DEFER_PRO && G == 256 && it >= 48) continue;
                ada_item(Ap, lds, it);
            } else {
                const int kv = (it - 192) >> 1, cgp = (it - 192) & 1;
                for (int k = tid; k < 4096; k += NTHREADS) { const float p = A.in[12][(size_t)kv * 4096 + k]; sv[k] = p; sv[4096 + k] = p; }
                __syncthreads();
                gemv_item(sv, 4096, A.in[13] + (size_t)kv * 4096 * 256, 256, cgp * 128, red, bias1 + kv * 256, bias1 + 512, nullptr);
            }
        }
        __syncthreads();
    }
    {
        LAS float* scr = (LAS float*)(lds + wave * 16384);
        const int gw = vcu * NWAVES + wave, NGW = G * NWAVES;
        constexpr int I0 = 4608, I1 = I0 + 2048, I2 = I1 + 3648, I3 = I2 + 2048, I4 = I3 + 2048, I5 = I4 + 2048, I6 = I5 + 512, I7 = I6 + 512, I8 = I7 + 16, I9 = I8 + 16;
        if (!(skip & 2)) for (int it = gw; it < I9; it += NGW) {
            if (it < I0) transpose_item(A.in[5], 2048, 4608, (bf16*)(ws + WS_WIN0), 1, scr, it, lane);
            else if (it < I1) transpose_item(A.in[6], 2048, 2048, (bf16*)(ws + WS_WOUT0), 0, scr, it - I0, lane);
            else if (it < I2) transpose_item(A.in[10], 2048, 3632, (bf16*)(ws + WS_WIN1), 2, scr, it - I1, lane);
            else if (it < I3) { if (!(DEFER_PRO && G == 256)) transpose_item(A.in[11], 2048, 2048, (bf16*)(ws + WS_WOUT1), 0, scr, it - I2, lane); }
            else if (it < I4) transpose_item(A.in[15], 2048, 2048, (bf16*)(ws + WS_WQ0), 0, scr, it - I3, lane);
            else if (it < I5) { if (!(DEFER_PRO && G == 256)) transpose_item(A.in[15] + (size_t)2048 * 2048, 2048, 2048, (bf16*)(ws + WS_WQ1), 0, scr, it - I4, lane); }
            else if (it < I6) transpose_item(A.in[13], 4096, 256, (bf16*)(ws + WS_W1T), 0, scr, it - I5, lane);
            else if (it < I7) transpose_item(A.in[13] + (size_t)4096 * 256, 4096, 256, (bf16*)(ws + WS_W1T) + (size_t)256 * 4096, 0, scr, it - I6, lane);
            else if (it < I8) transpose_item(A.in[14], 256, 128, (bf16*)(ws + WS_W2T), 3, scr, it - I7, lane);
            else transpose_item(A.in[14] + (size_t)256 * 128, 256, 128, (bf16*)(ws + WS_W2T) + (size_t)256 * 256, 0, scr, it - I8, lane);
        }
    }
    if (CONV_COAL) __syncthreads();
    {
        const size_t gtid = (size_t)vcu * NTHREADS + tid, nthr = (size_t)G * NTHREADS;
        {
            const int gw2 = vcu * NWAVES + wave, NGW2 = G * NWAVES;
            if (!(skip & 4)) for (int r = gw2; r < 2 * 16384; r += 2 * NGW2) {
                const int r2 = r + NGW2;
                const int tb = r >> 14, e = r & 16383; const float* src = (tb & 1 ? A.in[18] : A.in[17]) + ((size_t)(tb >> 1) * 16384 + e) * 2048;
                const int tb2 = r2 >> 14, e2 = r2 & 16383; const float* src2 = (tb2 & 1 ? A.in[18] : A.in[17]) + ((size_t)(tb2 >> 1) * 16384 + e2) * 2048;
                f32x4 pa[8], pb[8];
#if CONV_COAL
                { f32x4 ra[8], rb[8]; row_load_coal(src, ra, lane); row_load_coal(src2, rb, lane); LAS float* xs = (LAS float*)lds + wave * 4608; row_xpose(ra, pa, xs, lane); row_xpose(rb, pb, xs + 2304, lane); }
#else
                row_to_fp6_pre(src, pa, lane); row_to_fp6_pre(src2, pb, lane);
#endif
                row_to_fp6(src, ws + WS_TAB + (size_t)tb * 24 * MiB + (size_t)e * 1536, (float*)(ws + WS_TSCALE) + r, lane, &pa);
                row_to_fp6(src2, ws + WS_TAB + (size_t)tb2 * 24 * MiB + (size_t)e2 * 1536, (float*)(ws + WS_TSCALE) + r2, lane, &pb);
            }
        }
        cvt_rows_bf16(A.in[16], (bf16*)(ws + WS_SUBK), (size_t)2 * 8 * 2 * 128 * 128 / 8, gtid, nthr);
        f32x2* t64 = (f32x2*)(ws + WS_TAB64); f32x2* t128 = (f32x2*)(ws + WS_TAB128);
        if (!(skip & 8)) for (size_t i = gtid; i < (size_t)SEQ * 96; i += nthr) {
            const int pos = (int)(i / 96), r = (int)(i % 96);
            const bool is64 = r < 32; const int fi = is64 ? r : r - 32; const float dim = is64 ? 64.f : 128.f;
            const float inv = exp2f(-(2.f * (float)fi / dim) * 13.287712379549449f);
            const float ang = (float)pos * inv; float sn, cs; sincosf(ang, &sn, &cs);
            if (is64) t64[(size_t)pos * 32 + fi] = (f32x2){cs, sn}; else t128[(size_t)pos * 64 + fi] = (f32x2){cs, sn};
        }
        u32x4 z = {0u, 0u, 0u, 0u};
        for (size_t i = gtid; i < (size_t)208 * 2048 / 8; i += nthr) *(u32x4*)((bf16*)(ws + WS_WIN1) + (size_t)3632 * 2048 + i * 8) = z;
        for (size_t i = gtid; i < (size_t)2 * 128 * 256 / 8; i += nthr) { const size_t half = i / (128 * 256 / 8), r = i % (128 * 256 / 8); *(u32x4*)((bf16*)(ws + WS_W2T) + (half * 256 + 128) * 256 + r * 8) = z; }
    }
}
#undef A
template <bool XF32, bool ADDY = false>
__device__ __forceinline__ void adaln_rows(const void* X, const float* g, const float* mod, bf16* H, int vcu, int G, const bf16* Y = nullptr, bf16* XB = nullptr) {
    int tid_ = threadIdx.x; asm volatile("" : "+v"(tid_));
    const int lane = tid_ & 63, wave = __builtin_amdgcn_readfirstlane(tid_ >> 6);
    const int stride = G * NWAVES;
#pragma unroll 1
    for (int b = 0; b < T / SEQ; ++b) {
        f32x4 cs[8], sh[8];
#pragma unroll
        for (int j = 0; j < 8; ++j) { const int idx = lane * 8 + 512 * (j >> 1) + 4 * (j & 1);
            const f32x4 gg = *(const f32x4*)(g + idx), sc = *(const f32x4*)(mod + (size_t)b * 6144 + 2048 + idx);
            cs[j] = gg * (1.f + sc); sh[j] = *(const f32x4*)(mod + (size_t)b * 6144 + idx); }
        int row = b * SEQ + vcu * NWAVES + wave;
        if (row >= (b + 1) * SEQ) continue;
        f32x4 v[8];
        auto ld = [&](int r, f32x4 (&d)[8]) {
            if (XF32) { const float* xr = (const float*)X + (size_t)r * 2048;
#pragma unroll
                for (int j = 0; j < 8; ++j) d[j] = *(const f32x4*)(xr + lane * 8 + 512 * (j >> 1) + 4 * (j & 1)); }
            else { const bf16* xr = (const bf16*)X + (size_t)r * 2048;
#pragma unroll
                for (int j = 0; j < 4; ++j) { const u32x4 w = *(const u32x4*)(xr + lane * 8 + 512 * j);
                    d[2 * j] = (f32x4){bflo(w.x), bfhi(w.x), bflo(w.y), bfhi(w.y)}; d[2 * j + 1] = (f32x4){bflo(w.z), bfhi(w.z), bflo(w.w), bfhi(w.w)}; } }
            if (ADDY) {
                const bf16* yr = Y + (size_t)r * 2048; bf16* xo = XB + (size_t)r * 2048;
#pragma unroll
                for (int j = 0; j < 4; ++j) { const u32x4 w = *(const u32x4*)(yr + lane * 8 + 512 * j);
                    const f32x4 s0 = d[2 * j] + (f32x4){bflo(w.x), bfhi(w.x), bflo(w.y), bfhi(w.y)}, s1 = d[2 * j + 1] + (f32x4){bflo(w.z), bfhi(w.z), bflo(w.w), bfhi(w.w)};
                    const u32x4 pw = pack8(s0, s1); *(u32x4*)(xo + lane * 8 + 512 * j) = pw;
                    d[2 * j] = (f32x4){bflo(pw.x), bfhi(pw.x), bflo(pw.y), bfhi(pw.y)}; d[2 * j + 1] = (f32x4){bflo(pw.z), bfhi(pw.z), bflo(pw.w), bfhi(pw.w)}; }
            }
        };
        ld(row, v);
#pragma unroll 1
        for (; row < (b + 1) * SEQ; row += stride) {
            f32x4 nx[8]; const int rn = row + stride; const bool more = rn < (b + 1) * SEQ;
            if (!ADDY || more) ld(more ? rn : row, nx);
            float ss = 0.f;
#pragma unroll
            for (int j = 0; j < 8; ++j) ss += v[j].x * v[j].x + v[j].y * v[j].y + v[j].z * v[j].z + v[j].w * v[j].w;
            const float r = 1.0f / sqrtf(wave_sum(ss) * (1.f / DM) + NORM_EPS);
            bf16* hrow = H + (size_t)row * 2048;
#pragma unroll
            for (int j = 0; j < 4; ++j) {
                const f32x4 o0 = v[2 * j] * r * cs[2 * j] + sh[2 * j], o1 = v[2 * j + 1] * r * cs[2 * j + 1] + sh[2 * j + 1];
                u32x4 w; w.x = cvtpk(o0.x, o0.y); w.y = cvtpk(o0.z, o0.w); w.z = cvtpk(o1.x, o1.y); w.w = cvtpk(o1.z, o1.w);
                *(u32x4*)(hrow + lane * 8 + 512 * j) = w;
            }
#pragma unroll
            for (int j = 0; j < 8; ++j) v[j] = nx[j];
        }
    }
}
__device__ __forceinline__ void phase_adaln_bf(KArgs Ap, int li, int vcu, int G) {
    adaln_rows<false>((*Ap).ws + WS_XB, (*Ap).in[4] + (size_t)li * 2048, (const float*)((*Ap).ws + WS_MOD) + (size_t)li * 2 * 6144, (bf16*)((*Ap).ws + WS_H), vcu, G);
}
template <bool XF32>
__device__ __forceinline__ void phase_adaln_add(KArgs Ap, const void* xold, int li, int vcu, int G) {
    adaln_rows<XF32, true>(xold, (*Ap).in[4] + (size_t)li * 2048, (const float*)((*Ap).ws + WS_MOD) + (size_t)li * 2 * 6144, (bf16*)((*Ap).ws + WS_H), vcu, G, (const bf16*)((*Ap).ws + WS_Y), (bf16*)((*Ap).ws + WS_XB));
}
__device__ __forceinline__ void phase_adaln(KArgs Ap, const float* xsrc, int li, int vcu, int G) {
    adaln_rows<true>(xsrc, (*Ap).in[4] + (size_t)li * 2048, (const float*)((*Ap).ws + WS_MOD) + (size_t)li * 2 * 6144, (bf16*)((*Ap).ws + WS_H), vcu, G);
}
__device__ __forceinline__ void phase_final(KArgs Ap, const float* xsrc, int vcu, int G) {
    const int lane = threadIdx.x & 63, wave = __builtin_amdgcn_readfirstlane(threadIdx.x >> 6);
    for (int row = vcu * NWAVES + wave; row < T; row += G * NWAVES) final_row(xsrc + (size_t)row * 2048, (*Ap).in[19], (*Ap).out + (size_t)row * 2048, lane);
}

#undef A
__global__ void __launch_bounds__(NTHREADS, 2) fwd_kernel(Args Aunused) {
    extern __shared__ __attribute__((aligned(16))) unsigned char lds_raw[];
    LAS unsigned char* lds = (LAS unsigned char*)lds_raw;
    const int G = gridDim.x, bx = blockIdx.x;
    const int vcu = (G % 8 == 0) ? (bx % 8) * (G / 8) + bx / 8 : bx;
    cg::grid_group grid = cg::this_grid();
    const XcdBarrier xbar = xcd_barrier_post((unsigned*)(kargs()->ws + WS_CTL), (volatile unsigned*)(kargs()->ws + WS_CTL + 16384) + 16 * bx);
#define A (*kargs())
#define ws (kargs()->ws)
#define mod ((const float*)(ws + WS_MOD))
#define tab64 ((const f32x2*)(ws + WS_TAB64))
#define tab128 ((const f32x2*)(ws + WS_TAB128))
#define H ((bf16*)(ws + WS_H))
#define ATT ((bf16*)(ws + WS_ATT))
#define xbuf (kargs()->out)
#ifndef PHASE_MASK
#define PHASE_MASK 0x1FFFF
#endif
#define PH(k) ((((PHASE_MASK) >> (k)) & 1) && A.ph_lo <= (k) && (k) < A.ph_hi)
#define SEAM(k) do { if (PH(k) && PH((k) + 1)) { if ((k) == 0) grid.sync(); else xcd_barrier(xbar); } } while (0)
#ifndef PEER_SELONLY
#define PEER_SELONLY 0
#endif
#ifndef FLOW1
#define FLOW1 0
#endif
#ifndef P9_ALT
#define P9_ALT 1
#endif
#ifndef RESID_IN_NORM
#define RESID_IN_NORM 0
#endif
#ifndef FLOW2
#define FLOW2 0
#endif
#ifndef PEER_HALF_PROBE
#define PEER_HALF_PROBE 0
#endif
#ifndef REPEAT_PHASE
#define REPEAT_PHASE -1
#endif
#define REP(k) for (int rep_ = 0; rep_ < ((REPEAT_PHASE) == (k) ? 2 : 1); ++rep_, (((REPEAT_PHASE) == (k) && rep_ == 1) ? xcd_barrier(xbar) : (void)0))
    if (PH(0)) REP(0) { phase_prologue(kargs(), lds, vcu, G, rep_ ? (PRO_SKIP) : 0); }
    SEAM(0);
    if (PH(1)) REP(1) { phase_adaln(kargs(), A.in[0], 0, vcu, G); }
    SEAM(1);
    if (PH(2)) REP(2) { pg8::Gemm g{H, (const bf16*)(ws + WS_WIN0), T, 4608, 2048, 2048}; pg8::StaticOrder S; S.init(T, 4608, G, bx);
        EpiQKV0 E{(bf16*)(ws + WS_QKV), tab64}; pg8::gemm_phase<EpiQKV0, pg8::StaticOrder, true, true>(lds, g, S, E); }
    if (DEFER_PRO && PH(2) && bx >= 128 && G == 256) {
        for (int it = 48 + (bx - 128); it < 192; it += 128) { __syncthreads(); ada_item(kargs(), lds, it); }
        __syncthreads();
    }
    SEAM(2);
    if (PH(3)) REP(3) {
        const bf16* qkv = (const bf16*)(ws + WS_QKV);
        float lam;
        { const float* lv = A.in[7]; const int lane = threadIdx.x & 63; const float d1 = wave_sum(lv[lane] * lv[64 + lane]), d2 = wave_sum(lv[128 + lane] * lv[192 + lane]); lam = __expf(d1) - __expf(d2) + 0.2f; }
#ifndef SKIP_DA
#define SKIP_DA 0
#endif
        if (SKIP_DA) { for (size_t i = (size_t)vcu * NTHREADS + threadIdx.x; i < (size_t)T * 128; i += (size_t)G * NTHREADS) { const size_t r = i >> 7, cc = i & 127; *(u32x4*)(ATT + r * 2048 + cc * 8) = (u32x4){0u, 0u, 0u, 0u}; } }
        else for (int n = vcu; n < 256; n += G)
            for (int i = 0; i < 2; ++i) { const int bh = n >> 4, s = n & 15, qb = i == 0 ? s : 31 - s; __syncthreads(); da_unit(lds, qkv, ATT, bh >> 3, bh & 7, qb, lam, A.in[8], (float*)(ws + WS_SLOT)); }
#ifndef NAIVE_SWA
#define NAIVE_SWA 0
#endif
#ifndef SKIP_SWA
#define SKIP_SWA 0
#endif
        if (SKIP_SWA) { for (size_t i = (size_t)vcu * NTHREADS + threadIdx.x; i < (size_t)T * 128; i += (size_t)G * NTHREADS) { const size_t r = i >> 7, cc = i & 127; *(u32x4*)(ATT + r * 2048 + 1024 + cc * 8) = (u32x4){0u, 0u, 0u, 0u}; } }
        else if (NAIVE_SWA) { const int wv = __builtin_amdgcn_readfirstlane(threadIdx.x >> 6);
            for (int it = vcu * NWAVES + wv; it < T * 16; it += G * NWAVES) swa_naive(qkv, ATT, (it >> 4) >> 13, (it >> 4) & (SEQ - 1), it & 15, A.in[9], threadIdx.x & 63); }
        else
        for (int n = vcu; n < 1024; n += G) { __syncthreads(); swa_unit(lds, qkv, ATT, n >> 9, (n >> 7) & 3, n & 127, A.in[9]); }
    }
    SEAM(3);
#if FLOW1
    if (PH(4)) {
        using R = flow::R1;
        flow::Q fq{(unsigned*)(ws + flow::WS_FLOW) + R::BASE, (int)(xbar.x & 7u), 0u};
        for (int t = flow::pop<R, false>(lds, fq, -1); t >= 0; t = flow::pop<R, false>(lds, fq, -1)) {
            const int xq = (t >> 24) & 7, st = (t >> 16) & 255, rt = (t >> 8) & 255, ix = t & 255;
            if (st == 0) { pg8::Gemm g{ATT, (const bf16*)(ws + WS_WOUT0), T, 2048, 2048, 2048}; EpiResid<true> E{A.in[0], (bf16*)(ws + WS_XB), mod + 4096};
                flow::GOrder<R, 0> S{lds, &fq, t}; pg8::gemm_phase<EpiResid<true>, flow::GOrder<R, 0>, true, true>(lds, g, S, E); }
            else if (st == 2) { pg8::Gemm g{H, (const bf16*)(ws + WS_WQ0), T, 2048, 2048, 2048}; EpiPlain E{(bf16*)(ws + WS_Q1), 2048};
                flow::GOrder<R, 2> S{lds, &fq, t}; pg8::gemm_phase<EpiPlain, flow::GOrder<R, 2>, true, true>(lds, g, S, E); }
            else if (st == 4) { pg8::Gemm g{H, (const bf16*)(ws + WS_WIN1), T, 3840, 2048, 2048}; EpiQKV1 E{ws, tab128};
                flow::GOrder<R, 4> S{lds, &fq, t}; pg8::gemm_phase<EpiQKV1, flow::GOrder<R, 4>, true, true>(lds, g, S, E); }
            else if (st == 1) {
                flow::acquire();
                int tid_ = threadIdx.x; asm volatile("" : "+v"(tid_));
                const int lane = tid_ & 63, wave = __builtin_amdgcn_readfirstlane(tid_ >> 6);
                const float* md = mod + (size_t)1 * 2 * 6144; const float* gg = A.in[4] + (size_t)1 * 2048;
                for (int i = 0; i < 8; ++i) { const int row = rt * 256 + ix * 64 + wave * 8 + i; adaln_row_bf((const bf16*)(ws + WS_XB) + (size_t)row * 2048, gg, md + (size_t)(row >> 13) * 6144, H + (size_t)row * 2048, lane); }
                flow::publish<false>(flow::arrive_ctr(fq, 1, rt), nullptr);
            } else {
                flow::acquire();
                peer_tile<0>(lds, rt * 8 + ix, 0, xbar);
                flow::publish<false>(flow::arrive_ctr(fq, 3, rt), flow::pact_ctr(fq, xq));
            }
        }
    }
#else
#if RESID_IN_NORM
    if (PH(4)) REP(4) { pg8::Gemm g{ATT, (const bf16*)(ws + WS_WOUT0), T, 2048, 2048, 2048}; pg8::StaticOrder S; S.init(T, 2048, G, bx);
        EpiGate E{(bf16*)(ws + WS_Y), mod + 4096}; pg8::gemm_phase<EpiGate, pg8::StaticOrder, true, true>(lds, g, S, E); }
    SEAM(4);
    if (PH(5)) { phase_adaln_add<true>(kargs(), A.in[0], 1, vcu, G); }
#else
    if (PH(4)) REP(4) { pg8::Gemm g{ATT, (const bf16*)(ws + WS_WOUT0), T, 2048, 2048, 2048}; pg8::StaticOrder S; S.init(T, 2048, G, bx);
        EpiResid<true> E{A.in[0], (bf16*)(ws + WS_XB), mod + 4096}; pg8::gemm_phase<EpiResid<true>, pg8::StaticOrder, true, true>(lds, g, S, E); }
    SEAM(4);
    if (PH(5)) REP(5) { phase_adaln_bf(kargs(), 1, vcu, G); }
#endif
    SEAM(5);
    if (PH(6)) REP(6) { pg8::Gemm g{H, (const bf16*)(ws + WS_WQ0), T, 2048, 2048, 2048}; pg8::StaticOrder S; S.init(T, 2048, G, bx);
        EpiPlain E{(bf16*)(ws + WS_Q1), 2048}; pg8::gemm_phase<EpiPlain, pg8::StaticOrder, true, true>(lds, g, S, E); }
    SEAM(6);
    if (PH(7)) REP(7) {
        if (REPEAT_PHASE == 7 && rep_ == 0 && PEER_HALF_PROBE >= 2) {
            if (((bx >> 3) & 1) == 0) { if (PEER_HALF_PROBE == 2) for (int tile = vcu; tile < 512; tile += G) peer_tile<0, true, false>(lds, tile, 0, xbar); }
            else { const int c = (bx >> 4) * 8 + (bx & 7);
                for (int r2 = 0; r2 < 2; ++r2) { pg8::Gemm g{H, (const bf16*)(ws + WS_WQ0), T, 2048, 2048, 2048}; pg8::StaticOrder S; S.init(T, 2048, 128, c);
                    EpiPlain E{ATT, 2048}; pg8::gemm_phase<EpiPlain, pg8::StaticOrder, true, true>(lds, g, S, E); } }
        } else
        for (int tile = vcu; tile < 512; tile += G)
            if (REPEAT_PHASE == 7 && rep_ == 0) { if (!(PEER_HALF_PROBE) || ((bx >> 3) & 1) == 0) peer_tile<0, true, (PEER_SELONLY != 0)>(lds, tile, 0, xbar); }
            else peer_tile<0>(lds, tile, 0, xbar);
    }
    SEAM(7);
    if (PH(8)) REP(8) { pg8::Gemm g{H, (const bf16*)(ws + WS_WIN1), T, 3840, 2048, 2048}; pg8::StaticOrder S; S.init(T, 3840, G, bx);
        EpiQKV1 E{ws, tab128}; pg8::gemm_phase<EpiQKV1, pg8::StaticOrder, true, true>(lds, g, S, E); }
#endif
    if (DEFER_PRO && PH(8) && bx >= 192 && G == 256) {
        __syncthreads();
        const int lane = threadIdx.x & 63, wv = __builtin_amdgcn_readfirstlane(threadIdx.x >> 6);
        LAS float* scr = (LAS float*)(lds + wv * 16384);
        for (int it = (bx - 192) * NWAVES + wv; it < 4096; it += 64 * NWAVES) {
            if (it < 2048) transpose_item(A.in[11], 2048, 2048, (bf16*)(ws + WS_WOUT1), 0, scr, it, lane);
            else transpose_item(A.in[15] + (size_t)2048 * 2048, 2048, 2048, (bf16*)(ws + WS_WQ1), 0, scr, it - 2048, lane);
        }
        __syncthreads();
    }
    SEAM(8);
    if (PH(9) && bx >= 16) {
        const int lane = threadIdx.x & 63, wv = __builtin_amdgcn_readfirstlane(threadIdx.x >> 6);
#pragma unroll 1
        for (int half = 0; half < 2; ++half) {
            if ((half == 0) == (((bx >> 3) & 1) == 0 || !P9_ALT)) {
                for (int un = bx - 16; un < 1024; un += G - 16) nsa_window_unit(lds, un >> 9, (un >> 8) & 1, un & 255);
                __syncthreads();
            } else {
                const int cvi = (P9_SKIP5 && G == 256) ? bx - 80 : bx - 16, cvn = (P9_SKIP5 && G == 256) ? 176 : G - 16;
                if (cvi >= 0)
                for (int r = 2 * 16384 + cvi * NWAVES + wv; r < 4 * 16384; r += 2 * cvn * NWAVES) {
                    const int r2 = r + cvn * NWAVES; const bool two = r2 < 4 * 16384;
                    const int tb = r >> 14, e = r & 16383; const float* src = (tb & 1 ? A.in[18] : A.in[17]) + ((size_t)(tb >> 1) * 16384 + e) * 2048;
                    const int rr = two ? r2 : r, tb2 = rr >> 14, e2 = rr & 16383; const float* src2 = (tb2 & 1 ? A.in[18] : A.in[17]) + ((size_t)(tb2 >> 1) * 16384 + e2) * 2048;
                    f32x4 pa[8], pb[8];
#if CONV_COAL
                    { f32x4 ra[8], rb[8]; row_load_coal(src, ra, lane); row_load_coal(src2, rb, lane); LAS float* xs = (LAS float*)lds + wv * 4608; row_xpose(ra, pa, xs, lane); row_xpose(rb, pb, xs + 2304, lane); }
#else
                    row_to_fp6_pre(src, pa, lane); row_to_fp6_pre(src2, pb, lane);
#endif
                    row_to_fp6(src, ws + WS_TAB + (size_t)tb * 24 * MiB + (size_t)e * 1536, (float*)(ws + WS_TSCALE) + r, lane, &pa);
                    if (two) row_to_fp6(src2, ws + WS_TAB + (size_t)tb2 * 24 * MiB + (size_t)e2 * 1536, (float*)(ws + WS_TSCALE) + rr, lane, &pb);
                }
            }
        }
    }
    if (PH(9)) REP(9) { pg8::Gemm g{(const bf16*)(ws + WS_KCVC), (const bf16*)(ws + WS_W1T), 4096, 512, 4096, 2048}; CmpOrder S{bx};
        EpiCmp1 E{(bf16*)(ws + WS_HID), (const float*)(ws + WS_BIAS1)}; pg8::gemm_phase<EpiCmp1, CmpOrder, false, true>(lds, g, S, E); }
    SEAM(9);
    if (PH(10)) { pg8::Gemm g{(const bf16*)(ws + WS_HID), (const bf16*)(ws + WS_W2T), 4096, 512, 256, 256}; CmpOrder S{bx};
        EpiCmp2 E{(bf16*)(ws + WS_KCMP), (bf16*)(ws + WS_VCMP), tab128}; pg8::gemm_phase<EpiCmp2, CmpOrder, false, true>(lds, g, S, E); }
    SEAM(10);
    if (PH(11)) REP(11) {
        if (vcu < 256) {
#pragma unroll 1
            for (int i = 0; i < 4; ++i) nsa_unit(lds, i >> 1, i & 1, (i & 1) ? 255 - vcu : vcu);
        }
    }
    SEAM(11);
#if FLOW2
    if (PH(12)) {
        using R = flow::R2;
        flow::Q fq{(unsigned*)(ws + flow::WS_FLOW) + R::BASE, (int)(xbar.x & 7u), 0u};
        for (int t = flow::pop<R, false>(lds, fq, -1); t >= 0; t = flow::pop<R, false>(lds, fq, -1)) {
            const int xq = (t >> 24) & 7, st = (t >> 16) & 255, rt = (t >> 8) & 255, ix = t & 255;
            if (st == 0) { pg8::Gemm g{ATT, (const bf16*)(ws + WS_WOUT1), T, 2048, 2048, 2048}; EpiResid<false> E{(const bf16*)(ws + WS_XB), (bf16*)(ws + WS_XB), mod + (size_t)2 * 2 * 6144 + 4096};
                flow::GOrder<R, 0> S{lds, &fq, t}; pg8::gemm_phase<EpiResid<false>, flow::GOrder<R, 0>, true, true>(lds, g, S, E); }
            else if (st == 2) { pg8::Gemm g{H, (const bf16*)(ws + WS_WQ1), T, 2048, 2048, 2048}; EpiPlain E{(bf16*)(ws + WS_Q1), 2048};
                flow::GOrder<R, 2> S{lds, &fq, t}; pg8::gemm_phase<EpiPlain, flow::GOrder<R, 2>, true, true>(lds, g, S, E); }
            else if (st == 1) {
                flow::acquire();
                int tid_ = threadIdx.x; asm volatile("" : "+v"(tid_));
                const int lane = tid_ & 63, wave = __builtin_amdgcn_readfirstlane(tid_ >> 6);
                const float* md = mod + (size_t)3 * 2 * 6144; const float* gg = A.in[4] + (size_t)3 * 2048;
                for (int i = 0; i < 8; ++i) { const int row = rt * 256 + ix * 64 + wave * 8 + i; adaln_row_bf((const bf16*)(ws + WS_XB) + (size_t)row * 2048, gg, md + (size_t)(row >> 13) * 6144, H + (size_t)row * 2048, lane); }
                flow::publish<false>(flow::arrive_ctr(fq, 1, rt), nullptr);
            } else {
                flow::acquire();
                peer_tile<1>(lds, rt * 8 + ix, 1, xbar);
                flow::publish<false>(flow::arrive_ctr(fq, 3, rt), flow::pact_ctr(fq, xq));
            }
        }
    }
#else
#if RESID_IN_NORM
    if (PH(12)) REP(12) { pg8::Gemm g{ATT, (const bf16*)(ws + WS_WOUT1), T, 2048, 2048, 2048}; pg8::StaticOrder S; S.init(T, 2048, G, bx);
        EpiGate E{(bf16*)(ws + WS_Y), mod + (size_t)2 * 2 * 6144 + 4096}; pg8::gemm_phase<EpiGate, pg8::StaticOrder, true, true>(lds, g, S, E); }
    SEAM(12);
    if (PH(13)) phase_adaln_add<false>(kargs(), ws + WS_XB, 3, vcu, G);
#else
    if (PH(12)) REP(12) { pg8::Gemm g{ATT, (const bf16*)(ws + WS_WOUT1), T, 2048, 2048, 2048}; pg8::StaticOrder S; S.init(T, 2048, G, bx);
        EpiResid<false> E{(const bf16*)(ws + WS_XB), (bf16*)(ws + WS_XB), mod + (size_t)2 * 2 * 6144 + 4096}; pg8::gemm_phase<EpiResid<false>, pg8::StaticOrder, true, true>(lds, g, S, E); }
    SEAM(12);
    if (PH(13)) phase_adaln_bf(kargs(), 3, vcu, G);
#endif
    SEAM(13);
    if (PH(14)) REP(14) { pg8::Gemm g{H, (const bf16*)(ws + WS_WQ1), T, 2048, 2048, 2048}; pg8::StaticOrder S; S.init(T, 2048, G, bx);
        EpiPlain E{(bf16*)(ws + WS_Q1), 2048}; pg8::gemm_phase<EpiPlain, pg8::StaticOrder, true, true>(lds, g, S, E); }
    SEAM(14);
    if (PH(15)) REP(15) {
        for (int tile = vcu; tile < 512; tile += G)
            peer_tile<1>(lds, tile, 1, xbar);
    }
#endif
    SEAM(15);
    if (PH(16)) phase_final(kargs(), (STOP_AFTER < 4) ? A.in[0] : (const float*)xbuf, vcu, G);
#undef PH
#undef SEAM
#undef A
#undef ws
#undef mod
#undef tab64
#undef tab128
#undef H
#undef ATT
#undef xbuf
}

extern "C" void kernel_launch(void* const* d_in, const int* in_sizes, int n_in, void* d_out, int out_size, void* d_ws, size_t ws_size, hipStream_t stream) {
    static int grid = 0;
    if (grid == 0) {
        if (n_in != 20 || out_size != T * DM || ws_size < WS_END) { fprintf(stderr, "kernel_launch: unexpected problem (n_in %d out %d ws %zu)\n", n_in, out_size, ws_size); grid = -1; return; }
        int dev = 0, cus = 0, per_cu = 0;
        hipGetDevice(&dev); hipDeviceGetAttribute(&cus, hipDeviceAttributeMultiprocessorCount, dev);
        hipFuncSetAttribute((const void*)fwd_kernel, hipFuncAttributeMaxDynamicSharedMemorySize, LDS_BYTES);
        hipOccupancyMaxActiveBlocksPerMultiprocessor(&per_cu, (const void*)fwd_kernel, NTHREADS, LDS_BYTES);
        (void)hipGetLastError();
        if (per_cu < 1) { fprintf(stderr, "kernel_launch: occupancy query says %d blocks per CU\n", per_cu); per_cu = 1; }
        grid = cus;
        if (grid > 256) grid = 256;
    }
    if (grid < 0) return;
    (void)hipMemsetAsync((char*)d_ws + WS_CTL, 0, 65536, stream);
    Args a{};
    for (int i = 0; i < 20; ++i) a.in[i] = (const float*)d_in[i];
    a.out = (float*)d_out; a.ws = (unsigned char*)d_ws;
#if N_LAUNCH_MODE == 1
    a.ph_lo = 0; a.ph_hi = (STOP_AFTER < 15) ? N_PHASES : 16;
    if (STOP_AFTER < 15) {
        a.ph_hi = STOP_AFTER + 1; void* args1[] = {&a};
        hipLaunchCooperativeKernel((const void*)fwd_kernel, dim3(grid), dim3(NTHREADS), args1, LDS_BYTES, stream);
        Args b = a; b.ph_lo = 16; b.ph_hi = 17; void* args2[] = {&b};
        hipLaunchCooperativeKernel((const void*)fwd_kernel, dim3(grid), dim3(NTHREADS), args2, LDS_BYTES, stream);
    } else {
        void* args[] = {&a};
        hipError_t e = hipLaunchCooperativeKernel((const void*)fwd_kernel, dim3(grid), dim3(NTHREADS), args, LDS_BYTES, stream);
        if (e != hipSuccess) fprintf(stderr, "cooperative launch failed: %s (grid %d)\n", hipGetErrorString(e), grid);
    }
#else
    for (int p = 0; p < N_PHASES; ++p) {
        if (p > STOP_AFTER && p != 16) continue;
        if (p == 16 && STOP_AFTER >= 15) continue;
        Args b = a; b.ph_lo = p; b.ph_hi = p + 1;
        hipLaunchKernelGGL(fwd_kernel, dim3(grid), dim3(NTHREADS), LDS_BYTES, stream, b);
    }
#endif
}
```
